# Optimizing an MI355X kernel written in HIP

```python
import jax, jax.numpy as jnp
from jax import lax
import numpy as np

D_MODEL = 1024
BATCH = 4
SEQ = 8192
DEPTH = 2

HEAD_DIM = 64
N_HEADS_A = 16
N_HEADS_B = 16
N_KV_GROUPS_B = 4
HEADS_PER_GROUP = N_HEADS_B // N_KV_GROUPS_B
Q_BLOCK = 128
ROPE_THETA = 500000.0
ROPE_DIM = HEAD_DIM // 4
CMP_BLOCK = 64
SEL_BLOCK = CMP_BLOCK
N_SELECT = 16
WINDOW = 512
SEL_Q_CHUNK = 64
CMP_HIDDEN = 256
N_EXPERTS = 64
TOP_K = 8
D_EXPERT = 256
D_SHARED = 256
ROUTED_SCALE = 2.5
MOE_BLOCK = 256
N_A_LAYERS = DEPTH // 2
N_B_LAYERS = DEPTH - N_A_LAYERS
EPS = 1e-6
FORCE_SCORE = 1e4

kernel_name = 'fox_nsa_yoco_moe_adaln_trunk'


def rmsnorm(x, gain):
    xf = x.astype(jnp.float32)
    xf = xf * lax.rsqrt(jnp.mean(xf * xf, axis=-1, keepdims=True) + EPS)
    return (xf * gain.astype(jnp.float32)).astype(x.dtype)


def modulate(xn, shift, scale):
    return xn * (1 + scale[:, None, :]) + shift[:, None, :]


def rope_tables(positions, dtype):
    inv_freq = ROPE_THETA ** (-jnp.arange(0, ROPE_DIM, 2, dtype=jnp.float32) / ROPE_DIM)
    ang = positions.astype(jnp.float32)[..., None] * inv_freq
    return jnp.cos(ang)[:, :, None, :].astype(dtype), jnp.sin(ang)[:, :, None, :].astype(dtype)


def apply_rope(x, cos, sin):
    half = ROPE_DIM // 2
    x1 = x[..., :half]
    x2 = x[..., half:ROPE_DIM]
    return jnp.concatenate([x1 * cos - x2 * sin, x2 * cos + x1 * sin, x[..., ROPE_DIM:]], axis=-1)


def forgetting_attention(u, w_in, b_f, q_gain, k_gain, w_o):
    B, S, _ = u.shape
    hd = N_HEADS_A * HEAD_DIM
    proj = u @ w_in
    q = rmsnorm(proj[..., :hd].reshape(B, S, N_HEADS_A, HEAD_DIM), q_gain)
    k = rmsnorm(proj[..., hd:2 * hd].reshape(B, S, N_HEADS_A, HEAD_DIM), k_gain)
    v = proj[..., 2 * hd:3 * hd].reshape(B, S, N_HEADS_A, HEAD_DIM)
    log_f = jax.nn.log_sigmoid((proj[..., 3 * hd:] + b_f).astype(jnp.float32))
    cum = jnp.cumsum(log_f, axis=1)
    cum_k = cum.transpose(0, 2, 1)
    nqb = S // Q_BLOCK
    q_blocks = q.reshape(B, nqb, Q_BLOCK, N_HEADS_A, HEAD_DIM).transpose(1, 0, 2, 3, 4)
    cum_blocks = cum.reshape(B, nqb, Q_BLOCK, N_HEADS_A).transpose(1, 0, 2, 3)
    key_pos = jnp.arange(S)
    scale = HEAD_DIM ** -0.5

    def block(args):
        qb, cq, bi = args
        logits = jnp.einsum('bqhd,bkhd->bhqk', qb, k, preferred_element_type=jnp.float32) * scale
        logits = logits + (cq.transpose(0, 2, 1)[..., None] - cum_k[:, :, None, :])
        q_pos = bi * Q_BLOCK + jnp.arange(Q_BLOCK)
        mask = key_pos[None, :] <= q_pos[:, None]
        p = jax.nn.softmax(jnp.where(mask[None, None], logits, -jnp.inf), axis=-1)
        return jnp.einsum('bhqk,bkhd->bqhd', p.astype(v.dtype), v)

    o = lax.map(block, (q_blocks, cum_blocks, jnp.arange(nqb)))
    o = o.transpose(1, 0, 2, 3, 4).reshape(B, S, hd)
    return o @ w_o


def shared_kv(h, cond, norm_kv, w_ada_kv, b_ada_kv, w_kv, pe_k, pe_v, w_ck1, w_ck2, w_cv1, w_cv2,
              k_gains, cos, sin):
    B, S, _ = h.shape
    shift, scale = jnp.split(cond @ w_ada_kv + b_ada_kv, 2, axis=-1)
    s = modulate(rmsnorm(h, norm_kv), shift, scale)
    kv = (s @ w_kv).reshape(B, S, 6, N_KV_GROUPS_B, HEAD_DIM)
    nb = S // CMP_BLOCK

    def compress(t, pe, w1, w2):
        blocks = t.reshape(B, nb, CMP_BLOCK, N_KV_GROUPS_B, HEAD_DIM) + pe[None, None, :, None, :]
        flat = blocks.transpose(0, 1, 3, 2, 4).reshape(B, nb, N_KV_GROUPS_B, CMP_BLOCK * HEAD_DIM)
        return jax.nn.silu(flat @ w1) @ w2

    k_cmp = rmsnorm(compress(kv[:, :, 0], pe_k, w_ck1, w_ck2), k_gains[0])
    v_cmp = compress(kv[:, :, 1], pe_v, w_cv1, w_cv2)
    k_sel = apply_rope(rmsnorm(kv[:, :, 2], k_gains[1]), cos, sin)
    v_sel = kv[:, :, 3]
    k_win = apply_rope(rmsnorm(kv[:, :, 4], k_gains[2]), cos, sin)
    v_win = kv[:, :, 5]
    return (k_cmp, v_cmp, k_sel, v_sel, k_win, v_win)


def selected_branch(q_rot, k_sel, v_sel, sel_idx):
    B, S, G, HPG, Dh = q_rot.shape
    nb = S // SEL_BLOCK
    nc = S // SEL_Q_CHUNK
    n_sel = sel_idx.shape[-1]
    k_blk = k_sel.reshape(B, nb, SEL_BLOCK, G, Dh).transpose(0, 3, 1, 2, 4)
    v_blk = v_sel.reshape(B, nb, SEL_BLOCK, G, Dh).transpose(0, 3, 1, 2, 4)
    qc = q_rot.reshape(B, nc, SEL_Q_CHUNK, G, HPG, Dh).transpose(1, 0, 2, 3, 4, 5)
    ic = sel_idx.reshape(B, nc, SEL_Q_CHUNK, G, n_sel).transpose(1, 0, 2, 3, 4)
    b_ix = jnp.arange(B)[:, None, None, None]
    g_ix = jnp.arange(G)[None, None, :, None]
    scale = Dh ** -0.5

    def chunk(args):
        qb, idx, ci = args
        kg = k_blk[b_ix, g_ix, idx]
        vg = v_blk[b_ix, g_ix, idx]
        logits = jnp.einsum('bqghd,bqgnkd->bqghnk', qb, kg, preferred_element_type=jnp.float32) * scale
        key_pos = idx[..., None] * SEL_BLOCK + jnp.arange(SEL_BLOCK)
        q_pos = ci * SEL_Q_CHUNK + jnp.arange(SEL_Q_CHUNK)
        mask = key_pos <= q_pos[None, :, None, None, None]
        logits = jnp.where(mask[:, :, :, None], logits, -jnp.inf)
        p = jax.nn.softmax(logits.reshape(B, SEL_Q_CHUNK, G, HPG, n_sel * SEL_BLOCK), axis=-1)
        return jnp.einsum('bqghm,bqgmd->bqghd', p.astype(vg.dtype),
                          vg.reshape(B, SEL_Q_CHUNK, G, n_sel * SEL_BLOCK, Dh))

    o = lax.map(chunk, (qc, ic, jnp.arange(nc)))
    return o.transpose(1, 0, 2, 3, 4, 5).reshape(B, S, G * HPG, Dh)


def window_branch(q_rot, k_win, v_win):
    B, S, G, HPG, Dh = q_rot.shape
    nq = S // Q_BLOCK
    span = WINDOW + Q_BLOCK
    kp = jnp.pad(k_win, ((0, 0), (WINDOW, 0), (0, 0), (0, 0)))
    vp = jnp.pad(v_win, ((0, 0), (WINDOW, 0), (0, 0), (0, 0)))
    qb_all = q_rot.reshape(B, nq, Q_BLOCK, G, HPG, Dh).transpose(1, 0, 2, 3, 4, 5)
    scale = Dh ** -0.5

    def block(args):
        qb, bi = args
        start = bi * Q_BLOCK
        kb = lax.dynamic_slice_in_dim(kp, start, span, axis=1)
        vb = lax.dynamic_slice_in_dim(vp, start, span, axis=1)
        logits = jnp.einsum('bqghd,bkgd->bqghk', qb, kb, preferred_element_type=jnp.float32) * scale
        q_pos = start + jnp.arange(Q_BLOCK)
        k_pos = start - WINDOW + jnp.arange(span)
        diff = q_pos[:, None] - k_pos[None, :]
        mask = (diff >= 0) & (diff < WINDOW) & (k_pos >= 0)[None, :]
        p = jax.nn.softmax(jnp.where(mask[None, :, None, None, :], logits, -jnp.inf), axis=-1)
        return jnp.einsum('bqghk,bkgd->bqghd', p.astype(vb.dtype), vb)

    o = lax.map(block, (qb_all, jnp.arange(nq)))
    return o.transpose(1, 0, 2, 3, 4, 5).reshape(B, S, G * HPG, Dh)


def nsa_attention(u, kv, cos, sin, w_in, b_gate, q_gain, w_o):
    k_cmp, v_cmp, k_sel, v_sel, k_win, v_win = kv
    B, S, _ = u.shape
    hd = N_HEADS_B * HEAD_DIM
    proj = u @ w_in
    q = rmsnorm(proj[..., :hd].reshape(B, S, N_HEADS_B, HEAD_DIM), q_gain)
    gates = jax.nn.sigmoid(proj[..., hd:] + b_gate).reshape(B, S, N_HEADS_B, 3)
    q_rot = apply_rope(q, cos, sin).reshape(B, S, N_KV_GROUPS_B, HEADS_PER_GROUP, HEAD_DIM)
    q_plain = q.reshape(B, S, N_KV_GROUPS_B, HEADS_PER_GROUP, HEAD_DIM)
    t_pos = jnp.arange(S)
    nb = S // CMP_BLOCK
    blk = jnp.arange(nb)
    logits = jnp.einsum('bsghd,bngd->bsghn', q_plain, k_cmp, preferred_element_type=jnp.float32) * HEAD_DIM ** -0.5
    vis = ((blk[None, :] + 1) * CMP_BLOCK - 1 <= t_pos[:, None])[None, :, None, None, :]
    p_cmp = jnp.where(vis, jax.nn.softmax(jnp.where(vis, logits, -1e30), axis=-1), 0.0)
    o_cmp = jnp.einsum('bsghn,bngd->bsghd', p_cmp.astype(v_cmp.dtype), v_cmp).reshape(B, S, N_HEADS_B, HEAD_DIM)
    importance = p_cmp.sum(axis=3)
    cur = t_pos // SEL_BLOCK
    forced = (blk[None, :] == 0) | (blk[None, :] == cur[:, None]) | (blk[None, :] == cur[:, None] - 1)
    future = blk[None, :] > cur[:, None]
    importance = jnp.where(forced[None, :, None, :], FORCE_SCORE,
                           jnp.where(future[None, :, None, :], -FORCE_SCORE, importance))
    n_sel = min(N_SELECT, nb)
    _, sel_idx = lax.top_k(importance, n_sel)
    o_sel = selected_branch(q_rot, k_sel, v_sel, sel_idx)
    o_win = window_branch(q_rot, k_win, v_win)
    o = gates[..., 0:1] * o_cmp + gates[..., 1:2] * o_sel + gates[..., 2:3] * o_win
    return o.reshape(B, S, hd) @ w_o


def moe_ffn(u, w_router, b_router, w_eg, w_eu, w_ed, w_sg, w_su, w_sd):
    B, S, D = u.shape
    T = B * S
    h = u.reshape(T, D)
    scores = jax.nn.sigmoid(jnp.matmul(h, w_router, preferred_element_type=jnp.float32))
    _, top_e = lax.top_k(scores + b_router.astype(jnp.float32), TOP_K)
    top_s = jnp.take_along_axis(scores, top_e, axis=-1)
    top_w = top_s / jnp.sum(top_s, axis=-1, keepdims=True) * ROUTED_SCALE
    n_assign = T * TOP_K
    flat_e = top_e.reshape(-1)
    flat_t = jnp.repeat(jnp.arange(T, dtype=jnp.int32), TOP_K)
    flat_w = top_w.reshape(-1)
    order = jnp.argsort(flat_e)
    se, st, sw = flat_e[order], flat_t[order], flat_w[order]
    counts = jnp.bincount(flat_e, length=N_EXPERTS)
    padded = (counts + MOE_BLOCK - 1) // MOE_BLOCK * MOE_BLOCK
    pad_end = jnp.cumsum(padded)
    pad_start = pad_end - padded
    grp_start = jnp.cumsum(counts) - counts
    dest = pad_start[se] + (jnp.arange(n_assign) - grp_start[se])
    n_blocks = (n_assign + MOE_BLOCK - 1) // MOE_BLOCK + N_EXPERTS
    n_rows = n_blocks * MOE_BLOCK
    row_tok = jnp.zeros((n_rows,), jnp.int32).at[dest].set(st)
    row_w = jnp.zeros((n_rows,), h.dtype).at[dest].set(sw.astype(h.dtype))
    block_e = jnp.minimum(jnp.searchsorted(pad_end, jnp.arange(n_blocks) * MOE_BLOCK, side='right'),
                          N_EXPERTS - 1)

    def expert_block(args):
        tok, e = args
        xb = h[tok]
        return (jax.nn.silu(xb @ w_eg[e]) * (xb @ w_eu[e])) @ w_ed[e]

    y_rows = lax.map(expert_block, (row_tok.reshape(n_blocks, MOE_BLOCK), block_e))
    routed = jax.ops.segment_sum(y_rows.reshape(n_rows, D) * row_w[:, None], row_tok, num_segments=T)
    shared = (jax.nn.silu(h @ w_sg) * (h @ w_su)) @ w_sd
    return (routed + shared).reshape(B, S, D)


def setup_inputs(seed: int = 0) -> dict:
    key = jax.random.key(seed)
    ks = jax.random.split(key, 36)
    D = D_MODEL
    HDA = N_HEADS_A * HEAD_DIM
    HDB = N_HEADS_B * HEAD_DIM
    G = N_KV_GROUPS_B

    def nrm(k, shape, s):
        return jax.random.normal(k, shape, jnp.float32) * s

    positions = (jax.random.randint(ks[2], (BATCH, 1), 0, 4096, dtype=jnp.int32)
                 + jnp.arange(SEQ, dtype=jnp.int32)[None, :])
    return {
        'x': nrm(ks[0], (BATCH, SEQ, D), 1.0),
        'c': nrm(ks[1], (BATCH, D), 1.0),
        'positions': positions,
        'w_ada': nrm(ks[3], (DEPTH, D, 6 * D), 0.5 * D ** -0.5),
        'b_ada': nrm(ks[4], (DEPTH, 6 * D), 0.02),
        'norm_mix': 1.0 + nrm(ks[5], (DEPTH, D), 0.05),
        'norm_ffn': 1.0 + nrm(ks[6], (DEPTH, D), 0.05),
        'w_in_a': nrm(ks[7], (N_A_LAYERS, D, 3 * HDA + N_HEADS_A), D ** -0.5),
        'b_f_a': 3.0 + nrm(ks[8], (N_A_LAYERS, N_HEADS_A), 0.1),
        'qnorm_a': 1.0 + nrm(ks[9], (N_A_LAYERS, HEAD_DIM), 0.05),
        'knorm_a': 1.0 + nrm(ks[10], (N_A_LAYERS, HEAD_DIM), 0.05),
        'w_o_a': nrm(ks[11], (N_A_LAYERS, HDA, D), HDA ** -0.5),
        'norm_kv': 1.0 + nrm(ks[12], (D,), 0.05),
        'w_ada_kv': nrm(ks[13], (D, 2 * D), 0.5 * D ** -0.5),
        'b_ada_kv': nrm(ks[14], (2 * D,), 0.02),
        'w_kv_b': nrm(ks[15], (D, 6 * G * HEAD_DIM), D ** -0.5),
        'pe_cmp_k': nrm(ks[16], (CMP_BLOCK, HEAD_DIM), 0.1),
        'pe_cmp_v': nrm(ks[17], (CMP_BLOCK, HEAD_DIM), 0.1),
        'w_cmp_k1': nrm(ks[18], (CMP_BLOCK * HEAD_DIM, CMP_HIDDEN), (CMP_BLOCK * HEAD_DIM) ** -0.5),
        'w_cmp_k2': nrm(ks[19], (CMP_HIDDEN, HEAD_DIM), CMP_HIDDEN ** -0.5),
        'w_cmp_v1': nrm(ks[20], (CMP_BLOCK * HEAD_DIM, CMP_HIDDEN), (CMP_BLOCK * HEAD_DIM) ** -0.5),
        'w_cmp_v2': nrm(ks[21], (CMP_HIDDEN, HEAD_DIM), CMP_HIDDEN ** -0.5),
        'knorm_b': 1.0 + nrm(ks[22], (3, HEAD_DIM), 0.05),
        'w_in_b': nrm(ks[23], (N_B_LAYERS, D, HDB + 3 * N_HEADS_B), D ** -0.5),
        'b_gate_b': nrm(ks[24], (N_B_LAYERS, 3 * N_HEADS_B), 0.1),
        'qnorm_b': 1.0 + nrm(ks[25], (N_B_LAYERS, HEAD_DIM), 0.05),
        'w_o_b': nrm(ks[26], (N_B_LAYERS, HDB, D), HDB ** -0.5),
        'w_router': nrm(ks[27], (DEPTH, D, N_EXPERTS), D ** -0.5),
        'b_router': nrm(ks[28], (DEPTH, N_EXPERTS), 0.01),
        'w_exp_gate': nrm(ks[29], (DEPTH, N_EXPERTS, D, D_EXPERT), D ** -0.5),
        'w_exp_up': nrm(ks[30], (DEPTH, N_EXPERTS, D, D_EXPERT), D ** -0.5),
        'w_exp_down': nrm(ks[31], (DEPTH, N_EXPERTS, D_EXPERT, D), D_EXPERT ** -0.5),
        'w_sh_gate': nrm(ks[32], (DEPTH, D, D_SHARED), D ** -0.5),
        'w_sh_up': nrm(ks[33], (DEPTH, D, D_SHARED), D ** -0.5),
        'w_sh_down': nrm(ks[34], (DEPTH, D_SHARED, D), D_SHARED ** -0.5),
    }


def reference(x, c, positions, w_ada, b_ada, norm_mix, norm_ffn, w_in_a, b_f_a, qnorm_a, knorm_a,
              w_o_a, norm_kv, w_ada_kv, b_ada_kv, w_kv_b, pe_cmp_k, pe_cmp_v, w_cmp_k1, w_cmp_k2,
              w_cmp_v1, w_cmp_v2, knorm_b, w_in_b, b_gate_b, qnorm_b, w_o_b, w_router, b_router,
              w_exp_gate, w_exp_up, w_exp_down, w_sh_gate, w_sh_up, w_sh_down):
    cos, sin = rope_tables(positions, x.dtype)
    cond = jax.nn.silu(c)
    h = x
    kv = None
    for layer in range(DEPTH):
        ada = cond @ w_ada[layer] + b_ada[layer]
        sh_m, sc_m, g_m, sh_f, sc_f, g_f = jnp.split(ada, 6, axis=-1)
        u = modulate(rmsnorm(h, norm_mix[layer]), sh_m, sc_m)
        if layer < N_A_LAYERS:
            mix = forgetting_attention(u, w_in_a[layer], b_f_a[layer], qnorm_a[layer], knorm_a[layer],
                                       w_o_a[layer])
        else:
            if layer == N_A_LAYERS:
                kv = shared_kv(h, cond, norm_kv, w_ada_kv, b_ada_kv, w_kv_b, pe_cmp_k, pe_cmp_v,
                               w_cmp_k1, w_cmp_k2, w_cmp_v1, w_cmp_v2, knorm_b, cos, sin)
            j = layer - N_A_LAYERS
            mix = nsa_attention(u, kv, cos, sin, w_in_b[j], b_gate_b[j], qnorm_b[j], w_o_b[j])
        h = h + g_m[:, None, :] * mix
        u = modulate(rmsnorm(h, norm_ffn[layer]), sh_f, sc_f)
        h = h + g_f[:, None, :] * moe_ffn(u, w_router[layer], b_router[layer], w_exp_gate[layer],
                                          w_exp_up[layer], w_exp_down[layer], w_sh_gate[layer],
                                          w_sh_up[layer], w_sh_down[layer])
    return h
```

```cpp
#include <hip/hip_runtime.h>
#include <cstdint>
#include <cstdio>

#define LAS __attribute__((address_space(3)))
#define GAS __attribute__((address_space(1)))
typedef unsigned short bf16_t;
typedef short bf16x8 __attribute__((ext_vector_type(8)));
typedef short s16x4 __attribute__((ext_vector_type(4)));
typedef float f32x4 __attribute__((ext_vector_type(4)));
typedef float f32x2 __attribute__((ext_vector_type(2)));
typedef float f32x16 __attribute__((ext_vector_type(16)));
typedef unsigned u32x4 __attribute__((ext_vector_type(4)));
typedef unsigned u32x2 __attribute__((ext_vector_type(2)));
typedef int i32x4 __attribute__((ext_vector_type(4)));

constexpr int DM = 1024, NB = 4, SEQ = 8192, NTOK = NB * SEQ;
constexpr int NH = 16, HD = 64, NG = 4;
constexpr int NEXP = 64, TOPK = 8, DEXP = 256;
constexpr int NCH = 2, CHTOK = NTOK / NCH;
constexpr int CH_ROWS = CHTOK * TOPK + NEXP * 256;
constexpr int NCMPB = SEQ / 64;
constexpr float EPSN = 1e-6f;
constexpr float LOG2E = 1.4426950408889634f;
constexpr float C2 = 0.125f * LOG2E;
constexpr int NWAVES = 8, NTHREADS = 512;
constexpr float YSCALE = 16.f;

enum { I_X = 0, I_C, I_POS, I_WADA, I_BADA, I_NMIX, I_NFFN, I_WINA, I_BFA, I_QNA, I_KNA, I_WOA, I_NKV, I_WADAKV, I_BADAKV, I_WKVB, I_PEK, I_PEV,
       I_WCK1, I_WCK2, I_WCV1, I_WCV2, I_KNB, I_WINB, I_BGB, I_QNB, I_WOB, I_WR, I_BR, I_WEG, I_WEU, I_WED, I_WSG, I_WSU, I_WSD, N_IN };

constexpr size_t MiB = 1u << 20;
constexpr size_t WS_CTL = 0, CTL_ZERO_BYTES = 1 * MiB;
constexpr size_t WS_ADA = 1 * MiB;
constexpr size_t WS_ADAKV = WS_ADA + 2 * 4 * 6144 * 4;
constexpr size_t WS_MF = WS_ADAKV + 4 * 2048 * 4;
constexpr size_t WS_ROPE = 2 * MiB;
constexpr size_t WS_LOGF = 4 * MiB;
constexpr size_t WS_CUM = 6 * MiB;
constexpr size_t WS_GATES = 8 * MiB;
constexpr size_t WS_TOKE = 14 * MiB;
constexpr size_t WS_TOKP = 15 * MiB;
constexpr size_t WS_ROWTOK = 16 * MiB;
constexpr size_t WS_ROWW = 24 * MiB;
constexpr size_t WS_KCMP = 32 * MiB;
constexpr size_t WS_VCMP = WS_KCMP + 512 * 1024;
constexpr size_t WS_WB = 33 * MiB;
constexpr size_t WS_WQKV = WS_WB;
constexpr size_t WS_WOA = WS_WQKV + 6 * MiB;
constexpr size_t WS_WKV = WS_WOA + 2 * MiB;
constexpr size_t WS_WQB = WS_WKV + 3 * MiB;
constexpr size_t WS_WOB = WS_WQB + 2 * MiB;
constexpr size_t WS_WC1K = WS_WOB + 2 * MiB;
constexpr size_t WS_WC1V = WS_WC1K + 2 * MiB;
constexpr size_t WS_WSGU = WS_WC1V + 2 * MiB;
constexpr size_t WS_WSD = WS_WSGU + 2 * MiB;
constexpr size_t WS_WEGU = WS_WSD + 1 * MiB;
constexpr size_t WS_WED = WS_WEGU + 64 * MiB;
constexpr size_t WS_U = WS_WED + 32 * MiB;
constexpr size_t WS_D = WS_U + 64 * MiB;
constexpr size_t WS_Q = WS_D, WS_K = WS_D + 64 * MiB, WS_V = WS_D + 128 * MiB, WS_O = WS_D + 192 * MiB;
constexpr size_t WS_ACT = WS_D;
constexpr size_t WS_ACTS = WS_D + 72 * MiB;
constexpr size_t WS_ACTS1 = WS_D + 224 * MiB;
constexpr size_t WS_Y = WS_D + 80 * MiB;
constexpr size_t WS_SKV = WS_D;
constexpr size_t WS_QP = WS_D + 64 * MiB, WS_QR = WS_D + 128 * MiB;
constexpr size_t WS_KSEL = WS_D + 192 * MiB, WS_VSEL = WS_KSEL + 16 * MiB, WS_KWIN = WS_VSEL + 16 * MiB, WS_VWIN = WS_KWIN + 16 * MiB;
constexpr size_t WS_ACK = WS_D + 256 * MiB, WS_ACV = WS_ACK + 16 * MiB;
constexpr size_t WS_SLAB = WS_D + 288 * MiB;
constexpr size_t WS_ONSA = WS_U;
constexpr size_t WS_END = WS_D + 368 * MiB;
static_assert((size_t)CH_ROWS * 512 <= 72 * MiB && (size_t)CH_ROWS * 2048 <= 288 * MiB, "moe chunk buffers");
static_assert(WS_END <= 612 * MiB, "workspace");

constexpr int CW_TMO = 0;
constexpr int CW_CNT = 1024;
constexpr int CW_BAR = 4096;

constexpr int RING_BYTES = 131072;
constexpr int MISC_OFF = 143360;
constexpr int LDS_BYTES = 147456;

__device__ __forceinline__ unsigned f2bf(float f) { unsigned u = __builtin_bit_cast(unsigned, f); return (u + 0x7fffu + ((u >> 16) & 1u)) >> 16; }
__device__ __forceinline__ unsigned pk2(float lo, float hi) { return f2bf(lo) | (f2bf(hi) << 16); }
__device__ __forceinline__ float bf2f(unsigned short v) { return __builtin_bit_cast(float, (unsigned)v << 16); }
__device__ __forceinline__ unsigned cvt_pk_bf16(float lo, float hi) { unsigned r; asm("v_cvt_pk_bf16_f32 %0, %1, %2" : "=v"(r) : "v"(lo), "v"(hi)); return r; }
__device__ __forceinline__ float wave_sum(float v) {
#pragma unroll
    for (int o = 1; o < 64; o <<= 1) v += __shfl_xor(v, o);
    return v;
}
__device__ __forceinline__ int crow(int r, int hi) { return (r & 3) + 8 * (r >> 2) + 4 * hi; }
__device__ __forceinline__ float sigmoidf_(float x) { return 1.f / (1.f + __expf(-x)); }
__device__ __forceinline__ float siluf_(float x) { return x / (1.f + __expf(-x)); }
__device__ __forceinline__ float siluf_fast(float x) { return x * __builtin_amdgcn_rcpf(1.f + __expf(-x)); }
#define LDS_WAIT() asm volatile("s_waitcnt lgkmcnt(0)" ::: "memory")
#define VM_WAIT() asm volatile("s_waitcnt vmcnt(0)" ::: "memory")
namespace pg8 {
constexpr int BM = 256, BK = 64, HALF = 128, HTB = HALF * BK * 2, STAGE_BYTES = 8 * HTB;
__device__ __forceinline__ int lds_byte(int r, int c) { const int st = (r >> 4) * 2 + (c >> 5), rr = r & 15, cc = c & 31, ob = rr * 64 + cc * 2; return st * 1024 + (ob ^ (((ob >> 9) & 1) << 5)); }
__device__ __forceinline__ void stage_rc(int b, int& R, int& C) { const int st = b / 1024, sb = b % 1024, swz = sb ^ (((sb >> 9) & 1) << 5); R = (st >> 1) * 16 + swz / 64; C = (st & 1) * 32 + (swz % 64) / 2; }
__device__ __forceinline__ int perm32(int rho) { const int n = rho >> 4, i = rho & 15; return 8 * (i >> 2) + 4 * n + (i & 3); }

struct Unit { int pm, pn, aux; };
struct Gemm { const bf16_t* A; int lda; int ldb; int K; };

template <class Epi, class Sched>
__device__ __forceinline__ void gemm_phase(LAS unsigned char* lds, const Gemm g, const Sched& S, const Epi& E) {
    int tid_ = threadIdx.x; asm volatile("" : "+v"(tid_));
    const int tid = tid_, wid = __builtin_amdgcn_readfirstlane(tid >> 6), lane = tid & 63, wr = wid >> 2, wc = wid & 3, fr = lane & 15, fq = lane >> 4;
    const int nt = g.K / BK;
    int RA[2], CA[2]; unsigned voffB[2];
#pragma unroll
    for (int i = 0; i < 2; ++i) { int R, C; stage_rc(tid * 16 + i * 8192, R, C); RA[i] = R; CA[i] = C;
        if constexpr (Sched::BCH) { const int b = tid * 16 + i * 8192, st = b >> 10, sb = b & 1023; R = (st >> 1) * 16 + ((sb & 255) >> 4); C = (st & 1) * 32 + (sb >> 8) * 8; }
        const int Rb = (R & ~31) + perm32(R & 31); voffB[i] = Sched::BCH ? (unsigned)((C >> 3) * g.ldb + Rb) * 16u : (unsigned)(Rb * g.ldb + C) * 2u; }
    const size_t hstepB = Sched::BCH ? (size_t)HALF * 16 : (size_t)HALF * g.ldb * 2;
    const unsigned ldsw = (unsigned)wid * 1024u;
    const int aoff = lds_byte(wr * 64 + fr, fq * 8), boff = Sched::BCH ? wc * 4096 + fq * 256 + fr * 16 : lds_byte(wc * 32 + fr, fq * 8);
#define PG8_SA(b, h) (((b) * 2 + (h)) * HTB)
#define PG8_SB(b, h) ((4 + (b) * 2 + (h)) * HTB)
#define PG8_STAGEB(bufoff, gbase) do { _Pragma("unroll") for (int _i = 0; _i < 2; ++_i) \
        __builtin_amdgcn_global_load_lds((const unsigned*)((const char*)(gbase) + voffB[_i]), (LAS unsigned*)(lds + (bufoff) + ldsw + _i * 8192), 16, 0, 0); } while (0)
#define PG8_STAGEA(bufoff, o0, o1, kb) do { \
        __builtin_amdgcn_global_load_lds((const unsigned*)((const char*)g.A + (size_t)(o0) + (size_t)(kb)), (LAS unsigned*)(lds + (bufoff) + ldsw), 16, 0, 0); \
        __builtin_amdgcn_global_load_lds((const unsigned*)((const char*)g.A + (size_t)(o1) + (size_t)(kb)), (LAS unsigned*)(lds + (bufoff) + ldsw + 8192), 16, 0, 0); } while (0)
#define PG8_LDA(dst, b, h) do { _Pragma("unroll") for (int m = 0; m < 4; ++m) _Pragma("unroll") for (int k = 0; k < 2; ++k) dst[m][k] = *(const LAS bf16x8*)(lds + PG8_SA(b, h) + aoff + m * 2048 + k * 1024); } while (0)
#define PG8_LDB(dst, b, h) do { _Pragma("unroll") for (int n = 0; n < 2; ++n) _Pragma("unroll") for (int k = 0; k < 2; ++k) dst[n][k] = *(const LAS bf16x8*)(lds + PG8_SB(b, h) + boff + n * 2048 + k * 1024); } while (0)
#define PG8_MMA(ai, bj, At, Bt) do { __builtin_amdgcn_s_setprio(1); _Pragma("unroll") for (int m = 0; m < 4; ++m) _Pragma("unroll") for (int n = 0; n < 2; ++n) _Pragma("unroll") for (int k = 0; k < 2; ++k) \
        acc[ai][bj][m][n] = __builtin_amdgcn_mfma_f32_16x16x32_bf16(Bt[n][k], At[m][k], acc[ai][bj][m][n], 0, 0, 0); __builtin_amdgcn_s_setprio(0); } while (0)
#define PG8_WAIT_V(n) asm volatile("s_waitcnt vmcnt(" #n ")" ::: "memory")
#define PG8_WAIT_L(n) asm volatile("s_waitcnt lgkmcnt(" #n ")" ::: "memory")
#define PG8_BAR __builtin_amdgcn_s_barrier()
#define PG8_SCHED __builtin_amdgcn_sched_barrier(0)
    Unit cur, nxt; int ui = 0;
    if (!S.next(0, cur)) return;
    f32x4 acc[2][2][4][2];
#pragma unroll
    for (int a = 0; a < 2; ++a)
#pragma unroll
        for (int b = 0; b < 2; ++b)
#pragma unroll
            for (int m = 0; m < 4; ++m)
#pragma unroll
                for (int n = 0; n < 2; ++n) acc[a][b][m][n] = (f32x4){0.f, 0.f, 0.f, 0.f};
    bf16x8 At[4][2], B0[2][2], B1[2][2];
    float pf[Epi::NPF > 0 ? Epi::NPF : 1];
    if constexpr (Epi::NPF > 0) E.pre(cur, wr, fr, pf);
    unsigned c00 = 0, c01 = 0, c10 = 0, c11 = 0, n00 = 0, n01 = 0, n10 = 0, n11 = 0;
    size_t cAu = 0, nAu = 0; const size_t hstepA = (size_t)HALF * g.lda * 2;
    if constexpr (Sched::GATHER) {
        c00 = S.a_off(cur, RA[0]) + CA[0] * 2u; c01 = S.a_off(cur, RA[1]) + CA[1] * 2u; c10 = S.a_off(cur, HALF + RA[0]) + CA[0] * 2u; c11 = S.a_off(cur, HALF + RA[1]) + CA[1] * 2u;
    } else {
        c00 = c10 = (unsigned)(RA[0] * g.lda + CA[0]) * 2u; c01 = c11 = (unsigned)(RA[1] * g.lda + CA[1]) * 2u; cAu = S.a_base(cur);
    }
#define PG8_STAGEA_H(bufoff, h, kb) do { if constexpr (Sched::GATHER) { if ((h) == 0) PG8_STAGEA(bufoff, c00, c01, kb); else PG8_STAGEA(bufoff, c10, c11, kb); } \
        else { PG8_STAGEA(bufoff, c00, c01, cAu + (h) * hstepA + (kb)); } } while (0)
    const char* cB = S.b_ptr(cur);
    const unsigned kstep = BK * 2;
    const unsigned kstepB = Sched::BCH ? (unsigned)g.ldb * 128u : kstep;
    PG8_STAGEB(PG8_SB(0, 0), cB); PG8_STAGEB(PG8_SB(0, 1), cB + hstepB); PG8_STAGEA_H(PG8_SA(0, 0), 0, 0); PG8_STAGEA_H(PG8_SA(0, 1), 1, 0);
    if (wr == 1) PG8_BAR;
    PG8_WAIT_V(2); PG8_BAR;
    PG8_STAGEB(PG8_SB(1, 0), cB + kstepB); PG8_STAGEA_H(PG8_SA(1, 0), 0, kstep); PG8_STAGEB(PG8_SB(1, 1), cB + hstepB + kstepB);
    PG8_WAIT_V(6); PG8_BAR;
    for (;;) {
        const bool has_next = S.next(ui + 1, nxt);
        const char* nB = cB; nAu = cAu;
        if constexpr (Sched::GATHER) { n00 = c00; n01 = c01; n10 = c10; n11 = c11; }
        if (has_next) { nB = S.b_ptr(nxt);
            if constexpr (Sched::GATHER) { n00 = S.a_off(nxt, RA[0]) + CA[0] * 2u; n01 = S.a_off(nxt, RA[1]) + CA[1] * 2u; n10 = S.a_off(nxt, HALF + RA[0]) + CA[0] * 2u; n11 = S.a_off(nxt, HALF + RA[1]) + CA[1] * 2u; }
            else nAu = S.a_base(nxt); }
#pragma unroll 1
        for (int t = 0; t < nt; t += 2) {
            const bool last = (t == nt - 2);
            const unsigned k1 = (unsigned)(t + 1) * kstep;
            const unsigned k2 = last ? 0u : (unsigned)(t + 2) * kstep, k3 = k2 + kstep;
            const unsigned k2B = Sched::BCH ? (last ? 0u : (unsigned)(t + 2) * kstepB) : k2;
            const char* bb = last ? nB : cB; const char* b2 = bb + k2B; const char* b3 = b2 + kstepB;
            PG8_LDB(B0, 0, 0); PG8_LDB(B1, 0, 1); PG8_SCHED; PG8_LDA(At, 0, 0); PG8_STAGEA_H(PG8_SA(1, 1), 1, k1);
            if (last) { if constexpr (Sched::GATHER) { c00 = n00; c01 = n01; c10 = n10; c11 = n11; } else cAu = nAu; }
            PG8_WAIT_V(8); PG8_WAIT_L(0); PG8_BAR; PG8_MMA(0, 0, At, B0); PG8_MMA(0, 1, At, B1); PG8_BAR; PG8_SCHED;
            PG8_LDA(At, 0, 1); PG8_STAGEB(PG8_SB(0, 0), b2); PG8_STAGEB(PG8_SB(0, 1), b2 + hstepB); PG8_STAGEA_H(PG8_SA(0, 0), 0, k2);
            PG8_WAIT_V(8); PG8_WAIT_L(0); PG8_BAR; PG8_MMA(1, 0, At, B0); PG8_MMA(1, 1, At, B1); PG8_BAR; PG8_SCHED;
            PG8_LDB(B0, 1, 0); PG8_LDB(B1, 1, 1); PG8_SCHED; PG8_LDA(At, 1, 0); PG8_STAGEA_H(PG8_SA(0, 1), 1, k2);
            PG8_WAIT_V(8); PG8_WAIT_L(0); PG8_BAR; PG8_MMA(0, 0, At, B0); PG8_MMA(0, 1, At, B1); PG8_BAR; PG8_SCHED;
            PG8_LDA(At, 1, 1); PG8_STAGEB(PG8_SB(1, 0), b3); PG8_STAGEB(PG8_SB(1, 1), b3 + hstepB); PG8_STAGEA_H(PG8_SA(1, 0), 0, k3);
            PG8_WAIT_V(8); PG8_WAIT_L(0); PG8_BAR; PG8_MMA(1, 0, At, B0); PG8_MMA(1, 1, At, B1); PG8_BAR; PG8_SCHED;
        }
        if (wr == 0) PG8_BAR;
        if constexpr (Epi::NPF > 0) E(acc, cur, wr, wc, fr, fq, pf); else E(acc, cur, wr, wc, fr, fq);
        if (!has_next) break;
#pragma unroll
        for (int a = 0; a < 2; ++a)
#pragma unroll
            for (int b = 0; b < 2; ++b)
#pragma unroll
                for (int m = 0; m < 4; ++m)
#pragma unroll
                    for (int n = 0; n < 2; ++n) acc[a][b][m][n] = (f32x4){0.f, 0.f, 0.f, 0.f};
        cur = nxt; cB = nB; ++ui;
        if constexpr (Epi::NPF > 0) E.pre(cur, wr, fr, pf);
        if (wr == 1) PG8_BAR;
    }
    PG8_WAIT_V(0);
    PG8_BAR;
#undef PG8_SA
#undef PG8_SB
#undef PG8_STAGEA
#undef PG8_STAGEA_H
#undef PG8_STAGEB
#undef PG8_LDA
#undef PG8_LDB
#undef PG8_MMA
#undef PG8_WAIT_V
#undef PG8_WAIT_L
#undef PG8_BAR
#undef PG8_SCHED
}

struct DenseSched {
    static constexpr bool GATHER = false, BCH = false;
    const bf16_t* Bt; int lda, ldb; int nM, nN, nwg, G, c; int rowbase;
    __device__ void init(const bf16_t* Bt_, int lda_, int ldb_, int M, int N, int G_, int c_, int rowbase_ = 0) { Bt = Bt_; lda = lda_; ldb = ldb_; nM = M / BM; nN = N / BM; nwg = nM * nN; G = G_; c = c_; rowbase = rowbase_; }
    __device__ __forceinline__ bool next(int i, Unit& u) const {
        const long L = (long)i * G + c; if (L >= nwg) return false;
        int wgid = (int)L; { const int q = nwg / 8, r = nwg % 8, xcd = wgid % 8, off = wgid / 8; wgid = (xcd < r ? xcd * (q + 1) : r * (q + 1) + (xcd - r) * q) + off; }
        const int nig = 8 * nN, gid = wgid / nig, fm = gid * 8, gsz = (nM - fm) < 8 ? (nM - fm) : 8;
        u.pm = fm + ((wgid % nig) % gsz); u.pn = (wgid % nig) / gsz; u.aux = 0; return true;
    }
    __device__ __forceinline__ size_t a_base(const Unit& u) const { return (size_t)(rowbase + u.pm * BM) * (size_t)lda * 2u; }
    __device__ __forceinline__ unsigned a_off(const Unit&, int) const { return 0u; }
    __device__ __forceinline__ const char* b_ptr(const Unit& u) const { return (const char*)(Bt + (size_t)u.pn * BM * ldb); }
};
struct SplitKSched {
    static constexpr bool GATHER = false, BCH = false;
    const bf16_t* Bt; int lda, ldb, Kc; int nM, nS, nwg, G, c;
    __device__ void init(const bf16_t* Bt_, int lda_, int ldb_, int Kc_, int M, int nS_, int G_, int c_) { Bt = Bt_; lda = lda_; ldb = ldb_; Kc = Kc_; nM = M / BM; nS = nS_; nwg = nM * nS; G = G_; c = c_; }
    __device__ __forceinline__ bool next(int i, Unit& u) const { const int L = i * G + c; if (L >= nwg) return false; u.pm = L % nM; u.aux = L / nM; u.pn = 0; return true; }
    __device__ __forceinline__ size_t a_base(const Unit& u) const { return ((size_t)(u.pm * BM) * (size_t)lda + (size_t)(u.aux * Kc)) * 2u; }
    __device__ __forceinline__ unsigned a_off(const Unit&, int) const { return 0u; }
    __device__ __forceinline__ const char* b_ptr(const Unit& u) const { return (const char*)(Bt + (size_t)u.aux * Kc); }
};
struct MoeTab { const LAS int* tstart; const LAS int* cnt; const LAS unsigned char* tile_e; int ntiles; };
struct MoeGatherSched {
    static constexpr bool GATHER = true, BCH = true;
    __device__ __forceinline__ size_t a_base(const Unit&) const { return 0; }
    MoeTab T; const bf16_t* Bt; const bf16_t* Bsh; const int* rowtok; int nN, G, c; int ldb; size_t bstride; int tokbase;
    __device__ __forceinline__ bool next(int i, Unit& u) const {
        if ((G & 7) == 0) { const int x = c & 7, j = i * (G >> 3) + (c >> 3); const int ts = (T.ntiles * x) >> 3, te = (T.ntiles * (x + 1)) >> 3; const int tile = ts + j / nN; if (tile >= te) return false; u.pm = tile; u.pn = j % nN; }
        else { const int L = i * G + c; if (L >= T.ntiles * nN) return false; u.pm = L / nN; u.pn = L % nN; }
        u.aux = T.tile_e[u.pm]; return true; }
    __device__ __forceinline__ unsigned a_off(const Unit& u, int row) const {
        const int e = u.aux; int lr = (u.pm - T.tstart[e]) * BM + row; const int cn = T.cnt[e]; lr = lr < cn ? lr : cn - 1;
        const int tok = (e == NEXP) ? tokbase + lr : rowtok[(size_t)e * CHTOK + lr]; return (unsigned)tok * (unsigned)(DM * 2); }
    __device__ __forceinline__ const char* b_ptr(const Unit& u) const { return (const char*)((u.aux == NEXP ? Bsh : Bt + (size_t)u.aux * bstride) + (size_t)u.pn * BM * 8); }
};
struct MoeDownSched {
    static constexpr bool GATHER = false, BCH = true;
    MoeTab T; const bf16_t* Bt; int nN, G, c; int lda, ldb; size_t bstride;
    __device__ __forceinline__ bool next(int i, Unit& u) const {
        if ((G & 7) == 0) { const int x = c & 7, j = i * (G >> 3) + (c >> 3); const int ts = (T.ntiles * x) >> 3, te = (T.ntiles * (x + 1)) >> 3; const int tile = ts + j / nN; if (tile >= te) return false; u.pm = tile; u.pn = j % nN; }
        else { const int L = i * G + c; if (L >= T.ntiles * nN) return false; u.pm = L / nN; u.pn = L % nN; }
        u.aux = T.tile_e[u.pm]; return true; }
    __device__ __forceinline__ size_t a_base(const Unit& u) const { return (size_t)(u.pm * BM) * (size_t)lda * 2u; }
    __device__ __forceinline__ unsigned a_off(const Unit&, int) const { return 0u; }
    __device__ __forceinline__ const char* b_ptr(const Unit& u) const { return (const char*)(Bt + (size_t)u.aux * bstride + (size_t)u.pn * BM * 8); }
};
}
namespace pg8 {
template <class T> __device__ __forceinline__ T* at(const void* base, unsigned byteoff) { return (T*)((const char*)base + (size_t)byteoff); }

struct EpiQKV {
    static constexpr int NPF = 0;
    static constexpr int NTRAIL = 0;
    bf16_t* Q; size_t kvstride; const float* qg; const float* kg;
    __device__ __forceinline__ void operator()(const f32x4 (&acc)[2][2][4][2], const Unit& u, int wr, int wc, int fr, int fq) const {
        const int kind = u.pn >> 2;
        bf16_t* base = Q + (size_t)kind * kvstride;
        const float* gn = kind == 0 ? qg : kg;
        const float osc = kind == 0 ? C2 : 1.f;
        f32x4 gv[2][2];
#pragma unroll
        for (int bj = 0; bj < 2; ++bj)
#pragma unroll
            for (int n = 0; n < 2; ++n) gv[bj][n] = *(const f32x4*)(gn + 32 * bj + 8 * fq + 4 * n);
        const int colbase = (u.pn & 3) * 256 + wc * 64 + 8 * fq;
#pragma unroll
        for (int ai = 0; ai < 2; ++ai)
#pragma unroll
            for (int m = 0; m < 4; ++m) {
                const int row = u.pm * BM + ai * HALF + wr * 64 + m * 16 + fr;
                float rs = 1.f;
                if (kind < 2) {
                    float ss = 0.f;
#pragma unroll
                    for (int bj = 0; bj < 2; ++bj)
#pragma unroll
                        for (int n = 0; n < 2; ++n) { const f32x4 x = acc[ai][bj][m][n]; ss += (x[0] * x[0] + x[1] * x[1]) + (x[2] * x[2] + x[3] * x[3]); }
                    ss += __shfl_xor(ss, 16); ss += __shfl_xor(ss, 32);
                    rs = rsqrtf(ss * (1.f / 64.f) + EPSN) * osc;
                }
                const unsigned ro = (unsigned)(row * DM + colbase) * 2u;
#pragma unroll
                for (int bj = 0; bj < 2; ++bj) {
                    f32x4 v0 = acc[ai][bj][m][0], v1 = acc[ai][bj][m][1];
                    if (kind < 2) { v0 = v0 * gv[bj][0] * rs; v1 = v1 * gv[bj][1] * rs; }
                    u32x4 w; w.x = cvt_pk_bf16(v0[0], v0[1]); w.y = cvt_pk_bf16(v0[2], v0[3]); w.z = cvt_pk_bf16(v1[0], v1[1]); w.w = cvt_pk_bf16(v1[2], v1[3]);
                    *at<u32x4>(base, ro + 64 * bj) = w;
                }
            }
    }
};

struct EpiResid {
    static constexpr int NPF = 0;
    static constexpr int NTRAIL = 0;
    const float* base; float* out; const float* gate;
    __device__ __forceinline__ void operator()(const f32x4 (&acc)[2][2][4][2], const Unit& u, int wr, int wc, int fr, int fq) const {
        const int col0 = u.pn * BM + wc * 32 + 8 * fq;
        const int b = (u.pm * BM) / SEQ;
        f32x4 gv[2][2];
#pragma unroll
        for (int bj = 0; bj < 2; ++bj)
#pragma unroll
            for (int n = 0; n < 2; ++n) gv[bj][n] = *(const f32x4*)(gate + (size_t)b * 6144 + col0 + bj * HALF + 4 * n);
#pragma unroll
        for (int ai = 0; ai < 2; ++ai) {
            f32x4 bv[4][2][2];
#pragma unroll
            for (int m = 0; m < 4; ++m) { const unsigned ro = (unsigned)((u.pm * BM + ai * HALF + wr * 64 + m * 16 + fr) * DM + col0) * 4u;
#pragma unroll
                for (int bj = 0; bj < 2; ++bj)
#pragma unroll
                    for (int n = 0; n < 2; ++n) bv[m][bj][n] = *at<const f32x4>(base, ro + (bj * HALF + 4 * n) * 4); }
#pragma unroll
            for (int m = 0; m < 4; ++m) { const unsigned ro = (unsigned)((u.pm * BM + ai * HALF + wr * 64 + m * 16 + fr) * DM + col0) * 4u;
#pragma unroll
                for (int bj = 0; bj < 2; ++bj)
#pragma unroll
                    for (int n = 0; n < 2; ++n) *at<f32x4>(out, ro + (bj * HALF + 4 * n) * 4) = bv[m][bj][n] + gv[bj][n] * acc[ai][bj][m][n]; }
        }
    }
};

struct EpiKV {
    static constexpr int NPF = 0;
    static constexpr int NTRAIL = 0;
    bf16_t *ack, *ksel; size_t acstride, kvstride; const float* pek;
    const float* pev; const float* kgain; const float* rope;
    LAS unsigned char* lds;
    __device__ __forceinline__ void operator()(const f32x4 (&acc)[2][2][4][2], const Unit& u, int wr, int wc, int fr, int fq) const {
        const int kind = u.pn, g = wc;
        const bool donorm = (kind == 2 || kind == 4);
        const float* gn = kgain + (kind == 2 ? 64 : 128);
        f32x4 gv[2][2];
#pragma unroll
        for (int bj = 0; bj < 2; ++bj)
#pragma unroll
            for (int n = 0; n < 2; ++n) gv[bj][n] = donorm ? *(const f32x4*)(gn + 32 * bj + 8 * fq + 4 * n) : (f32x4){1.f, 1.f, 1.f, 1.f};
#pragma unroll
        for (int ai = 0; ai < 2; ++ai)
#pragma unroll
            for (int m = 0; m < 4; ++m) {
                const int row = u.pm * BM + ai * HALF + wr * 64 + m * 16 + fr;
                f32x4 v[2][2];
#pragma unroll
                for (int bj = 0; bj < 2; ++bj)
#pragma unroll
                    for (int n = 0; n < 2; ++n) v[bj][n] = acc[ai][bj][m][n];
                if (kind < 2) {
                    const int b = row / SEQ, s = row % SEQ, nb = s >> 6, pos = s & 63;
                    const float* pe = (kind == 0 ? pek : pev) + pos * 64;
                    bf16_t* dbase = ack + (size_t)kind * acstride; const unsigned dofs = (unsigned)(((b * NCMPB + nb) * NG + g) * 4096 + pos * 64 + 8 * fq) * 2u;
#pragma unroll
                    for (int bj = 0; bj < 2; ++bj) {
                        const f32x4 p0 = *(const f32x4*)(pe + 32 * bj + 8 * fq), p1 = *(const f32x4*)(pe + 32 * bj + 8 * fq + 4);
                        const f32x4 v0 = v[bj][0] + p0, v1 = v[bj][1] + p1;
                        u32x4 w; w.x = cvt_pk_bf16(v0[0], v0[1]); w.y = cvt_pk_bf16(v0[2], v0[3]); w.z = cvt_pk_bf16(v1[0], v1[1]); w.w = cvt_pk_bf16(v1[2], v1[3]);
                        *at<u32x4>(dbase, dofs + 64 * bj) = w;
                    }
                } else {
                    if (donorm) {
                        float ss = 0.f;
#pragma unroll
                        for (int bj = 0; bj < 2; ++bj)
#pragma unroll
                            for (int n = 0; n < 2; ++n) { const f32x4 x = v[bj][n]; ss += (x[0] * x[0] + x[1] * x[1]) + (x[2] * x[2] + x[3] * x[3]); }
                        ss += __shfl_xor(ss, 16); ss += __shfl_xor(ss, 32);
                        const float rs = rsqrtf(ss * (1.f / 64.f) + EPSN);
#pragma unroll
                        for (int bj = 0; bj < 2; ++bj)
#pragma unroll
                            for (int n = 0; n < 2; ++n) v[bj][n] = v[bj][n] * gv[bj][n] * rs;
#pragma unroll
                        for (int n = 0; n < 2; ++n) {
                            const f32x4 cs = *(const f32x4*)(rope + (size_t)row * 16 + 4 * n), sn = *(const f32x4*)(rope + (size_t)row * 16 + 8 + 4 * n);
                            f32x4 mine = v[0][n], oth;
#pragma unroll
                            for (int j = 0; j < 4; ++j) oth[j] = __shfl_xor(mine[j], 16);
                            const f32x4 r0 = mine * cs - oth * sn, r1 = mine * cs + oth * sn;
                            if (fq == 0) v[0][n] = r0; else if (fq == 1) v[0][n] = r1;
                        }
                    }
                    bf16_t* dbase = ksel + (size_t)(kind - 2) * kvstride;
                    const unsigned blk = (unsigned)(((row >> 6) * NG + g) * 4096), key = (unsigned)(row & 63);
                    if (kind == 2) {
#pragma unroll
                        for (int bj = 0; bj < 2; ++bj) {
                            const f32x4 v0 = v[bj][0], v1 = v[bj][1];
                            u32x4 w; w.x = cvt_pk_bf16(v0[0], v0[1]); w.y = cvt_pk_bf16(v0[2], v0[3]); w.z = cvt_pk_bf16(v1[0], v1[1]); w.w = cvt_pk_bf16(v1[2], v1[3]);
                            *at<u32x4>(dbase, (blk + ((unsigned)(4 * bj + fq) * 64u + key) * 8u) * 2u) = w;
                        }
                    } else if (kind == 3) {
                        LAS unsigned char* stv = lds + 131072 + (wr * 4 + wc) * 1024;
                        const unsigned ks = key >> 4;
                        const int ln = fq * 16 + fr, dd_ = ln & 31, hh = ln >> 5;
#pragma unroll
                        for (int bj = 0; bj < 2; ++bj) {
                            const f32x4 v0 = v[bj][0], v1 = v[bj][1];
                            u32x4 w; w.x = cvt_pk_bf16(v0[0], v0[1]); w.y = cvt_pk_bf16(v0[2], v0[3]); w.z = cvt_pk_bf16(v1[0], v1[1]); w.w = cvt_pk_bf16(v1[2], v1[3]);
                            *(LAS u32x4*)(stv + fr * 64 + fq * 16) = w;
                            unsigned e8[8];
#pragma unroll
                            for (int j = 0; j < 8; ++j) e8[j] = *(const LAS unsigned short*)(stv + ((j & 3) + 8 * (j >> 2) + 4 * hh) * 64 + dd_ * 2);
                            u32x4 o; o.x = e8[0] | (e8[1] << 16); o.y = e8[2] | (e8[3] << 16); o.z = e8[4] | (e8[5] << 16); o.w = e8[6] | (e8[7] << 16);
                            *at<u32x4>(dbase, (blk + ((((ks * 2u + (unsigned)bj) * 2u + (unsigned)hh) * 32u + (unsigned)dd_) * 8u)) * 2u) = o;
                        }
                    } else {
                        const unsigned dofs = (unsigned)(row * 256 + g * 64 + 8 * fq) * 2u;
#pragma unroll
                        for (int bj = 0; bj < 2; ++bj) {
                            const f32x4 v0 = v[bj][0], v1 = v[bj][1];
                            u32x4 w; w.x = cvt_pk_bf16(v0[0], v0[1]); w.y = cvt_pk_bf16(v0[2], v0[3]); w.z = cvt_pk_bf16(v1[0], v1[1]); w.w = cvt_pk_bf16(v1[2], v1[3]);
                            *at<u32x4>(dbase, dofs + 64 * bj) = w;
                        }
                    }
                }
            }
    }
};

struct EpiQB {
    static constexpr int NPF = 0;
    static constexpr int NTRAIL = 0;
    bf16_t *qp, *qr; const float* qgain; const float* rope;
    __device__ __forceinline__ void operator()(const f32x4 (&acc)[2][2][4][2], const Unit& u, int wr, int wc, int fr, int fq) const {
        f32x4 gv[2][2];
#pragma unroll
        for (int bj = 0; bj < 2; ++bj)
#pragma unroll
            for (int n = 0; n < 2; ++n) gv[bj][n] = *(const f32x4*)(qgain + 32 * bj + 8 * fq + 4 * n);
        const int colbase = u.pn * 256 + wc * 64 + 8 * fq;
#pragma unroll
        for (int ai = 0; ai < 2; ++ai)
#pragma unroll
            for (int m = 0; m < 4; ++m) {
                const int row = u.pm * BM + ai * HALF + wr * 64 + m * 16 + fr;
                f32x4 v[2][2]; float ss = 0.f;
#pragma unroll
                for (int bj = 0; bj < 2; ++bj)
#pragma unroll
                    for (int n = 0; n < 2; ++n) { const f32x4 x = acc[ai][bj][m][n]; v[bj][n] = x; ss += (x[0] * x[0] + x[1] * x[1]) + (x[2] * x[2] + x[3] * x[3]); }
                ss += __shfl_xor(ss, 16); ss += __shfl_xor(ss, 32);
                const float rs = rsqrtf(ss * (1.f / 64.f) + EPSN) * C2;
#pragma unroll
                for (int bj = 0; bj < 2; ++bj)
#pragma unroll
                    for (int n = 0; n < 2; ++n) v[bj][n] = v[bj][n] * gv[bj][n] * rs;
                const unsigned ro = (unsigned)(row * DM + colbase) * 2u;
#pragma unroll
                for (int bj = 0; bj < 2; ++bj) {
                    const f32x4 v0 = v[bj][0], v1 = v[bj][1];
                    u32x4 w; w.x = cvt_pk_bf16(v0[0], v0[1]); w.y = cvt_pk_bf16(v0[2], v0[3]); w.z = cvt_pk_bf16(v1[0], v1[1]); w.w = cvt_pk_bf16(v1[2], v1[3]);
                    *at<u32x4>(qp, ro + 64 * bj) = w;
                }
#pragma unroll
                for (int n = 0; n < 2; ++n) {
                    const f32x4 cs = *(const f32x4*)(rope + (size_t)row * 16 + 4 * n), sn = *(const f32x4*)(rope + (size_t)row * 16 + 8 + 4 * n);
                    f32x4 mine = v[0][n], oth;
#pragma unroll
                    for (int j = 0; j < 4; ++j) oth[j] = __shfl_xor(mine[j], 16);
                    const f32x4 r0 = mine * cs - oth * sn, r1 = mine * cs + oth * sn;
                    if (fq == 0) v[0][n] = r0; else if (fq == 1) v[0][n] = r1;
                }
#pragma unroll
                for (int bj = 0; bj < 2; ++bj) {
                    const f32x4 v0 = v[bj][0], v1 = v[bj][1];
                    u32x4 w; w.x = cvt_pk_bf16(v0[0], v0[1]); w.y = cvt_pk_bf16(v0[2], v0[3]); w.z = cvt_pk_bf16(v1[0], v1[1]); w.w = cvt_pk_bf16(v1[2], v1[3]);
                    *at<u32x4>(qr, ro + 64 * bj) = w;
                }
            }
    }
};

struct EpiGU {
    static constexpr int NPF = 0;
    static constexpr int NTRAIL = 8;
    bf16_t* act; bf16_t* acts; MoeTab T;
    __device__ __forceinline__ void operator()(const f32x4 (&acc)[2][2][4][2], const Unit& u, int wr, int wc, int fr, int fq) const {
        const int col0 = u.pn * 128 + wc * 32 + 8 * fq;
        const bool sh = (u.aux == NEXP);
        bf16_t* base = sh ? acts : act; const int tile0 = sh ? (u.pm - T.tstart[NEXP]) : u.pm;
#pragma unroll
        for (int ai = 0; ai < 2; ++ai)
#pragma unroll
            for (int m = 0; m < 4; ++m) {
                const unsigned row = (unsigned)(tile0 * BM + ai * HALF + wr * 64 + m * 16 + fr);
                f32x4 o[2];
#pragma unroll
                for (int n = 0; n < 2; ++n) { const f32x4 gt = acc[ai][0][m][n], up = acc[ai][1][m][n];
#pragma unroll
                    for (int j = 0; j < 4; ++j) o[n][j] = siluf_fast(gt[j]) * up[j]; }
                u32x4 w; w.x = cvt_pk_bf16(o[0][0], o[0][1]); w.y = cvt_pk_bf16(o[0][2], o[0][3]); w.z = cvt_pk_bf16(o[1][0], o[1][1]); w.w = cvt_pk_bf16(o[1][2], o[1][3]);
                *at<u32x4>(base, (row * DEXP + col0) * 2u) = w;
            }
    }
};

__device__ __forceinline__ unsigned pk4_fp8(const f32x4 v) {
    const float lim = 440.f;
    int p = __builtin_amdgcn_cvt_pk_fp8_f32(__builtin_amdgcn_fmed3f(v[0], -lim, lim), __builtin_amdgcn_fmed3f(v[1], -lim, lim), 0, false);
    p = __builtin_amdgcn_cvt_pk_fp8_f32(__builtin_amdgcn_fmed3f(v[2], -lim, lim), __builtin_amdgcn_fmed3f(v[3], -lim, lim), p, true);
    return (unsigned)p;
}
struct EpiY {
    static constexpr int NPF = 8;
    static constexpr int NTRAIL = 0;
    unsigned char* Y; MoeTab T; const float* roww;
    __device__ __forceinline__ void pre(const Unit& u, int wr, int fr, float (&pf)[8]) const {
        const int e = u.aux, lbase = (u.pm - T.tstart[e]) * BM;
#pragma unroll
        for (int ai = 0; ai < 2; ++ai)
#pragma unroll
            for (int m = 0; m < 4; ++m) pf[ai * 4 + m] = *at<const float>(roww, (unsigned)(e * CHTOK + lbase + ai * HALF + wr * 64 + m * 16 + fr) * 4u);
    }
    __device__ __forceinline__ void operator()(const f32x4 (&acc)[2][2][4][2], const Unit& u, int wr, int wc, int fr, int fq, const float (&pf)[8]) const {
        const int col0 = u.pn * BM + wc * 64 + 16 * fq;
#pragma unroll
        for (int ai = 0; ai < 2; ++ai)
#pragma unroll
            for (int m = 0; m < 4; ++m) {
                const int r = ai * HALF + wr * 64 + m * 16 + fr;
                const float w8 = pf[ai * 4 + m] * YSCALE;
                u32x4 w; w.x = pk4_fp8(acc[ai][0][m][0] * w8); w.y = pk4_fp8(acc[ai][0][m][1] * w8); w.z = pk4_fp8(acc[ai][1][m][0] * w8); w.w = pk4_fp8(acc[ai][1][m][1] * w8);
                *at<u32x4>(Y, (unsigned)((u.pm * BM + r) * DM + col0)) = w;
            }
    }
};

struct EpiCombine {
    static constexpr int NPF = 0;
    static constexpr int NTRAIL = 0;
    float* h; const unsigned char* Y; const int* toke; const int* tokp; const LAS int* pstart; const float* gate; int tokbase;
    __device__ __forceinline__ void operator()(const f32x4 (&acc)[2][2][4][2], const Unit& u, int wr, int wc, int fr, int fq) const {
        const int col0 = u.pn * BM + wc * 64 + 16 * fq;
        const int b = (tokbase + u.pm * BM) / SEQ;
        const float* gp = gate + (size_t)b * 6144 + u.pn * BM + wc * 64 + 4 * fq;
        const int t0 = tokbase + u.pm * BM + wr * 64 + fr;
        i32x4 e0 = *at<const i32x4>(toke, (unsigned)t0 * 32u), e1 = *at<const i32x4>(toke, (unsigned)t0 * 32u + 16u);
        i32x4 p0 = *at<const i32x4>(tokp, (unsigned)t0 * 32u), p1 = *at<const i32x4>(tokp, (unsigned)t0 * 32u + 16u);
#pragma unroll
        for (int ai = 0; ai < 2; ++ai)
#pragma unroll
            for (int m = 0; m < 4; ++m) {
                const int t = t0 + ai * HALF + m * 16;
                int yr[8];
#pragma unroll
                for (int k = 0; k < 4; ++k) { yr[k] = pstart[e0[k]] + p0[k]; yr[4 + k] = pstart[e1[k]] + p1[k]; }
                u32x4 yw[8];
#pragma unroll
                for (int k = 0; k < 8; ++k) yw[k] = *at<const u32x4>(Y, (unsigned)(yr[k] * DM + col0));
                const unsigned ho = (unsigned)(t * DM + u.pn * BM + wc * 64 + 4 * fq) * 4u;
                f32x4 hv[4];
#pragma unroll
                for (int q = 0; q < 4; ++q) hv[q] = *at<const f32x4>(h, ho + 64u * q);
                if (ai * 4 + m < 7) { const int tn = t0 + ((ai * 4 + m + 1) >> 2) * HALF + ((ai * 4 + m + 1) & 3) * 16;
                    e0 = *at<const i32x4>(toke, (unsigned)tn * 32u); e1 = *at<const i32x4>(toke, (unsigned)tn * 32u + 16u);
                    p0 = *at<const i32x4>(tokp, (unsigned)tn * 32u); p1 = *at<const i32x4>(tokp, (unsigned)tn * 32u + 16u); }
                f32x4 s[2][2];
#pragma unroll
                for (int bj = 0; bj < 2; ++bj)
#pragma unroll
                    for (int n = 0; n < 2; ++n) s[bj][n] = (f32x4){0.f, 0.f, 0.f, 0.f};
#pragma unroll
                for (int k = 0; k < 8; ++k) {
#pragma unroll
                    for (int q = 0; q < 4; ++q) { const unsigned ww = q == 0 ? yw[k].x : q == 1 ? yw[k].y : q == 2 ? yw[k].z : yw[k].w;
                        const f32x2 lo = __builtin_amdgcn_cvt_pk_f32_fp8((int)ww, false), hi2 = __builtin_amdgcn_cvt_pk_f32_fp8((int)ww, true);
                        s[q >> 1][q & 1][0] += lo.x; s[q >> 1][q & 1][1] += lo.y; s[q >> 1][q & 1][2] += hi2.x; s[q >> 1][q & 1][3] += hi2.y; }
                }
#pragma unroll
                for (int bj = 0; bj < 2; ++bj)
#pragma unroll
                    for (int n = 0; n < 2; ++n) {
                        const f32x4 gvv = *(const f32x4*)(gp + 32 * bj + 16 * n);
                        *at<f32x4>(h, ho + (32 * bj + 16 * n) * 4) = hv[2 * bj + n] + gvv * (acc[ai][bj][m][n] + s[bj][n] * (1.f / YSCALE));
                    }
                asm volatile("" ::: "memory");
            }
    }
};

struct EpiSlab {
    static constexpr int NPF = 0;
    static constexpr int NTRAIL = 0;
    float* slab;
    __device__ __forceinline__ void operator()(const f32x4 (&acc)[2][2][4][2], const Unit& u, int wr, int wc, int fr, int fq) const {
        const int col0 = wc * 32 + 8 * fq;
#pragma unroll
        for (int ai = 0; ai < 2; ++ai)
#pragma unroll
            for (int m = 0; m < 4; ++m) {
                const unsigned ro = (unsigned)((u.aux * 2048 + u.pm * BM + ai * HALF + wr * 64 + m * 16 + fr) * 256 + col0) * 4u;
#pragma unroll
                for (int bj = 0; bj < 2; ++bj)
#pragma unroll
                    for (int n = 0; n < 2; ++n) *at<f32x4>(slab, ro + (bj * HALF + 4 * n) * 4) = acc[ai][bj][m][n];
            }
    }
};
}
namespace att {
constexpr int NSLOT = 4;
constexpr int L_K = 0, L_V = 32768, L_CK = 65536, L_WSF = 73728, L_UNI = 75776, L_LIST = 75840, L_OS = 76800;
__device__ __forceinline__ s16x4 vtr(const LAS char* p) { typedef short v4i16_t __attribute__((ext_vector_type(4))); return __builtin_bit_cast(s16x4, __builtin_amdgcn_ds_read_tr16_b64_v4i16((LAS v4i16_t*)p)); }
__device__ __forceinline__ int dppx1(int x) { return __builtin_amdgcn_update_dpp(0, x, 0xB1, 0xF, 0xF, false); }
__device__ __forceinline__ int dppx2(int x) { return __builtin_amdgcn_update_dpp(0, x, 0x4E, 0xF, 0xF, false); }
__device__ __forceinline__ float dppx1f(float x) { return __int_as_float(dppx1(__float_as_int(x))); }
__device__ __forceinline__ float dppx2f(float x) { return __int_as_float(dppx2(__float_as_int(x))); }

__device__ __forceinline__ void glds16(const void* gsrc, unsigned lds_dst) { unsigned keep;
    asm volatile("s_mov_b32 %0, m0\n\ts_mov_b32 m0, %2\n\ts_nop 0\n\tglobal_load_lds_dwordx4 %1, off\n\ts_mov_b32 m0, %0" : "=&s"(keep) : "v"(gsrc), "s"(lds_dst) : "memory"); }
__device__ __forceinline__ void glds4(const void* gsrc, unsigned lds_dst) { unsigned keep;
    asm volatile("s_mov_b32 %0, m0\n\ts_mov_b32 m0, %2\n\ts_nop 0\n\tglobal_load_lds_dword %1, off\n\ts_mov_b32 m0, %0" : "=&s"(keep) : "v"(gsrc), "s"(lds_dst) : "memory"); }
template <bool HAS_CK>
__device__ __forceinline__ void ring_issue(LAS char* lds, int slot, const bf16_t* Kg, const bf16_t* Vg, int pitch, int key0, const float* ckg, int wid, int lane) {
    const unsigned l0 = (unsigned)(uintptr_t)lds;
    { const int krow = 8 * wid + (lane >> 3);
      glds16(Kg + (size_t)(key0 + krow) * pitch + ((lane & 7) ^ ((krow >> 1) & 7)) * 8, (unsigned)__builtin_amdgcn_readfirstlane((int)(l0 + L_K + slot * 8192 + wid * 1024))); }
    { const int vrow = 8 * wid + (lane >> 3);
      glds16(Vg + (size_t)(key0 + vrow) * pitch + ((lane & 7) ^ (4 * ((vrow >> 1) & 1))) * 8, (unsigned)__builtin_amdgcn_readfirstlane((int)(l0 + L_V + slot * 8192 + wid * 1024))); }
    if (HAS_CK) glds4(ckg + key0 + lane, (unsigned)__builtin_amdgcn_readfirstlane((int)(l0 + L_CK + (slot * 8 + wid) * 256)));
}
#define RING_WAIT_BAR(N) asm volatile("s_waitcnt vmcnt(%0) lgkmcnt(0)\n\ts_barrier" :: "i"(N) : "memory")
#define SCHED_FENCE() __builtin_amdgcn_sched_barrier(0)
__device__ __forceinline__ void kfrag_load(bf16x8 (&kf)[8], const LAS char* kb, int r32, int hi) {
    const int sw = (r32 >> 1) & 7;
#pragma unroll
    for (int d0 = 0; d0 < 4; ++d0) { const int ch = ((2 * d0 + hi) ^ sw) * 16; kf[2 * d0] = *(const LAS bf16x8*)(kb + r32 * 128 + ch); kf[2 * d0 + 1] = *(const LAS bf16x8*)(kb + (r32 + 32) * 128 + ch); }
}
__device__ __forceinline__ void qk_mma(f32x16& p0, f32x16& p1, const bf16x8 (&kf)[8], const bf16x8 (&qf)[4]) {
#pragma unroll
    for (int d0 = 0; d0 < 4; ++d0) { p0 = __builtin_amdgcn_mfma_f32_32x32x16_bf16(kf[2 * d0], qf[d0], p0, 0, 0, 0); p1 = __builtin_amdgcn_mfma_f32_32x32x16_bf16(kf[2 * d0 + 1], qf[d0], p1, 0, 0, 0); }
}
__device__ __forceinline__ void qk_mma_c(f32x16& p0, f32x16& p1, const f32x16& cinit, const bf16x8 (&kf)[8], const bf16x8 (&qf)[4]) {
    p0 = __builtin_amdgcn_mfma_f32_32x32x16_bf16(kf[0], qf[0], cinit, 0, 0, 0); p1 = __builtin_amdgcn_mfma_f32_32x32x16_bf16(kf[1], qf[0], cinit, 0, 0, 0);
#pragma unroll
    for (int d0 = 1; d0 < 4; ++d0) { p0 = __builtin_amdgcn_mfma_f32_32x32x16_bf16(kf[2 * d0], qf[d0], p0, 0, 0, 0); p1 = __builtin_amdgcn_mfma_f32_32x32x16_bf16(kf[2 * d0 + 1], qf[d0], p1, 0, 0, 0); }
}
__device__ __forceinline__ void vfrag_load(s16x4 (&vlo)[8], s16x4 (&vhi)[8], const LAS char* vb, int lane, int hi) {
    const int x = ((lane >> 3) & 1) * 64;
    const LAS char* vq = vb + (4 * hi + ((lane & 15) >> 2)) * 128 + ((lane >> 4) & 1) * 32 + (lane & 3) * 8;
    const LAS char* v0 = vq + x; const LAS char* v1 = vq + (64 ^ x);
#pragma unroll
    for (int ks = 0; ks < 4; ++ks) { vlo[ks] = vtr(v0 + ks * 2048); vhi[ks] = vtr(v0 + ks * 2048 + 1024); vlo[4 + ks] = vtr(v1 + ks * 2048); vhi[4 + ks] = vtr(v1 + ks * 2048 + 1024); }
}
typedef __bf16 bf16v2 __attribute__((ext_vector_type(2)));
__device__ __forceinline__ unsigned pkbf(float lo, float hi) { const f32x2 v = {lo, hi}; return __builtin_bit_cast(unsigned, __builtin_convertvector(v, bf16v2)); }
__device__ __forceinline__ void pv_mma(f32x16 (&o)[2], const f32x16& p0, const f32x16& p1, const s16x4 (&vlo)[8], const s16x4 (&vhi)[8]) {
    u32x4 pa[4];
#pragma unroll
    for (int i = 0; i < 4; ++i) { pa[0][i] = pkbf(p0[2 * i], p0[2 * i + 1]); pa[1][i] = pkbf(p0[8 + 2 * i], p0[8 + 2 * i + 1]);
                                  pa[2][i] = pkbf(p1[2 * i], p1[2 * i + 1]); pa[3][i] = pkbf(p1[8 + 2 * i], p1[8 + 2 * i + 1]); }
    LDS_WAIT(); SCHED_FENCE();
#pragma unroll
    for (int d0 = 0; d0 < 2; ++d0)
#pragma unroll
        for (int ks = 0; ks < 4; ++ks) {
            const s16x4 lo = vlo[4 * d0 + ks], hh = vhi[4 * d0 + ks];
            const bf16x8 vf = __builtin_shufflevector(lo, hh, 0, 1, 2, 3, 4, 5, 6, 7);
            o[d0] = __builtin_amdgcn_mfma_f32_32x32x16_bf16(__builtin_bit_cast(bf16x8, pa[ks]), vf, o[d0], 0, 0, 0);
        }
}
__device__ __forceinline__ void pv_mma_m(f32x16 (&o)[2], const f32x16& p0, const f32x16& p1, const s16x4 (&vlo)[8], const s16x4 (&vhi)[8], unsigned mw) {
    u32x4 pa[4];
#pragma unroll
    for (int i = 0; i < 4; ++i) { pa[0][i] = pkbf(p0[2 * i], p0[2 * i + 1]) & mw; pa[1][i] = pkbf(p0[8 + 2 * i], p0[8 + 2 * i + 1]) & mw;
                                  pa[2][i] = pkbf(p1[2 * i], p1[2 * i + 1]) & mw; pa[3][i] = pkbf(p1[8 + 2 * i], p1[8 + 2 * i + 1]) & mw; }
    LDS_WAIT(); SCHED_FENCE();
#pragma unroll
    for (int d0 = 0; d0 < 2; ++d0)
#pragma unroll
        for (int ks = 0; ks < 4; ++ks) {
            const s16x4 lo = vlo[4 * d0 + ks], hh = vhi[4 * d0 + ks];
            const bf16x8 vf = __builtin_shufflevector(lo, hh, 0, 1, 2, 3, 4, 5, 6, 7);
            o[d0] = __builtin_amdgcn_mfma_f32_32x32x16_bf16(__builtin_bit_cast(bf16x8, pa[ks]), vf, o[d0], 0, 0, 0);
        }
}
#define TILE_QK(p0, p1, kb, vb) \
    bf16x8 kf_[8]; s16x4 vlo_[8], vhi_[8]; \
    kfrag_load(kf_, (kb), r32, hi); LDS_WAIT(); SCHED_FENCE(); \
    qk_mma(p0, p1, kf_, qf); SCHED_FENCE(); \
    vfrag_load(vlo_, vhi_, (vb), lane, hi); SCHED_FENCE(); \
    exp_sum(p0, p1);
#define TILE_PV(o, p0, p1) pv_mma(o, p0, p1, vlo_, vhi_); SCHED_FENCE();
#define TILE_QK_C(p0, p1, cinit, kb, vb) \
    bf16x8 kf_[8]; s16x4 vlo_[8], vhi_[8]; \
    kfrag_load(kf_, (kb), r32, hi); LDS_WAIT(); SCHED_FENCE(); \
    qk_mma_c(p0, p1, cinit, kf_, qf); SCHED_FENCE(); \
    vfrag_load(vlo_, vhi_, (vb), lane, hi); SCHED_FENCE(); \
    exp_sum(p0, p1);
#define QK_ONLY(p0, p1, kb) { bf16x8 kf_[8]; kfrag_load(kf_, (kb), r32, hi); LDS_WAIT(); SCHED_FENCE(); qk_mma(p0, p1, kf_, qf); SCHED_FENCE(); } exp_sum(p0, p1);
#define PV_ONLY(o, p0, p1, vb) { s16x4 vlo_[8], vhi_[8]; vfrag_load(vlo_, vhi_, (vb), lane, hi); pv_mma(o, p0, p1, vlo_, vhi_); SCHED_FENCE(); }
#define HALF_BAR() asm volatile("s_waitcnt lgkmcnt(0)\n\ts_barrier" ::: "memory")
__device__ __forceinline__ void exp_sum(f32x16& p0, f32x16& p1) {
#pragma unroll
    for (int r = 0; r < 16; ++r) { p0[r] = __builtin_amdgcn_exp2f(p0[r]); p1[r] = __builtin_amdgcn_exp2f(p1[r]); }
}
#define OPQ(x) asm("" : "+v"(x))
__device__ __forceinline__ float psum(const f32x16& p0, const f32x16& p1) {
    float s0 = p0[0], s1 = p1[0], s2 = p0[8], s3 = p1[8];
#pragma unroll
    for (int r = 1; r < 8; ++r) { s0 += p0[r]; OPQ(s0); s1 += p1[r]; OPQ(s1); s2 += p0[r + 8]; OPQ(s2); s3 += p1[r + 8]; OPQ(s3); }
    s0 += s2; OPQ(s0); s1 += s3; OPQ(s1);
    return s0 + s1;
}
__device__ __forceinline__ void p_pack(u32x4 (&pa)[4], const f32x16& p0, const f32x16& p1) {
#pragma unroll
    for (int i = 0; i < 4; ++i) { pa[0][i] = pkbf(p0[2 * i], p0[2 * i + 1]); pa[1][i] = pkbf(p0[8 + 2 * i], p0[8 + 2 * i + 1]); pa[2][i] = pkbf(p1[2 * i], p1[2 * i + 1]); pa[3][i] = pkbf(p1[8 + 2 * i], p1[8 + 2 * i + 1]); }
}
__device__ __forceinline__ void pv_mma_p(f32x16 (&o)[2], const u32x4 (&pa)[4], const s16x4 (&vlo)[8], const s16x4 (&vhi)[8]) {
#pragma unroll
    for (int ks = 0; ks < 4; ++ks)
#pragma unroll
        for (int d0 = 0; d0 < 2; ++d0) {
            const bf16x8 vf = __builtin_shufflevector(vlo[4 * d0 + ks], vhi[4 * d0 + ks], 0, 1, 2, 3, 4, 5, 6, 7);
            o[d0] = __builtin_amdgcn_mfma_f32_32x32x16_bf16(__builtin_bit_cast(bf16x8, pa[ks]), vf, o[d0], 0, 0, 0);
        }
}
#define SG_PAIR(nv) do { _Pragma("unroll") for (int g_ = 0; g_ < 8; ++g_) { __builtin_amdgcn_sched_group_barrier(0x008, 1, 0); __builtin_amdgcn_sched_group_barrier(0x402, (nv), 0); } } while (0)
__device__ __forceinline__ void rows_from_cols(float s, LAS float* wsf, int r32, int hi, float (&out)[16]) {
    LDS_WAIT();
    if (hi == 0) wsf[r32] = s;
    LDS_WAIT();
#pragma unroll
    for (int m = 0; m < 4; ++m) { const f32x4 t = *(const LAS f32x4*)(wsf + 8 * m + 4 * hi); out[4 * m] = t[0]; out[4 * m + 1] = t[1]; out[4 * m + 2] = t[2]; out[4 * m + 3] = t[3]; }
    LDS_WAIT();
}

__device__ __forceinline__ void fox_unit(LAS char* lds, int b, int h, int qb, const bf16_t* Q, const bf16_t* K, const bf16_t* V, bf16_t* O, const float* CUM, float M2) {
    int tid_ = threadIdx.x; asm volatile("" : "+v"(tid_));
    const int tid = tid_, lane = tid & 63, r32 = lane & 31, hi = lane >> 5, wid = __builtin_amdgcn_readfirstlane(tid >> 6);
    const int q0 = qb * 256, qpos = q0 + 32 * wid + r32;
    const size_t rowbase = (size_t)b * SEQ;
    const bf16_t* Kg = K + rowbase * DM + h * HD; const bf16_t* Vg = V + rowbase * DM + h * HD;
    const float* ckg = CUM + (size_t)(b * NH + h) * SEQ;
    const int NT = (q0 + 256) / 64;
    ring_issue<true>(lds, 0, Kg, Vg, DM, 64 * (NT - 2), ckg, wid, lane); ring_issue<true>(lds, 1, Kg, Vg, DM, 64 * (NT - 1), ckg, wid, lane);
    ring_issue<true>(lds, 2, Kg, Vg, DM, 64 * (NT - 4), ckg, wid, lane); ring_issue<true>(lds, 3, Kg, Vg, DM, 64 * (NT - 3), ckg, wid, lane);
    bf16x8 qf[4];
    { const bf16_t* qp = Q + (rowbase + qpos) * DM + h * HD;
#pragma unroll
      for (int d0 = 0; d0 < 4; ++d0) qf[d0] = *(const bf16x8*)(qp + d0 * 16 + hi * 8); }
    const float cq = ckg[qpos] - M2;
    f32x16 o[2]; o[0] = (f32x16){}; o[1] = (f32x16){}; float lsum = 0.f;
    const int wave_last = (q0 + 32 * wid + 31) >> 6;
    int t0 = 0;
    { const float c0 = ckg[q0];
      int t = NT - 5;
#pragma unroll 1
      for (int base = NT - 5; base >= 0; base -= 64) {
          const int tt = base - lane; const float ce = ckg[64 * (tt >= 0 ? tt : 0) + 63]; const float lim = c0 + (46.f + 2.f * M2); const bool skip = (tt >= 0) && (ce > lim);
          const unsigned long long bm = __ballot(skip);
          if (bm) { t = base - (int)__builtin_ctzll(bm); break; }
          t = base - 64;
      }
      t0 = __builtin_amdgcn_readfirstlane(t < 0 ? 0 : t + 1); }
#define FOX_TILE(t_, slot_) do { if ((t_) <= wave_last) { \
            f32x16 p0, p1; \
            const LAS float* ck = (const LAS float*)(lds + L_CK + ((slot_) * 8 + wid) * 256); \
            _Pragma("unroll") for (int m = 0; m < 4; ++m) { const f32x4 a = *(const LAS f32x4*)(ck + 8 * m + 4 * hi), c = *(const LAS f32x4*)(ck + 32 + 8 * m + 4 * hi); \
                _Pragma("unroll") for (int j = 0; j < 4; ++j) { p0[4 * m + j] = cq - a[j]; p1[4 * m + j] = cq - c[j]; } } \
            TILE_QK(p0, p1, lds + L_K + (slot_) * 8192, lds + L_V + (slot_) * 8192) \
            if (64 * (t_) + 63 > q0 + 32 * wid) { const int kb = 64 * (t_) + 4 * hi; \
                _Pragma("unroll") for (int r = 0; r < 16; ++r) { const int kv = kb + (r & 3) + 8 * (r >> 2); if (kv > qpos) p0[r] = 0.f; if (kv + 32 > qpos) p1[r] = 0.f; } } \
            lsum += psum(p0, p1); \
            TILE_PV(o, p0, p1) } } while (0)
#define FOX_INIT(p0, p1, slot_) do { const LAS float* ck = (const LAS float*)(lds + L_CK + ((slot_) * 8 + wid) * 256); \
            _Pragma("unroll") for (int m = 0; m < 4; ++m) { const f32x4 a = *(const LAS f32x4*)(ck + 8 * m + 4 * hi), c = *(const LAS f32x4*)(ck + 32 + 8 * m + 4 * hi); \
                _Pragma("unroll") for (int j = 0; j < 4; ++j) { p0[4 * m + j] = cq - a[j]; p1[4 * m + j] = cq - c[j]; } } } while (0)
#define FOX_PAIR(sa, sb) do { \
            f32x16 a0, a1, b0, b1; u32x4 pa[4], pb[4]; \
            { bf16x8 kfa[8]; FOX_INIT(a0, a1, sa); kfrag_load(kfa, lds + L_K + (sa) * 8192, r32, hi); LDS_WAIT(); SCHED_FENCE(); \
              qk_mma(a0, a1, kfa, qf); SCHED_FENCE(); } \
            { bf16x8 kfb[8]; s16x4 val[8], vah[8]; \
              FOX_INIT(b0, b1, sb); kfrag_load(kfb, lds + L_K + (sb) * 8192, r32, hi); LDS_WAIT(); SCHED_FENCE(); \
              vfrag_load(val, vah, lds + L_V + (sa) * 8192, lane, hi); SCHED_FENCE(); \
              qk_mma(b0, b1, kfb, qf); exp_sum(a0, a1); lsum += psum(a0, a1); p_pack(pa, a0, a1); SCHED_FENCE(); \
              LDS_WAIT(); SCHED_FENCE(); \
              pv_mma_p(o, pa, val, vah); exp_sum(b0, b1); lsum += psum(b0, b1); p_pack(pb, b0, b1); SCHED_FENCE(); } \
            { s16x4 vbl[8], vbh[8]; vfrag_load(vbl, vbh, lds + L_V + (sb) * 8192, lane, hi); LDS_WAIT(); SCHED_FENCE(); \
              pv_mma_p(o, pb, vbl, vbh); SCHED_FENCE(); } } while (0)
    int sp = 0;
#pragma unroll 1
    for (int ta = NT - 2; ta + 1 >= t0; ta -= 2) {
        RING_WAIT_BAR(0);
        if (ta != NT - 2) {
            const int na = ta - 2;
            if (na + 1 >= t0) { if (na >= t0) ring_issue<true>(lds, 2 * (sp ^ 1), Kg, Vg, DM, 64 * na, ckg, wid, lane);
                                ring_issue<true>(lds, 2 * (sp ^ 1) + 1, Kg, Vg, DM, 64 * (na + 1), ckg, wid, lane); }
        }
        if (ta >= t0 && ta + 1 < wave_last) { FOX_PAIR(2 * sp, 2 * sp + 1); }
        else { if (ta >= t0) FOX_TILE(ta, 2 * sp);
               FOX_TILE(ta + 1, 2 * sp + 1); }
        sp ^= 1;
    }
#undef FOX_TILE
#undef FOX_PAIR
#undef FOX_INIT
    RING_WAIT_BAR(0);
    lsum += __shfl_xor(lsum, 32);
    float sc[16];
    rows_from_cols(1.f / lsum, (LAS float*)(lds + L_WSF) + wid * 64, r32, hi, sc);
    { LAS bf16_t* stg = (LAS bf16_t*)(lds + wid * 4096);
#pragma unroll
      for (int r = 0; r < 16; ++r) { const int q = crow(r, hi); stg[q * 64 + r32] = (bf16_t)f2bf(o[0][r] * sc[r]); stg[q * 64 + 32 + r32] = (bf16_t)f2bf(o[1][r] * sc[r]); }
      LDS_WAIT();
      bf16_t* Ow = O + (rowbase + q0 + 32 * wid) * DM + h * HD;
#pragma unroll
      for (int i = 0; i < 4; ++i) { const int rw = (lane >> 3) + 8 * i, ch = lane & 7; const u32x4 v = *(const LAS u32x4*)(stg + rw * 64 + ch * 8); *(u32x4*)(Ow + (size_t)rw * DM + ch * 8) = v; } }
    __syncthreads();
}

struct NsaArgs { const bf16_t *QP, *QR, *KCMP, *VCMP, *KSEL, *VSEL, *KWIN, *VWIN; const float* GATES; bf16_t* O; float Mcmp, Msel, Mwin; };

__device__ __forceinline__ int next_bit4(unsigned u0, unsigned u1, unsigned u2, unsigned u3, int from) {
    if (from >= 128) return 128;
    const int w = from >> 5; const unsigned mlow = ~0u << (from & 31);
    unsigned x;
    x = (w == 0) ? (u0 & mlow) : 0u;                         if (x) return __builtin_ctz(x);
    x = (w == 1) ? (u1 & mlow) : (w < 1 ? u1 : 0u);          if (x) return 32 + __builtin_ctz(x);
    x = (w == 2) ? (u2 & mlow) : (w < 2 ? u2 : 0u);          if (x) return 64 + __builtin_ctz(x);
    x = (w == 3) ? (u3 & mlow) : (w < 3 ? u3 : 0u);          if (x) return 96 + __builtin_ctz(x);
    return 128;
}

__device__ __forceinline__ void nsa_unit(LAS char* lds, int b, int g, int c, const NsaArgs& A) {
    int tid_ = threadIdx.x; asm volatile("" : "+v"(tid_));
    const int tid = tid_, lane = tid & 63, r32 = lane & 31, hi = lane >> 5, wid = __builtin_amdgcn_readfirstlane(tid >> 6);
    const int q0 = 64 * c, ti = 8 * wid + (r32 >> 2);
    const int head = 4 * g + (r32 & 3);
    const size_t row = (size_t)b * SEQ + q0 + ti;
    LAS float* wsf = (LAS float*)(lds + L_WSF) + wid * 64;

    LAS float* osl = (LAS float*)(lds + L_OS) + wid * 2048 + lane;

    unsigned mw0 = 0u, mw1 = 0u, mw2 = 0u, mw3 = 0u;
    const float gate_c = A.GATES[row * 48 + head * 3 + 0], gate_s = A.GATES[row * 48 + head * 3 + 1], gate_w = A.GATES[row * 48 + head * 3 + 2];
    bf16x8 qf[4];
    { const bf16_t* qp = A.QR + row * DM + head * HD;
#pragma unroll
      for (int d0 = 0; d0 < 4; ++d0) qf[d0] = *(const bf16x8*)(qp + d0 * 16 + hi * 8); }
    {
        bf16x8 qfp[4];
        { const bf16_t* qp = A.QP + row * DM + head * HD;
#pragma unroll
          for (int d0 = 0; d0 < 4; ++d0) qfp[d0] = *(const bf16x8*)(qp + d0 * 16 + hi * 8); }
        const bf16_t* Kg = A.KCMP + (size_t)b * NCMPB * 256 + g * HD; const bf16_t* Vg = A.VCMP + (size_t)b * NCMPB * 256 + g * HD;
        const int nvis = (q0 + ti + 1) >> 6;
        const int ntl = (c + 1 > 64) ? 2 : 1;
        { const bf16_t* Kw = A.KWIN + (size_t)b * SEQ * 256 + g * HD; const bf16_t* Vw = A.VWIN + (size_t)b * SEQ * 256 + g * HD; const int tlo = c >= 8 ? c - 8 : 0;
          ring_issue<false>(lds, 2, Kw, Vw, 256, 64 * tlo, nullptr, wid, lane);
          if (tlo + 1 <= c) ring_issue<false>(lds, 3, Kw, Vw, 256, 64 * (tlo + 1), nullptr, wid, lane); }
        ring_issue<false>(lds, 0, Kg, Vg, 256, 0, nullptr, wid, lane);
        if (ntl == 2) ring_issue<false>(lds, 1, Kg, Vg, 256, 64, nullptr, wid, lane);
        RING_WAIT_BAR(0);
        float lsum = 0.f;
#pragma unroll 1
        for (int t = 0; t < ntl; ++t) {
            f32x16 p0, p1;
#pragma unroll
            for (int r = 0; r < 16; ++r) { p0[r] = -A.Mcmp; p1[r] = -A.Mcmp; }
            { bf16x8 kf_[8]; kfrag_load(kf_, lds + L_K + t * 8192, r32, hi); LDS_WAIT(); SCHED_FENCE(); qk_mma(p0, p1, kf_, qfp); SCHED_FENCE(); }
            exp_sum(p0, p1);
#pragma unroll
            for (int r = 0; r < 16; ++r) { const int n = 64 * t + crow(r, hi); if (n >= nvis) p0[r] = 0.f; if (n + 32 >= nvis) p1[r] = 0.f; }
            lsum += psum(p0, p1);
        }
        lsum += __shfl_xor(lsum, 32);
        const float inv = lsum > 0.f ? 1.f / lsum : 0.f;
        const int k4 = lane & 3;
        unsigned keys[16];
#pragma unroll
        for (int i = 0; i < 16; ++i) keys[i] = 0u;
        f32x16 o[2]; o[0] = (f32x16){}; o[1] = (f32x16){};
#pragma unroll
        for (int t = 0; t < 2; ++t) {
            if (t < ntl) {
                f32x16 p0, p1;
#pragma unroll
                for (int r = 0; r < 16; ++r) { p0[r] = -A.Mcmp; p1[r] = -A.Mcmp; }
                bf16x8 kf_[8]; s16x4 vlo_[8], vhi_[8];
                kfrag_load(kf_, lds + L_K + t * 8192, r32, hi); LDS_WAIT(); SCHED_FENCE();
                qk_mma(p0, p1, kf_, qfp); SCHED_FENCE();
                vfrag_load(vlo_, vhi_, lds + L_V + t * 8192, lane, hi); SCHED_FENCE();
                exp_sum(p0, p1);
#pragma unroll
                for (int r = 0; r < 16; ++r) { const int n = 64 * t + crow(r, hi); if (n >= nvis) p0[r] = 0.f; if (n + 32 >= nvis) p1[r] = 0.f; }
                TILE_PV(o, p0, p1)
#pragma unroll
                for (int jj = 0; jj < 2; ++jj)
#pragma unroll
                    for (int m4 = 0; m4 < 4; ++m4) {
                        const float v0 = (jj ? p1[4 * m4] : p0[4 * m4]) * inv, v1 = (jj ? p1[4 * m4 + 1] : p0[4 * m4 + 1]) * inv, v2 = (jj ? p1[4 * m4 + 2] : p0[4 * m4 + 2]) * inv, v3 = (jj ? p1[4 * m4 + 3] : p0[4 * m4 + 3]) * inv;
                        const float s01 = (k4 & 1) ? v0 : v1, k01 = (k4 & 1) ? v1 : v0; const float a01 = k01 + dppx1f(s01);
                        const float s23 = (k4 & 1) ? v2 : v3, k23 = (k4 & 1) ? v3 : v2; const float a23 = k23 + dppx1f(s23);
                        const float s2 = (k4 & 2) ? a01 : a23, k2 = (k4 & 2) ? a23 : a01; const float imp = k2 + dppx2f(s2);
                        const int j = 2 * t + jj;
                        const int n = 32 * j + 8 * m4 + 4 * hi + k4;
                        const bool valid = (n >= 1) && (n <= c - 2);
                        keys[4 * j + m4] = valid ? ((__float_as_uint(imp) & ~127u) | (unsigned)(127 - n) | 0x80000000u) : 0u;
                    }
            }
        }
        { float sc[16]; rows_from_cols(inv * gate_c, wsf, r32, hi, sc);
#pragma unroll
          for (int r = 0; r < 16; ++r) { osl[r * 64] = o[0][r] * sc[r]; osl[(16 + r) * 64] = o[1][r] * sc[r]; } }
        if (c + 1 <= 16) {
            mw0 = (1u << (c + 1)) - 1u;
        } else {
#pragma unroll 1
            for (int round = 0; round < 13; ++round) {
                unsigned mx = keys[0];
#pragma unroll
                for (int i = 1; i < 16; ++i) mx = mx > keys[i] ? mx : keys[i];
                { const unsigned t1 = (unsigned)dppx1((int)mx); mx = mx > t1 ? mx : t1; }
                { const unsigned t2 = (unsigned)dppx2((int)mx); mx = mx > t2 ? mx : t2; }
                { const auto rr = __builtin_amdgcn_permlane32_swap(mx, mx, false, false); const unsigned t3 = rr[0] > rr[1] ? rr[0] : rr[1]; mx = mx > t3 ? mx : t3; }
#pragma unroll
                for (int i = 0; i < 16; ++i) keys[i] = (keys[i] == mx) ? 0u : keys[i];
            }
#pragma unroll
            for (int j = 0; j < 4; ++j) {
                unsigned wbits = 0u;
#pragma unroll
                for (int m4 = 0; m4 < 4; ++m4) {
                    const int n = 32 * j + 8 * m4 + 4 * hi + k4;
                    const bool valid = (n >= 1) && (n <= c - 2);
                    if (valid && keys[4 * j + m4] == 0u) wbits |= 1u << (8 * m4 + 4 * hi + k4);
                }
                wbits |= (unsigned)dppx1((int)wbits); wbits |= (unsigned)dppx2((int)wbits); wbits |= (unsigned)__shfl_xor((int)wbits, 32);
                if (j == 0) mw0 = wbits; else if (j == 1) mw1 = wbits; else if (j == 2) mw2 = wbits; else mw3 = wbits;
            }
            mw0 |= 1u;
            { const int n = c - 1; const unsigned bt = 1u << (n & 31); if ((n >> 5) == 0) mw0 |= bt; else if ((n >> 5) == 1) mw1 |= bt; else if ((n >> 5) == 2) mw2 |= bt; else mw3 |= bt; }
            { const int n = c;     const unsigned bt = 1u << (n & 31); if ((n >> 5) == 0) mw0 |= bt; else if ((n >> 5) == 1) mw1 |= bt; else if ((n >> 5) == 2) mw2 |= bt; else mw3 |= bt; }
        }
    }
    __syncthreads();
    {
        const bf16_t* Kg = A.KWIN + (size_t)b * SEQ * 256 + g * HD; const bf16_t* Vg = A.VWIN + (size_t)b * SEQ * 256 + g * HD;
        const int tlo = c >= 8 ? c - 8 : 0;
        f32x16 o[2]; o[0] = (f32x16){}; o[1] = (f32x16){}; float lsum = 0.f;
        f32x16 negm;
        { float mv_ = -A.Mwin; asm volatile("" : "+v"(mv_));
#pragma unroll
          for (int r = 0; r < 16; ++r) negm[r] = mv_; }
#define WIN_TILE(t_, slot_) do { f32x16 p0, p1; \
            TILE_QK_C(p0, p1, negm, lds + L_K + (slot_) * 8192, lds + L_V + (slot_) * 8192) \
            if ((t_) == c) { _Pragma("unroll") for (int r = 0; r < 16; ++r) { const int kl = crow(r, hi); if (kl > ti) p0[r] = 0.f; if (kl + 32 > ti) p1[r] = 0.f; } } \
            else if ((t_) == c - 8) { _Pragma("unroll") for (int r = 0; r < 16; ++r) { const int kl = crow(r, hi); if (kl <= ti) p0[r] = 0.f; if (kl + 32 <= ti) p1[r] = 0.f; } } \
            lsum += psum(p0, p1); \
            TILE_PV(o, p0, p1) } while (0)
        int sp = 1;
#pragma unroll 1
        for (int t = tlo; t <= c; t += 2) {
            RING_WAIT_BAR(0);
            if (t + 2 <= c) ring_issue<false>(lds, 2 * (sp ^ 1), Kg, Vg, 256, 64 * (t + 2), nullptr, wid, lane);
            if (t + 3 <= c) ring_issue<false>(lds, 2 * (sp ^ 1) + 1, Kg, Vg, 256, 64 * (t + 3), nullptr, wid, lane);
            WIN_TILE(t, 2 * sp);
            if (t + 1 <= c) WIN_TILE(t + 1, 2 * sp + 1);
            sp ^= 1;
        }
        RING_WAIT_BAR(0);
#undef WIN_TILE
        lsum += __shfl_xor(lsum, 32);
        float sc[16]; rows_from_cols(gate_w / lsum, wsf, r32, hi, sc);
#pragma unroll
        for (int r = 0; r < 16; ++r) { osl[r * 64] += o[0][r] * sc[r]; osl[(16 + r) * 64] += o[1][r] * sc[r]; }
    }
    {
        f32x16 o[2]; o[0] = (f32x16){}; o[1] = (f32x16){}; float lsum = 0.f;
        f32x16 negm;
        { float mv_ = -A.Msel; asm volatile("" : "+v"(mv_));
#pragma unroll
          for (int r = 0; r < 16; ++r) negm[r] = mv_; }
        const bf16_t* Kb = A.KSEL + (size_t)(b * NCMPB) * NG * 4096 + g * 4096; const bf16_t* Vb = A.VSEL + (size_t)(b * NCMPB) * NG * 4096 + g * 4096;
        unsigned U0 = mw0, U1 = mw1, U2 = mw2, U3 = mw3;
#pragma unroll
        for (int s = 4; s <= 16; s <<= 1) { U0 |= (unsigned)__shfl_xor((int)U0, s); U1 |= (unsigned)__shfl_xor((int)U1, s); U2 |= (unsigned)__shfl_xor((int)U2, s); U3 |= (unsigned)__shfl_xor((int)U3, s); }
        U0 = __builtin_amdgcn_readfirstlane(U0); U1 = __builtin_amdgcn_readfirstlane(U1); U2 = __builtin_amdgcn_readfirstlane(U2); U3 = __builtin_amdgcn_readfirstlane(U3);
        bf16x8 kf[8], vf[8];
#define SEL_LOADK(n_) do { const bf16_t* kp = Kb + (size_t)(n_) * (NG * 4096) + (hi * 64 + r32) * 8; \
            _Pragma("unroll") for (int d0 = 0; d0 < 4; ++d0) { kf[2 * d0] = *(const bf16x8*)(kp + d0 * 1024); kf[2 * d0 + 1] = *(const bf16x8*)(kp + d0 * 1024 + 256); } } while (0)
#define SEL_LOADV(n_) do { const bf16_t* vp = Vb + (size_t)(n_) * (NG * 4096) + (hi * 32 + r32) * 8; \
            _Pragma("unroll") for (int ks = 0; ks < 4; ++ks) _Pragma("unroll") for (int d0 = 0; d0 < 2; ++d0) vf[2 * ks + d0] = *(const bf16x8*)(vp + (ks * 2 + d0) * 512); } while (0)
        LAS unsigned char* blist = (LAS unsigned char*)(lds + L_CK + wid * 256);
        { const unsigned b0 = ((lane < 32 ? U0 : U1) >> (lane & 31)) & 1u, b1 = ((lane < 32 ? U2 : U3) >> (lane & 31)) & 1u;
          const int c01 = __builtin_popcount(U0) + __builtin_popcount(U1), c23 = __builtin_popcount(U2) + __builtin_popcount(U3);
          const int p0_ = (int)__builtin_amdgcn_mbcnt_hi(U1, __builtin_amdgcn_mbcnt_lo(U0, 0u)), p1_ = c01 + (int)__builtin_amdgcn_mbcnt_hi(U3, __builtin_amdgcn_mbcnt_lo(U2, 0u));
          if (b0) blist[p0_] = (unsigned char)lane;
          if (b1) blist[p1_] = (unsigned char)(64 + lane);
          if (lane < 4) blist[c01 + c23 + lane] = 255; }
        int n = __builtin_amdgcn_readfirstlane((int)blist[0]), n2 = __builtin_amdgcn_readfirstlane((int)blist[1]);
        int li = 2; int nxv = (int)blist[2];
        SEL_LOADK(n); SEL_LOADV(n);
#pragma unroll 1
        while (n < 128) {
            const unsigned wn = (n >> 5) == 0 ? mw0 : (n >> 5) == 1 ? mw1 : (n >> 5) == 2 ? mw2 : mw3;
            const bool mine = (wn >> (n & 31)) & 1u;
            f32x16 p0, p1;
            qk_mma_c(p0, p1, negm, kf, qf); SCHED_FENCE();
            if (n2 < 128) SEL_LOADK(n2);
            SCHED_FENCE();
            exp_sum(p0, p1);
            if (n == c) {
#pragma unroll
                for (int r = 0; r < 16; ++r) { const int kl = crow(r, hi); if (kl > ti) p0[r] = 0.f; if (kl + 32 > ti) p1[r] = 0.f; }
            }
            const unsigned keepw = mine ? 0xffffffffu : 0u; const float keep = mine ? 1.f : 0.f;
            lsum += keep * psum(p0, p1);
            u32x4 pa[4];
#pragma unroll
            for (int i = 0; i < 4; ++i) { pa[0][i] = pkbf(p0[2 * i], p0[2 * i + 1]) & keepw; pa[1][i] = pkbf(p0[8 + 2 * i], p0[8 + 2 * i + 1]) & keepw;
                                          pa[2][i] = pkbf(p1[2 * i], p1[2 * i + 1]) & keepw; pa[3][i] = pkbf(p1[8 + 2 * i], p1[8 + 2 * i + 1]) & keepw; }
#pragma unroll
            for (int ks = 0; ks < 4; ++ks) { o[0] = __builtin_amdgcn_mfma_f32_32x32x16_bf16(__builtin_bit_cast(bf16x8, pa[ks]), vf[2 * ks], o[0], 0, 0, 0);
                                             o[1] = __builtin_amdgcn_mfma_f32_32x32x16_bf16(__builtin_bit_cast(bf16x8, pa[ks]), vf[2 * ks + 1], o[1], 0, 0, 0); }
            SCHED_FENCE();
            if (n2 < 128) SEL_LOADV(n2);
            SCHED_FENCE();
            n = n2; n2 = __builtin_amdgcn_readfirstlane(nxv); ++li; nxv = (int)blist[li];
        }
#undef SEL_LOADK
#undef SEL_LOADV
        lsum += __shfl_xor(lsum, 32);
        float sc[16]; rows_from_cols(gate_s / lsum, wsf, r32, hi, sc);
        bf16_t* Ob = A.O + ((size_t)b * SEQ + q0 + 8 * wid) * DM + 4 * g * HD;
        { LAS bf16_t* stg = (LAS bf16_t*)(lds + wid * 4096);
#pragma unroll
          for (int r = 0; r < 16; ++r) { const int q = crow(r, hi); stg[q * 64 + r32] = (bf16_t)f2bf(osl[r * 64] + o[0][r] * sc[r]); stg[q * 64 + 32 + r32] = (bf16_t)f2bf(osl[(16 + r) * 64] + o[1][r] * sc[r]); }
          LDS_WAIT();
#pragma unroll
          for (int i = 0; i < 4; ++i) { const int rw = (lane >> 3) + 8 * i, ch = lane & 7; const u32x4 v = *(const LAS u32x4*)(stg + rw * 64 + ch * 8);
              *(u32x4*)(Ob + (size_t)(rw >> 2) * DM + (rw & 3) * HD + ch * 8) = v; } }
    }
    __syncthreads();
}
}
struct Args { const float* in[N_IN]; float* out; unsigned char* ws; int ph_lo, ph_hi; };
#define AS4 __attribute__((address_space(4)))
typedef const float* const AS4* KIn;
struct Ctx {
    const int* pos; float* out; unsigned char* ws;
    LAS unsigned char* lds; unsigned* ctl; int tid, lane, wave, G, bid;
};

enum { MAP_ID = 0, MAP_HPERM = 1, MAP_IL8 = 2 };
template <int MAP> __device__ __forceinline__ int rowmap(int s) {
    if (MAP == MAP_HPERM) return (s & ~255) + 128 * ((s >> 5) & 1) + 32 * ((s >> 6) & 3) + (s & 31);
    if (MAP == MAP_IL8) return (s & ~255) + 128 * ((s >> 5) & 1) + 32 * ((s >> 6) & 3) + 8 * ((s >> 2) & 3) + 4 * ((s >> 4) & 1) + (s & 3);
    return s;
}
template <int MAP>
__device__ __forceinline__ void xitem64(const float* W, int ld, int sc0, int k0, bf16_t* WT, int Kd, int rowoff, int mapbase, LAS float* scr, int lane, bool probe_rep = false) {
    f32x4 v[16];
#pragma unroll
    for (int i = 0; i < 16; ++i) { const int kk = 4 * i + (lane >> 4);
        v[i] = *(const f32x4*)(W + (size_t)(k0 + kk) * ld + sc0 + 4 * (lane & 15)); }
#pragma unroll
    for (int i = 0; i < 16; ++i) { const int kk = 4 * i + (lane >> 4); *(LAS f32x4*)(scr + kk * 64 + 4 * ((lane & 15) ^ ((kk >> 3) & 7))) = v[i]; }
    LDS_WAIT(); asm volatile("" ::: "memory");
    const int c = lane & 7;
#pragma unroll
    for (int j = 0; j < 8; ++j) { const int n = (lane >> 3) + 8 * j; const LAS float* sp = scr + (8 * c) * 64 + 4 * ((n >> 2) ^ c) + (n & 3);
        u32x4 o; o.x = cvt_pk_bf16(sp[0 * 64], sp[1 * 64]); o.y = cvt_pk_bf16(sp[2 * 64], sp[3 * 64]); o.z = cvt_pk_bf16(sp[4 * 64], sp[5 * 64]); o.w = cvt_pk_bf16(sp[6 * 64], sp[7 * 64]);
        *(u32x4*)(WT + (size_t)(rowoff + rowmap<MAP>(mapbase + n)) * Kd + k0 + 8 * c) = o; }
    LDS_WAIT(); asm volatile("" ::: "memory");
}
template <int MAP>
__device__ __forceinline__ void conv_dense(Ctx& C, const float* src, int ld, int K, int N, bf16_t* dst, int gw, int ngw) {
    LAS float* scr = (LAS float*)(C.lds + C.wave * 16384);
    const int nkb = K / 64, nnb = N / 64;
    for (int it = gw; it < nkb * nnb; it += ngw) { const int kb = it / nnb, nb = it % nnb; xitem64<MAP>(src, ld, 64 * nb, 64 * kb, dst, K, 0, 64 * nb, scr, C.lane); }
}
template <int KT>
__device__ __forceinline__ void xsub64(const float* W, int ld, int sc0, int k0, LAS bf16_t* tile, int nt0, int k0t, int lane) {
    f32x4 v[16];
#pragma unroll
    for (int i = 0; i < 16; ++i) { const int kk = 4 * i + (lane >> 4); v[i] = *(const f32x4*)(W + (size_t)(k0 + kk) * ld + sc0 + 4 * (lane & 15)); }
#pragma unroll
    for (int i = 0; i < 16; ++i) { const int kt = k0t + 4 * i + (lane >> 4);
        const unsigned w01 = cvt_pk_bf16(v[i][0], v[i][1]), w23 = cvt_pk_bf16(v[i][2], v[i][3]);
#pragma unroll
        for (int j = 0; j < 4; ++j) { const int n = nt0 + 4 * (lane & 15) + j; const unsigned ww = (j < 2) ? w01 : w23;
            tile[n * KT + 8 * ((kt >> 3) ^ ((n >> 2) & 7)) + (kt & 7)] = (bf16_t)((j & 1) ? (ww >> 16) : (ww & 0xffffu)); } }
}
__device__ __forceinline__ void conv_experts(Ctx& C, const float* wg, const float* wu, const float* wd, int nexp, bf16_t* dgu, bf16_t* dd, int gw, int ngw, bool down_only = false) {
    (void)gw; (void)ngw;
    LAS bf16_t* tile = (LAS bf16_t*)C.lds;
    const int per_e = 8 + 4;
    const int w = C.wave, lane = C.lane;
    __syncthreads();
    for (int bi = C.bid; bi < nexp * per_e; bi += C.G) {
        const int e = bi / per_e, r = bi % per_e;
        if (r < 8 && down_only) continue;
        if (r < 8) {
            const int bj = r >> 2, kq = r & 3;
            const float* src = (bj ? wu : wg) + (size_t)e * DM * DEXP;
#pragma unroll 1
            for (int s2 = 0; s2 < 2; ++s2) { const int st = w + 8 * s2, nb = st >> 2, kb = st & 3;
                xsub64<256>(src, DEXP, 64 * nb, 256 * kq + 64 * kb, tile, 64 * nb, 64 * kb, lane); }
            __syncthreads();
            bf16_t* dst = dgu + (size_t)e * 512 * DM + 256 * kq;
#pragma unroll 8
            for (int i = 0; i < 16; ++i) { const int n = 32 * w + 2 * i + (lane >> 5), c8 = lane & 31;
                const u32x4 v = *(const LAS u32x4*)(tile + n * 256 + 8 * (c8 ^ ((n >> 2) & 7)));
                *(u32x4*)(dst + (size_t)(256 * (n >> 7) + 128 * bj + (n & 127)) * DM + 8 * c8) = v; }
            __syncthreads();
        } else {
            const int cg = r - 8;
            const float* src = wd + (size_t)e * DEXP * DM;
#pragma unroll 1
            for (int s2 = 0; s2 < 2; ++s2) { const int st = w + 8 * s2, nb = st >> 2, kb = st & 3;
                xsub64<256>(src, DM, 256 * cg + 64 * nb, 64 * kb, tile, 64 * nb, 64 * kb, lane); }
            __syncthreads();
            bf16_t* dst = dd + (size_t)e * DM * DEXP;
#pragma unroll 8
            for (int i = 0; i < 16; ++i) { const int n = 32 * w + 2 * i + (lane >> 5), c8 = lane & 31;
                const u32x4 v = *(const LAS u32x4*)(tile + n * 256 + 8 * (c8 ^ ((n >> 2) & 7)));
                *(u32x4*)(dst + (size_t)rowmap<MAP_IL8>(256 * cg + n) * DEXP + 8 * c8) = v; }
            __syncthreads();
        }
    }
}

struct CvAddr { const float* s; u32x4* d[4]; int ld; };
__device__ __forceinline__ void cv_addr(CvAddr& a, int t, int ngu, const float* wg, const float* wu, const float* wd, bf16_t* dgu, bf16_t* dd, int lane) {
    if (t < ngu) { const int e = t >> 8, bj = (t >> 7) & 1, k8 = t & 127;
        a.s = (bj ? wu : wg) + (size_t)e * DM * DEXP + (size_t)(8 * k8) * DEXP + lane; a.ld = DEXP;
        u32x4* db = (u32x4*)(dgu + (size_t)e * 512 * DM) + (k8 * 512 + 128 * bj + lane);
#pragma unroll
        for (int i = 0; i < 4; ++i) a.d[i] = db + 256 * (i >> 1) + 64 * (i & 1); }
    else { const int r = t - ngu, e = r >> 7, k8 = (r >> 2) & 31, cg = r & 3;
        a.s = wd + (size_t)e * DEXP * DM + (size_t)(8 * k8) * DM + 256 * cg + lane; a.ld = DM;
        u32x4* db = (u32x4*)(dd + (size_t)e * DM * DEXP) + k8 * 1024;
#pragma unroll
        for (int i = 0; i < 4; ++i) a.d[i] = db + rowmap<MAP_IL8>(256 * cg + 64 * i + lane); }
}
__device__ __forceinline__ void conv_experts_ch(Ctx& C, const float* wg, const float* wu, const float* wd, int nexp, bf16_t* dgu, bf16_t* dd, bool with_down) {
    int lane_ = (int)threadIdx.x; asm volatile("" : "+v"(lane_)); lane_ &= 63;
    const int gw = C.bid * NWAVES + __builtin_amdgcn_readfirstlane((int)threadIdx.x >> 6), ngw = C.G * NWAVES, lane = lane_;
    const int ngu = nexp * 256, ntask = ngu + (with_down ? nexp * 128 : 0);
#pragma unroll 1
    for (int t0 = gw; t0 < ntask; t0 += 2 * ngw) {
        const int t1 = t0 + ngw; const bool has1 = t1 < ntask;
        CvAddr a0, a1; cv_addr(a0, t0, ngu, wg, wu, wd, dgu, dd, lane); cv_addr(a1, has1 ? t1 : t0, ngu, wg, wu, wd, dgu, dd, lane);
        float v0[8][4], v1[8][4];
#pragma unroll
        for (int j = 0; j < 8; ++j)
#pragma unroll
            for (int i = 0; i < 4; ++i) v0[j][i] = a0.s[(size_t)j * a0.ld + 64 * i];
        if (has1) {
#pragma unroll
            for (int j = 0; j < 8; ++j)
#pragma unroll
                for (int i = 0; i < 4; ++i) v1[j][i] = a1.s[(size_t)j * a1.ld + 64 * i];
        } else {
#pragma unroll
            for (int j = 0; j < 8; ++j)
#pragma unroll
                for (int i = 0; i < 4; ++i) v1[j][i] = 0.f;
        }
#pragma unroll
        for (int i = 0; i < 4; ++i) { u32x4 o; o.x = cvt_pk_bf16(v0[0][i], v0[1][i]); o.y = cvt_pk_bf16(v0[2][i], v0[3][i]); o.z = cvt_pk_bf16(v0[4][i], v0[5][i]); o.w = cvt_pk_bf16(v0[6][i], v0[7][i]); *a0.d[i] = o; }
        if (has1) {
#pragma unroll
            for (int i = 0; i < 4; ++i) { u32x4 o; o.x = cvt_pk_bf16(v1[0][i], v1[1][i]); o.y = cvt_pk_bf16(v1[2][i], v1[3][i]); o.z = cvt_pk_bf16(v1[4][i], v1[5][i]); o.w = cvt_pk_bf16(v1[6][i], v1[7][i]); *a1.d[i] = o; }
        }
    }
}

__device__ __forceinline__ void ada_units(Ctx& C, KIn kin) {
    LAS float* cond = (LAS float*)C.lds;
    LAS float* part = cond + 4096;
    for (int i = C.tid; i < 4096; i += NTHREADS) cond[i] = siluf_(kin[I_C][i]);
    __syncthreads();
    float* ADA = (float*)(C.ws + WS_ADA); float* ADAKV = (float*)(C.ws + WS_ADAKV);
    for (int u = C.bid; u < 224; u += C.G) {
        const int col0 = 64 * u; const float* W; const float* bias; float* outp; int ld, ostride;
        if (col0 < 12288) { const int l = col0 / 6144, c = col0 % 6144; W = kin[I_WADA] + (size_t)l * DM * 6144 + c; ld = 6144; bias = kin[I_BADA] + l * 6144 + c; outp = ADA + (size_t)l * 4 * 6144 + c; ostride = 6144; }
        else { const int c = col0 - 12288; W = kin[I_WADAKV] + c; ld = 2048; bias = kin[I_BADAKV] + c; outp = ADAKV + c; ostride = 2048; }
        const int kq = C.tid >> 6, cl = C.tid & 63;
        float a0 = 0.f, a1 = 0.f, a2 = 0.f, a3 = 0.f;
#pragma unroll 16
        for (int k = 128 * kq; k < 128 * kq + 128; ++k) { const float w = W[(size_t)k * ld + cl]; a0 += cond[k] * w; a1 += cond[1024 + k] * w; a2 += cond[2048 + k] * w; a3 += cond[3072 + k] * w; }
        part[(kq * 4 + 0) * 64 + cl] = a0; part[(kq * 4 + 1) * 64 + cl] = a1; part[(kq * 4 + 2) * 64 + cl] = a2; part[(kq * 4 + 3) * 64 + cl] = a3;
        __syncthreads();
        if (C.tid < 256) { const int b = C.tid >> 6; float s = bias[cl];
#pragma unroll
            for (int q = 0; q < 8; ++q) s += part[(q * 4 + b) * 64 + cl];
            outp[(size_t)b * ostride + cl] = s; }
        __syncthreads();
    }
}
__device__ __forceinline__ void misc_tables(Ctx& C, KIn kin) {
    float* ROPE = (float*)(C.ws + WS_ROPE);
    for (int i = C.bid * NTHREADS + C.tid; i < NTOK * 8; i += C.G * NTHREADS) { const int t = i >> 3, f = i & 7;
        const float invf = exp2f(-(float)f * (18.931568569324174f / 8.0f));
        const float ang = (float)C.pos[t] * invf; ROPE[(size_t)t * 16 + f] = cosf(ang); ROPE[(size_t)t * 16 + 8 + f] = sinf(ang); }
    if (C.bid == 0 && C.wave == 0) {
        float* MF = (float*)(C.ws + WS_MF);
        const int d = C.lane;
        float qa = fabsf(kin[I_QNA][d]), ka = fabsf(kin[I_KNA][d]), qb = fabsf(kin[I_QNB][d]), k0 = fabsf(kin[I_KNB][d]), k1 = fabsf(kin[I_KNB][64 + d]), k2 = fabsf(kin[I_KNB][128 + d]);
#pragma unroll
        for (int o = 1; o < 64; o <<= 1) { qa = fmaxf(qa, __shfl_xor(qa, o)); ka = fmaxf(ka, __shfl_xor(ka, o)); qb = fmaxf(qb, __shfl_xor(qb, o)); k0 = fmaxf(k0, __shfl_xor(k0, o)); k1 = fmaxf(k1, __shfl_xor(k1, o)); k2 = fmaxf(k2, __shfl_xor(k2, o)); }
        const float f = 8.f * LOG2E * 1.002f;
        if (d == 0) { MF[0] = f * qa * ka; MF[1] = f * qb * k0; MF[2] = f * qb * k1; MF[3] = f * qb * k2; }
    }
}

__device__ __forceinline__ void split8(const f32x4 a, const f32x4 b, u32x4& hi, u32x4& lo) {
    hi.x = cvt_pk_bf16(a[0], a[1]); hi.y = cvt_pk_bf16(a[2], a[3]); hi.z = cvt_pk_bf16(b[0], b[1]); hi.w = cvt_pk_bf16(b[2], b[3]);
    lo.x = cvt_pk_bf16(a[0] - __builtin_bit_cast(float, hi.x << 16), a[1] - __builtin_bit_cast(float, hi.x & 0xffff0000u));
    lo.y = cvt_pk_bf16(a[2] - __builtin_bit_cast(float, hi.y << 16), a[3] - __builtin_bit_cast(float, hi.y & 0xffff0000u));
    lo.z = cvt_pk_bf16(b[0] - __builtin_bit_cast(float, hi.z << 16), b[1] - __builtin_bit_cast(float, hi.z & 0xffff0000u));
    lo.w = cvt_pk_bf16(b[2] - __builtin_bit_cast(float, hi.w << 16), b[3] - __builtin_bit_cast(float, hi.w & 0xffff0000u));
}
struct NormVar { const float* gain; const float* shift; const float* scale; bf16_t* out; };
template <int NV, int NW  , class EpiS>
__device__ __forceinline__ void norm_tile(Ctx& C, int tok0, const float* h, const NormVar (&V)[NV], int skv, const float* W, int ldw, int c0, int ncols, const EpiS& ES) {
    LAS float* GV = (LAS float*)C.lds;
    LAS float* SV = GV + 1024;
    LAS float* RS = SV + 1024;
    LAS float* WL = RS + 128;
    int lane_ = C.lane; asm volatile("" : "+v"(lane_));
    const int lane = lane_, wid = C.wave;
    {
        f32x4 G[NV][4], S[NV][4];
#pragma unroll
        for (int v = 0; v < NV; ++v)
#pragma unroll
            for (int j = 0; j < 4; ++j) { const int k = (64 * j + lane) * 4; const f32x4 gn = *(const f32x4*)(V[v].gain + k), sc = *(const f32x4*)(V[v].scale + k); G[v][j] = gn * (sc + 1.f); S[v][j] = *(const f32x4*)(V[v].shift + k);
                if (v == skv && wid == 0) { *(LAS f32x4*)(GV + k) = G[v][j]; *(LAS f32x4*)(SV + k) = S[v][j]; } }
#pragma unroll 4
        for (int i = 0; i < 16; ++i) {
            const int row = tok0 + 16 * wid + i;
            const f32x4* xr = (const f32x4*)(h + (size_t)row * DM) + lane;
            f32x4 x[4]; float ss = 0.f;
#pragma unroll
            for (int j = 0; j < 4; ++j) { x[j] = xr[64 * j]; ss += (x[j][0] * x[j][0] + x[j][1] * x[j][1]) + (x[j][2] * x[j][2] + x[j][3] * x[j][3]); }
            const float rstd = rsqrtf(wave_sum(ss) * (1.f / DM) + EPSN);
            if (lane == 0) RS[16 * wid + i] = rstd;
#pragma unroll
            for (int v = 0; v < NV; ++v) { u32x2* o8 = (u32x2*)(V[v].out + (size_t)row * DM) + lane;
#pragma unroll
                for (int j = 0; j < 4; ++j) { const f32x4 uu = x[j] * rstd * G[v][j] + S[v][j]; u32x2 w; w.x = cvt_pk_bf16(uu[0], uu[1]); w.y = cvt_pk_bf16(uu[2], uu[3]); o8[64 * j] = w; } }
        }
    }
    __syncthreads();
    f32x16 acc0 = (f32x16){}, acc1 = (f32x16){};
    const int tl = 32 * wid + (lane & 31), half = lane >> 5;
    const float rstd = (wid < 4) ? RS[tl] : 0.f;
    const float* hrow = h + (size_t)(tok0 + (wid < 4 ? tl : 0)) * DM;
    LAS unsigned char* WHI = (LAS unsigned char*)WL; LAS unsigned char* WLO = WHI + 32 * NW * 16;
#pragma unroll 1
    for (int kc = 0; kc < 4; ++kc) {
        {
            constexpr int NP = 32 * NW / NTHREADS;
            float wv[NP][8];
#pragma unroll
            for (int q = 0; q < NP; ++q) { const int p = C.tid + q * NTHREADS, n = p % NW, kg = p / NW;
#pragma unroll
                for (int i = 0; i < 8; ++i) wv[q][i] = (n < ncols) ? W[(size_t)(kc * 256 + 8 * kg + i) * ldw + c0 + n] : 0.f; }
#pragma unroll
            for (int q = 0; q < NP; ++q) { const int p = C.tid + q * NTHREADS;
                u32x4 hw, lw; split8((f32x4){wv[q][0], wv[q][1], wv[q][2], wv[q][3]}, (f32x4){wv[q][4], wv[q][5], wv[q][6], wv[q][7]}, hw, lw);
                *(LAS u32x4*)(WHI + p * 16) = hw; *(LAS u32x4*)(WLO + p * 16) = lw; }
        }
        __syncthreads();
        if (wid < 4) {
#pragma unroll 1
            for (int ks4 = 0; ks4 < 16; ks4 += 4) {
                f32x4 hv[4][2];
#pragma unroll
                for (int jj = 0; jj < 4; ++jj) { const float* hp = hrow + kc * 256 + 16 * (ks4 + jj) + 8 * half; hv[jj][0] = *(const f32x4*)hp; hv[jj][1] = *(const f32x4*)(hp + 4); }
#pragma unroll
                for (int jj = 0; jj < 4; ++jj) {
                    const int ks = ks4 + jj, k = kc * 256 + 16 * ks + 8 * half;
                    const f32x4 u0 = hv[jj][0] * rstd * *(const LAS f32x4*)(GV + k) + *(const LAS f32x4*)(SV + k), u1 = hv[jj][1] * rstd * *(const LAS f32x4*)(GV + k + 4) + *(const LAS f32x4*)(SV + k + 4);
                    u32x4 hw, lw; split8(u0, u1, hw, lw);
                    const bf16x8 bhi = __builtin_bit_cast(bf16x8, hw), blo = __builtin_bit_cast(bf16x8, lw);
                    const int fo = ((2 * ks + half) * NW + (lane & 31)) * 16;
                    const bf16x8 ah0 = *(const LAS bf16x8*)(WHI + fo), al0 = *(const LAS bf16x8*)(WLO + fo);
                    acc0 = __builtin_amdgcn_mfma_f32_32x32x16_bf16(ah0, bhi, acc0, 0, 0, 0); acc0 = __builtin_amdgcn_mfma_f32_32x32x16_bf16(ah0, blo, acc0, 0, 0, 0); acc0 = __builtin_amdgcn_mfma_f32_32x32x16_bf16(al0, bhi, acc0, 0, 0, 0);
                    if (NW == 64) { const bf16x8 ah1 = *(const LAS bf16x8*)(WHI + fo + 512), al1 = *(const LAS bf16x8*)(WLO + fo + 512);
                        acc1 = __builtin_amdgcn_mfma_f32_32x32x16_bf16(ah1, bhi, acc1, 0, 0, 0); acc1 = __builtin_amdgcn_mfma_f32_32x32x16_bf16(ah1, blo, acc1, 0, 0, 0); acc1 = __builtin_amdgcn_mfma_f32_32x32x16_bf16(al1, bhi, acc1, 0, 0, 0); }
                }
            }
        }
        __syncthreads();
    }
    ES(C, tok0, acc0, acc1);
}

struct EpiForget { float* logf; const float* bf;
    __device__ __forceinline__ void operator()(Ctx& C, int tok0, const f32x16& a0, const f32x16&) const {
        if (C.wave >= 4) return;
        const int t = tok0 + 32 * C.wave + (C.lane & 31), hi = C.lane >> 5;
#pragma unroll
        for (int r = 0; r < 16; ++r) { const int n = crow(r, hi); if (n < 16) { const float x = a0[r] + bf[n]; logf[(size_t)n * NTOK + t] = fminf(x, 0.f) - log1pf(__expf(-fabsf(x))); } }
    } };
struct EpiGates { float* gates; const float* bg;
    __device__ __forceinline__ void operator()(Ctx& C, int tok0, const f32x16& a0, const f32x16& a1) const {
        if (C.wave >= 4) return;
        const int t = tok0 + 32 * C.wave + (C.lane & 31), hi = C.lane >> 5;
#pragma unroll
        for (int r = 0; r < 16; ++r) { const int n = crow(r, hi); gates[(size_t)t * 48 + n] = sigmoidf_(a0[r] + bg[n]); if (n + 32 < 48) gates[(size_t)t * 48 + n + 32] = sigmoidf_(a1[r] + bg[n + 32]); }
    } };
struct EpiRoute { const float* brout; unsigned* cnt; int* toke; int* tokp; int* rowtok; float* roww;
    __device__ __forceinline__ void operator()(Ctx& C, int tok0, const f32x16& a0, const f32x16& a1) const {
        LAS int* hist = (LAS int*)(C.lds + 100000); LAS int* base = hist + 64;
        const int lane = C.lane, hi = lane >> 5, t = tok0 + 32 * C.wave + (lane & 31);
        const int ch = tok0 / CHTOK;
        if (C.tid < 64) hist[C.tid] = 0;
        int te[8]; float tw[8]; int rk[8];
        if (C.wave < 4) {
            float sc[32]; unsigned key[32];
#pragma unroll
            for (int r = 0; r < 16; ++r) { const int e = crow(r, hi);
                sc[r] = sigmoidf_(a0[r]); sc[16 + r] = sigmoidf_(a1[r]);
                const float v0 = sc[r] + brout[e], v1 = sc[16 + r] + brout[e + 32];
                const unsigned u0 = __float_as_uint(v0), u1 = __float_as_uint(v1);
                key[r] = (u0 & 0x80000000u) ? ~u0 : (u0 | 0x80000000u); key[16 + r] = (u1 & 0x80000000u) ? ~u1 : (u1 | 0x80000000u); }
            float ssum = 0.f;
#pragma unroll
            for (int k = 0; k < 8; ++k) {
                unsigned mx = 0u;
#pragma unroll
                for (int i = 0; i < 32; ++i) mx = mx > key[i] ? mx : key[i];
                { const unsigned o = (unsigned)__shfl_xor((int)mx, 32); mx = mx > o ? mx : o; }
                int idx = 64;
#pragma unroll
                for (int i = 0; i < 32; ++i) { const int e = crow(i & 15, hi) + 32 * (i >> 4); idx = (key[i] == mx && e < idx) ? e : idx; }
                { const int o = __shfl_xor(idx, 32); idx = o < idx ? o : idx; }
                float sk = -1.f;
#pragma unroll
                for (int i = 0; i < 32; ++i) { const int e = crow(i & 15, hi) + 32 * (i >> 4); const bool hit = (e == idx); sk = hit ? sc[i] : sk; key[i] = hit ? 0u : key[i]; }
                { const float o = __shfl_xor(sk, 32); sk = fmaxf(sk, o); }
                te[k] = idx; tw[k] = sk; ssum += sk;
            }
            const float inv = 2.5f / ssum;
#pragma unroll
            for (int k = 0; k < 8; ++k) tw[k] *= inv;
        }
        __syncthreads();
        if (C.wave < 4 && hi == 0) {
#pragma unroll
            for (int k = 0; k < 8; ++k) rk[k] = atomicAdd((int*)(hist + te[k]), 1);
        }
        __syncthreads();
        if (C.tid < 64) base[C.tid] = (int)atomicAdd(cnt + ch * 64 + C.tid, (unsigned)hist[C.tid]);
        __syncthreads();
        if (C.wave < 4 && hi == 0) {
            i32x4 e0, e1, p0, p1;
#pragma unroll
            for (int k = 0; k < 8; ++k) { const int e = te[k], p = base[e] + rk[k];
                if (k < 4) { e0[k] = e; p0[k] = p; } else { e1[k - 4] = e; p1[k - 4] = p; }
                rowtok[((size_t)ch * 64 + e) * CHTOK + p] = t; roww[((size_t)ch * 64 + e) * CHTOK + p] = tw[k]; }
            *(i32x4*)(toke + (size_t)t * 8) = e0; *(i32x4*)(toke + (size_t)t * 8 + 4) = e1; *(i32x4*)(tokp + (size_t)t * 8) = p0; *(i32x4*)(tokp + (size_t)t * 8 + 4) = p1;
        }
        __syncthreads();
    } };

__device__ __forceinline__ pg8::MoeTab moe_tables(Ctx& C, const unsigned* cnt_g, const LAS int** pstart_out, bool with_shared = false) {
    LAS int* cnt = (LAS int*)(C.lds + MISC_OFF + 1024); LAS int* tstart = cnt + 68; LAS int* pstart = tstart + 68; LAS unsigned char* tile_e = (LAS unsigned char*)(pstart + 68);
    const int ne = with_shared ? NEXP + 1 : NEXP;
    __syncthreads();
    if (C.tid < 64) cnt[C.tid] = (int)__hip_atomic_load(cnt_g + C.tid, __ATOMIC_RELAXED, __HIP_MEMORY_SCOPE_AGENT);
    if (C.tid == 64) cnt[64] = with_shared ? CHTOK : 0;
    __syncthreads();
    if (C.tid < 64) {
        const int e = C.tid; const int nt = (cnt[e] + 255) >> 8;
        int inc = nt;
#pragma unroll
        for (int o = 1; o < 64; o <<= 1) { const int v = __shfl_up(inc, o); if (C.lane >= o) inc += v; }
        if (e == 63) tstart[67] = inc;
        asm volatile("s_waitcnt lgkmcnt(0)" ::: "memory");
        if (e < 64) { tstart[e] = inc - nt; pstart[e] = (inc - nt) * 256; if (e == 63 && ne == 64) { tstart[64] = inc; pstart[64] = inc * 256; } }
    }
    __syncthreads();
    if (ne > 64 && C.tid == 0) { const int base = tstart[67], n64 = (cnt[64] + 255) >> 8; tstart[64] = base; pstart[64] = base * 256; tstart[65] = base + n64; pstart[65] = (base + n64) * 256; }
    __syncthreads();
    if (C.tid < ne) { for (int m = tstart[C.tid]; m < tstart[C.tid + 1]; ++m) tile_e[m] = (unsigned char)C.tid; }
    __syncthreads();
    pg8::MoeTab T; T.tstart = tstart; T.cnt = cnt; T.tile_e = tile_e; T.ntiles = tstart[ne];
    *pstart_out = pstart;
    return T;
}

__device__ __forceinline__ void cumsum_unit(Ctx& C, int bh) {
    const float* LOGF = (const float*)(C.ws + WS_LOGF); float* CUM = (float*)(C.ws + WS_CUM);
    LAS float* wt = (LAS float*)(C.lds + MISC_OFF + 3072);
    const int b = bh >> 4, hh = bh & 15;
    float v[16]; float run = 0.f;
#pragma unroll
    for (int i = 0; i < 16; ++i) { run += LOGF[(size_t)hh * NTOK + (size_t)b * SEQ + 16 * C.tid + i]; v[i] = run; }
    float inc = run;
#pragma unroll
    for (int o = 1; o < 64; o <<= 1) { const float n = __shfl_up(inc, o); if (C.lane >= o) inc += n; }
    if (C.lane == 63) wt[C.wave] = inc;
    __syncthreads();
    float pre = inc - run;
    for (int w = 0; w < C.wave; ++w) pre += wt[w];
#pragma unroll
    for (int i = 0; i < 16; ++i) CUM[(size_t)bh * SEQ + 16 * C.tid + i] = (pre + v[i]) * LOG2E;
    __syncthreads();
}

__device__ __forceinline__ void compress2(Ctx& C, KIn kin) {
    LAS float* w2l = (LAS float*)C.lds;
    LAS float* hl = (LAS float*)(C.lds + 65536) + C.wave * 256;
    const float* SLAB = (const float*)(C.ws + WS_SLAB);
    const int gw = C.bid * NWAVES + C.wave, ngw = C.G * NWAVES;
#pragma unroll 1
    for (int kind = 0; kind < 2; ++kind) {
        const float* w2 = kin[kind == 0 ? I_WCK2 : I_WCV2];
        __syncthreads();
        { f32x4 wv[8];
#pragma unroll
          for (int q = 0; q < 8; ++q) wv[q] = *(const f32x4*)(w2 + 4 * (C.tid + q * NTHREADS));
#pragma unroll
          for (int q = 0; q < 8; ++q) *(LAS f32x4*)(w2l + 4 * (C.tid + q * NTHREADS)) = wv[q]; }
        __syncthreads();
        bf16_t* dst = (bf16_t*)(C.ws + (kind == 0 ? WS_KCMP : WS_VCMP));
        for (int row = gw; row < 2048; row += ngw) {
            const float* sl = SLAB + (size_t)kind * 8 * 2048 * 256 + (size_t)row * 256;
            float sv[4][8];
#pragma unroll
            for (int i = 0; i < 4; ++i)
#pragma unroll
                for (int ks = 0; ks < 8; ++ks) sv[i][ks] = sl[(size_t)ks * 2048 * 256 + C.lane + 64 * i];
#pragma unroll
            for (int i = 0; i < 4; ++i) { float s = 0.f;
#pragma unroll
                for (int ks = 0; ks < 8; ++ks) s += sv[i][ks];
                hl[C.lane + 64 * i] = siluf_(s); }
            LDS_WAIT();
            float a0 = 0.f, a1 = 0.f, a2 = 0.f, a3 = 0.f;
#pragma unroll 8
            for (int j = 0; j < 256; j += 4) { const f32x4 hv = *(const LAS f32x4*)(hl + j);
                a0 += hv[0] * w2l[j * 64 + C.lane]; a1 += hv[1] * w2l[(j + 1) * 64 + C.lane]; a2 += hv[2] * w2l[(j + 2) * 64 + C.lane]; a3 += hv[3] * w2l[(j + 3) * 64 + C.lane]; }
            const float acc = (a0 + a1) + (a2 + a3);
            float o = acc;
            if (kind == 0) { const float ss = wave_sum(acc * acc); o = acc * rsqrtf(ss * (1.f / 64.f) + EPSN) * kin[I_KNB][C.lane]; }
            dst[(size_t)row * 64 + C.lane] = (bf16_t)f2bf(o);
            LDS_WAIT();
        }
    }
    __syncthreads();
}
#define XB_TMO      128
#define XB_XCNT(j)  (256  + 64 * (j))
#define XB_XSUB(j)  (1280 + 64 * (j))
#define XB_XGEN(j)  (2304 + 64 * (j))
#define XB_TOP      3328
#define XB_TOPGEN   3392
#define XCD_BAR_WORDS 3456
#define XB_SPIN_CAP (1u << 22)
__device__ __forceinline__ unsigned xb_ld(unsigned* p)              { return __hip_atomic_load(p, __ATOMIC_RELAXED, __HIP_MEMORY_SCOPE_AGENT); }
__device__ __forceinline__ unsigned xb_add(unsigned* p, unsigned v) { return __hip_atomic_fetch_add(p, v, __ATOMIC_RELAXED, __HIP_MEMORY_SCOPE_AGENT); }
__device__ __forceinline__ unsigned xb_xcc_id() { return (unsigned)__builtin_amdgcn_s_getreg((3 << 11) | 20) & 0xFu; }
#define XB_SPIN(cond, bar) do { unsigned _sp = 0; while (cond) { __builtin_amdgcn_s_sleep(1); \
    if ((++_sp & 255u) == 0u) { if (xb_ld(&(bar)[XB_TMO])) break; if (_sp > XB_SPIN_CAP) { atomicAdd(&(bar)[XB_TMO], 1u); break; } } } } while (0)
struct XcdBarrier { unsigned* bar; unsigned x; volatile LAS unsigned* st; };
__device__ __forceinline__ XcdBarrier xcd_barrier_post(unsigned* bar, volatile LAS unsigned* st) {
    XcdBarrier b; b.bar = bar; b.x = xb_xcc_id(); b.st = st;
    if (threadIdx.x == 0) (void)xb_add(&bar[XB_XCNT(b.x)], 1u);
    return b;
}
__device__ __forceinline__ void xcd_barrier_complete(unsigned* bar, unsigned x, unsigned& nloc, unsigned& nx) {
    const unsigned G = gridDim.x * gridDim.y * gridDim.z;
    unsigned sum, cnt, mine, sp = 0u;
    for (;;) {
        sum = 0u; cnt = 0u; mine = 0u;
#pragma unroll
        for (unsigned j = 0; j < 16; ++j) { const unsigned c = xb_ld(&bar[XB_XCNT(j)]); sum += c; cnt += (c > 0u) ? 1u : 0u; mine = (j == x) ? c : mine; }
        if (sum == G) break;
        __builtin_amdgcn_s_sleep(1);
        if ((++sp & 255u) == 0u) { if (xb_ld(&bar[XB_TMO])) break; if (sp > XB_SPIN_CAP) { atomicAdd(&bar[XB_TMO], 1u); break; } }
    }
    nloc = mine > 0u ? mine : 1u; nx = cnt > 0u ? cnt : 1u;
}
__device__ __forceinline__ void xcd_barrier(const XcdBarrier& b) {
    asm volatile("s_waitcnt vmcnt(0)" ::: "memory");
    __syncthreads();
    if (threadIdx.x == 0) {
        unsigned* bar = b.bar;
        __builtin_amdgcn_s_waitcnt(0);
        unsigned nloc = b.st[0], nx = b.st[1];
        if (nloc == 0u) { xcd_barrier_complete(bar, b.x, nloc, nx); b.st[0] = nloc; b.st[1] = nx; }
        const unsigned old = xb_add(&bar[XB_XSUB(b.x)], 1u);
        const unsigned gen = old / nloc;
        if (old + 1u == (gen + 1u) * nloc) {
            __builtin_amdgcn_fence(__ATOMIC_RELEASE, "agent");
            asm volatile("s_waitcnt vmcnt(0)" ::: "memory");
            const unsigned og = xb_add(&bar[XB_TOP], 1u);
            const unsigned tg = og / nx;
            if (og + 1u == (tg + 1u) * nx) xb_add(&bar[XB_TOPGEN], 1u);
            else XB_SPIN(xb_ld(&bar[XB_TOPGEN]) == tg, bar);
            __builtin_amdgcn_fence(__ATOMIC_ACQUIRE, "agent");
            xb_add(&bar[XB_XGEN(b.x)], 1u);
            asm volatile("s_waitcnt vmcnt(0)" ::: "memory");
        } else {
            XB_SPIN(xb_ld(&bar[XB_XGEN(b.x)]) == gen, bar);
            __builtin_amdgcn_fence(__ATOMIC_ACQUIRE, "agent");
            asm volatile("s_waitcnt vmcnt(0)" ::: "memory");
        }
    }
    __syncthreads();
}

#ifndef MK_ONE_LAUNCH
#define MK_ONE_LAUNCH 1
#endif
constexpr int N_PHASES = 25;

__global__ void __launch_bounds__(NTHREADS, 2) fwd_kernel(Args args) {
    extern __shared__ __attribute__((aligned(16))) unsigned char lds_raw[];
    { volatile LAS unsigned* MISC0 = (volatile LAS unsigned*)((LAS unsigned char*)lds_raw + MISC_OFF); if (threadIdx.x < 16) MISC0[threadIdx.x] = 0u; }
    __syncthreads();
#if MK_ONE_LAUNCH
    XcdBarrier bar = xcd_barrier_post((unsigned*)(args.ws + WS_CTL) + CW_BAR, (volatile LAS unsigned*)((LAS unsigned char*)lds_raw + MISC_OFF) + 8);
#define GRID_BAR() xcd_barrier(bar)
#else
#define GRID_BAR() do {} while (0)
#endif
#if MK_ONE_LAUNCH
    constexpr int lo = 0, hi = N_PHASES;
#else
    const int lo = args.ph_lo, hi = args.ph_hi;
#endif
#ifndef PHMASK
#define PHMASK 0x1ffffffu
#endif
#define INR(k) (lo <= (k) && (k) < hi)
#define PHB(b) ((PHMASK >> (b)) & 1u)
#define IN(k) (PHB(k) && INR(k))
#define SEAM(k) do { if (INR(k) && INR((k) + 1)) GRID_BAR(); } while (0)
#ifndef REPMASK
#define REPMASK 0u
#endif
#define NREP(b) (((REPMASK >> (b)) & 1u) ? 2 : 1)
#define PH_BEGIN \
    unsigned zo_; asm volatile("s_mov_b32 %0, 0" : "=s"(zo_)); \
    const AS4 char* kb_ = (const AS4 char*)__builtin_amdgcn_kernarg_segment_ptr() + zo_; \
    KIn kin = (KIn)kb_; \
    Ctx C; C.out = *(float* const AS4*)(kb_ + 8 * N_IN); C.ws = *(unsigned char* const AS4*)(kb_ + 8 * N_IN + 8); C.pos = (const int*)kin[I_POS]; \
    C.lds = (LAS unsigned char*)lds_raw; C.ctl = (unsigned*)(C.ws + WS_CTL); \
    { int t_ = threadIdx.x; asm volatile("" : "+v"(t_)); C.tid = t_; } C.lane = C.tid & 63; C.wave = __builtin_amdgcn_readfirstlane(C.tid >> 6); C.G = gridDim.x; C.bid = blockIdx.x; \
    const int vcu = (C.G % 8 == 0) ? (C.bid % 8) * (C.G / 8) + C.bid / 8 : C.bid; (void)vcu; \
    const float* ADA0 = (const float*)(C.ws + WS_ADA); (void)ADA0; const float* ADAKV = (const float*)(C.ws + WS_ADAKV); (void)ADAKV; const float* MF = (const float*)(C.ws + WS_MF); (void)MF; \
    bf16_t* U = (bf16_t*)(C.ws + WS_U); (void)U;

    for (int rp_ = 0; rp_ < NREP(0); ++rp_) if (IN(0)) { PH_BEGIN
        ada_units(C, kin);
        misc_tables(C, kin);
        const int gw = C.bid * NWAVES + C.wave, ngw = C.G * NWAVES;
        {
            LAS float* scr = (LAS float*)(C.lds + C.wave * 16384);
            constexpr int N0 = 16 * 48, N1 = N0 + 256, N2 = N1 + 16 * 24, N3 = N2 + 256, N4 = N3 + 256, N5 = N4 + 64 * 4, N6 = N5 + 64 * 4;
            for (int it = gw; it < N6; it += ngw) {
                if (it < N0)      { const int r = it,      kb = r / 48, nb = r % 48; xitem64<MAP_HPERM>(kin[I_WINA], 3088, 64 * nb, 64 * kb, (bf16_t*)(C.ws + WS_WQKV), DM, 0, 64 * nb, scr, C.lane); }
                else if (it < N1) { const int r = it - N0, kb = r / 16, nb = r % 16; xitem64<MAP_ID>(kin[I_WOA], DM, 64 * nb, 64 * kb, (bf16_t*)(C.ws + WS_WOA), DM, 0, 64 * nb, scr, C.lane); }
                else if (it < N2) { const int r = it - N1, kb = r / 24, nb = r % 24; xitem64<MAP_HPERM>(kin[I_WKVB], 1536, 64 * nb, 64 * kb, (bf16_t*)(C.ws + WS_WKV), DM, 0, 64 * nb, scr, C.lane); }
                else if (it < N3) { const int r = it - N2, kb = r / 16, nb = r % 16; xitem64<MAP_HPERM>(kin[I_WINB], 1072, 64 * nb, 64 * kb, (bf16_t*)(C.ws + WS_WQB), DM, 0, 64 * nb, scr, C.lane); }
                else if (it < N4) { const int r = it - N3, kb = r / 16, nb = r % 16; xitem64<MAP_ID>(kin[I_WOB], DM, 64 * nb, 64 * kb, (bf16_t*)(C.ws + WS_WOB), DM, 0, 64 * nb, scr, C.lane); }
                else if (it < N5) { const int r = it - N4, kb = r / 4,  nb = r % 4;  xitem64<MAP_ID>(kin[I_WCK1], 256, 64 * nb, 64 * kb, (bf16_t*)(C.ws + WS_WC1K), 4096, 0, 64 * nb, scr, C.lane); }
                else              { const int r = it - N5, kb = r / 4,  nb = r % 4;  xitem64<MAP_ID>(kin[I_WCV1], 256, 64 * nb, 64 * kb, (bf16_t*)(C.ws + WS_WC1V), 4096, 0, 64 * nb, scr, C.lane); }
            }
        }
        conv_experts_ch(C, kin[I_WSG], kin[I_WSU], kin[I_WSD], 2, (bf16_t*)(C.ws + WS_WSGU), (bf16_t*)(C.ws + WS_WSD), false);
        conv_experts(C, kin[I_WSG], kin[I_WSU], kin[I_WSD], 2, (bf16_t*)(C.ws + WS_WSGU), (bf16_t*)(C.ws + WS_WSD), gw, ngw, true);
        __syncthreads();
    }
#pragma unroll 1
    for (int layer = 0; layer < 2; ++layer) {
#define CONV_LAYER_EXPERTS() conv_experts_ch(C, kin[I_WEG] + (size_t)layer * NEXP * DM * DEXP, kin[I_WEU] + (size_t)layer * NEXP * DM * DEXP, kin[I_WED] + (size_t)layer * NEXP * DEXP * DM, NEXP, (bf16_t*)(C.ws + WS_WEGU), (bf16_t*)(C.ws + WS_WED), true)
        if (layer == 0) {
            SEAM(0);
            for (int rp_ = 0; rp_ < NREP(1); ++rp_) if (IN(1)) { PH_BEGIN const float* ADA = ADA0 + (size_t)layer * 4 * 6144; (void)ADA;
                for (int tile = C.bid; tile < NTOK / 128; tile += C.G) {
                    const int tok0 = tile * 128, b = tok0 / SEQ;
                    const NormVar V[1] = {{kin[I_NMIX], ADA + (size_t)b * 6144, ADA + (size_t)b * 6144 + 1024, U}};
                    EpiForget ES{(float*)(C.ws + WS_LOGF), kin[I_BFA]};
                    norm_tile<1, 32>(C, tok0, kin[I_X], V, 0, kin[I_WINA], 3088, 3072, 16, ES);
                    __syncthreads();
                }
            }
            SEAM(1);
            for (int rp_ = 0; rp_ < NREP(2); ++rp_) if (IN(2)) { PH_BEGIN const float* ADA = ADA0 + (size_t)layer * 4 * 6144; (void)ADA;
                { pg8::Gemm g{U, DM, DM, DM};
                  pg8::DenseSched S; S.init((const bf16_t*)(C.ws + WS_WQKV), DM, DM, NTOK, 3072, C.G, C.bid);
                  pg8::EpiQKV E{(bf16_t*)(C.ws + WS_Q), (size_t)(WS_K - WS_Q) / 2, kin[I_QNA], kin[I_KNA]};
                  pg8::gemm_phase(C.lds, g, S, E); }
                for (int bh = C.bid; bh < NB * NH; bh += C.G) cumsum_unit(C, bh);
            }
            SEAM(2);
            for (int rp_ = 0; rp_ < NREP(3); ++rp_) if (IN(3)) { PH_BEGIN const float* ADA = ADA0 + (size_t)layer * 4 * 6144; (void)ADA;
                const float M2 = MF[0];
                const int cslot = (C.G == 256) ? ((C.bid >> 3) & 7) : 0;
                for (int i = 0;; ++i) {
                    int bh, qb;
                    if (C.G == 256) { if (i >= 8) break; bh = vcu >> 2; const int c4 = vcu & 3, k = i >> 1; qb = (i & 1) ? (8 * k + 7 - c4) : (8 * k + c4); }
                    else { const int u = i * C.G + C.bid; if (u >= NB * NH * 32) break; bh = u >> 5; qb = u & 31; }
                    if (i == cslot) CONV_LAYER_EXPERTS();
                    att::fox_unit((LAS char*)C.lds, bh >> 4, bh & 15, qb, (const bf16_t*)(C.ws + WS_Q), (const bf16_t*)(C.ws + WS_K), (const bf16_t*)(C.ws + WS_V), (bf16_t*)(C.ws + WS_O), (const float*)(C.ws + WS_CUM), M2);
                }
            }
            SEAM(3);
            for (int rp_ = 0; rp_ < NREP(4); ++rp_) if (IN(4)) { PH_BEGIN const float* ADA = ADA0 + (size_t)layer * 4 * 6144; (void)ADA;
                pg8::Gemm g{(const bf16_t*)(C.ws + WS_O), DM, DM, DM};
                pg8::DenseSched S; S.init((const bf16_t*)(C.ws + WS_WOA), DM, DM, NTOK, DM, C.G, C.bid);
                pg8::EpiResid E{kin[I_X], C.out, ADA + 2048};
                pg8::gemm_phase(C.lds, g, S, E);
            }
            SEAM(4);
        } else {
            if (IN(12)) { PH_BEGIN const float* ADA = ADA0 + (size_t)layer * 4 * 6144; (void)ADA;
                for (int tile = C.bid; tile < NTOK / 128; tile += C.G) {
                    const int tok0 = tile * 128, b = tok0 / SEQ;
                    const NormVar V[2] = {{kin[I_NKV], ADAKV + (size_t)b * 2048, ADAKV + (size_t)b * 2048 + 1024, (bf16_t*)(C.ws + WS_SKV)},
                                          {kin[I_NMIX] + DM, ADA + (size_t)b * 6144, ADA + (size_t)b * 6144 + 1024, U}};
                    EpiGates ES{(float*)(C.ws + WS_GATES), kin[I_BGB]};
                    norm_tile<2, 64>(C, tok0, C.out, V, 1, kin[I_WINB], 1072, 1024, 48, ES);
                    __syncthreads();
                }
            }
            SEAM(12);
            for (int rp_ = 0; rp_ < NREP(13); ++rp_) if (IN(13)) { PH_BEGIN const float* ADA = ADA0 + (size_t)layer * 4 * 6144; (void)ADA;
                pg8::Gemm g{(const bf16_t*)(C.ws + WS_SKV), DM, DM, DM};
                pg8::DenseSched S; S.init((const bf16_t*)(C.ws + WS_WKV), DM, DM, NTOK, 1536, C.G, C.bid);
                pg8::EpiKV E{(bf16_t*)(C.ws + WS_ACK), (bf16_t*)(C.ws + WS_KSEL), (size_t)(WS_ACV - WS_ACK) / 2, (size_t)(WS_VSEL - WS_KSEL) / 2,
                              kin[I_PEK], kin[I_PEV], kin[I_KNB], (const float*)(C.ws + WS_ROPE), C.lds};
                pg8::gemm_phase(C.lds, g, S, E);
            }
            SEAM(13);
            for (int rp_ = 0; rp_ < NREP(14); ++rp_) if (IN(14)) { PH_BEGIN const float* ADA = ADA0 + (size_t)layer * 4 * 6144; (void)ADA;
                { pg8::Gemm g{U, DM, DM, DM};
                  pg8::DenseSched S; S.init((const bf16_t*)(C.ws + WS_WQB), DM, DM, NTOK, DM, C.G, C.bid);
                  pg8::EpiQB E{(bf16_t*)(C.ws + WS_QP), (bf16_t*)(C.ws + WS_QR), kin[I_QNB], (const float*)(C.ws + WS_ROPE)};
                  pg8::gemm_phase(C.lds, g, S, E); }
#pragma unroll 1
                for (int kind = 0; kind < 2; ++kind) {
                    pg8::Gemm g{(const bf16_t*)(C.ws + (kind == 0 ? WS_ACK : WS_ACV)), 4096, 4096, 512};
                    pg8::SplitKSched S; S.init((const bf16_t*)(C.ws + (kind == 0 ? WS_WC1K : WS_WC1V)), 4096, 4096, 512, 2048, 8, C.G, (C.bid + 128 * kind) % C.G);
                    pg8::EpiSlab E{(float*)(C.ws + WS_SLAB) + (size_t)kind * 8 * 2048 * 256};
                    pg8::gemm_phase(C.lds, g, S, E);
                }
            }
            SEAM(14);
            if (IN(15)) { PH_BEGIN compress2(C, kin); }
            SEAM(15);
            for (int rp_ = 0; rp_ < NREP(16); ++rp_) if (IN(16)) { PH_BEGIN const float* ADA = ADA0 + (size_t)layer * 4 * 6144; (void)ADA;
                att::NsaArgs A{(const bf16_t*)(C.ws + WS_QP), (const bf16_t*)(C.ws + WS_QR), (const bf16_t*)(C.ws + WS_KCMP), (const bf16_t*)(C.ws + WS_VCMP), (const bf16_t*)(C.ws + WS_KSEL), (const bf16_t*)(C.ws + WS_VSEL),
                               (const bf16_t*)(C.ws + WS_KWIN), (const bf16_t*)(C.ws + WS_VWIN), (const float*)(C.ws + WS_GATES), (bf16_t*)(C.ws + WS_ONSA), MF[1], MF[2], MF[3]};
                const int cslot = (C.G == 256) ? ((C.bid >> 3) & 7) : 0;
                for (int i = 0;; ++i) {
                    int bg, c;
                    if (C.G == 256) { if (i >= 8) break; bg = vcu >> 4; const int j = vcu & 15, k = i >> 1; c = (i & 1) ? (32 * k + 31 - j) : (32 * k + j); }
                    else { const int u = i * C.G + C.bid; if (u >= NB * NG * 128) break; bg = u >> 7; c = u & 127; }
                    if (i == cslot) CONV_LAYER_EXPERTS();
                    att::nsa_unit((LAS char*)C.lds, bg >> 2, bg & 3, c, A);
                }
            }
            SEAM(16);
            if (IN(17)) { PH_BEGIN const float* ADA = ADA0 + (size_t)layer * 4 * 6144; (void)ADA;
                pg8::Gemm g{(const bf16_t*)(C.ws + WS_ONSA), DM, DM, DM};
                pg8::DenseSched S; S.init((const bf16_t*)(C.ws + WS_WOB), DM, DM, NTOK, DM, C.G, C.bid);
                pg8::EpiResid E{C.out, C.out, ADA + 2048};
                pg8::gemm_phase(C.lds, g, S, E);
            }
            SEAM(17);
        }
        const int pm1 = layer == 0 ? 5 : 18;
        if (PHB(5) && INR(pm1)) { PH_BEGIN const float* ADA = ADA0 + (size_t)layer * 4 * 6144;
            for (int tile = C.bid; tile < NTOK / 128; tile += C.G) {
                const int tok0 = tile * 128, b = tok0 / SEQ; const float* ad = ADA + (size_t)b * 6144;
                const NormVar V[1] = {{kin[I_NFFN] + layer * DM, ad + 3072, ad + 4096, U}};
                EpiRoute ES{kin[I_BR] + layer * NEXP, C.ctl + CW_CNT + layer * NCH * 64, (int*)(C.ws + WS_TOKE), (int*)(C.ws + WS_TOKP), (int*)(C.ws + WS_ROWTOK), (float*)(C.ws + WS_ROWW)};
                norm_tile<1, 64>(C, tok0, C.out, V, 0, kin[I_WR] + (size_t)layer * DM * NEXP, NEXP, 0, NEXP, ES);
                __syncthreads();
            }
        }
        SEAM(pm1);
#pragma unroll 1
        for (int step = 0; step <= NCH; ++step) {
            const int pa = pm1 + 1 + 2 * step;
            for (int rp_ = 0; rp_ < NREP(6); ++rp_) if (PHB(6) && INR(pa)) { PH_BEGIN const float* ADA = ADA0 + (size_t)layer * 4 * 6144; (void)ADA;
                bf16_t* ACT = (bf16_t*)(C.ws + WS_ACT); unsigned char* Y = C.ws + WS_Y;
                if (step < NCH) {
                    const int ch = step;
                    const unsigned* cntg = (const unsigned*)(C.ctl + CW_CNT + (layer * NCH + ch) * 64);
                    const int* ROWTOK = (const int*)(C.ws + WS_ROWTOK) + (size_t)ch * 64 * CHTOK;
                    const LAS int* pstart; const pg8::MoeTab T = moe_tables(C, cntg, &pstart, true);
                    pg8::Gemm g{U, DM, 512, DM};
                    pg8::MoeGatherSched S; S.T = T; S.Bt = (const bf16_t*)(C.ws + WS_WEGU); S.Bsh = (const bf16_t*)(C.ws + WS_WSGU) + (size_t)layer * 512 * DM; S.rowtok = ROWTOK; S.nN = 2; S.G = C.G; S.c = C.bid; S.ldb = DM; S.bstride = (size_t)512 * DM; S.tokbase = ch * CHTOK;
                    pg8::EpiGU E{ACT, (bf16_t*)(C.ws + (ch & 1 ? WS_ACTS1 : WS_ACTS)), T};
                    pg8::gemm_phase(C.lds, g, S, E);
                }
                if (step >= 1) {
                    const int ch = step - 1;
                    const unsigned* cntg = (const unsigned*)(C.ctl + CW_CNT + (layer * NCH + ch) * 64);
                    const LAS int* pstart; const pg8::MoeTab T = moe_tables(C, cntg, &pstart); (void)T;
                    pg8::Gemm g{(const bf16_t*)(C.ws + (ch & 1 ? WS_ACTS1 : WS_ACTS)), DEXP, DEXP, DEXP};
                    pg8::DenseSched S; S.init((const bf16_t*)(C.ws + WS_WSD) + (size_t)layer * DM * DEXP, DEXP, DEXP, CHTOK, DM, C.G, C.bid, 0);
                    pg8::EpiCombine E{C.out, Y, (const int*)(C.ws + WS_TOKE), (const int*)(C.ws + WS_TOKP), pstart, ADA + 5120, ch * CHTOK};
                    pg8::gemm_phase(C.lds, g, S, E);
                }
            }
            if (!(layer == 1 && step == NCH)) SEAM(pa);
            if (step < NCH) {
                const int ch = step;
                for (int rp_ = 0; rp_ < NREP(7); ++rp_) if (PHB(7) && INR(pa + 1)) { PH_BEGIN
                    const unsigned* cntg = (const unsigned*)(C.ctl + CW_CNT + (layer * NCH + ch) * 64);
                    const float* ROWW = (const float*)(C.ws + WS_ROWW) + (size_t)ch * 64 * CHTOK;
                    const LAS int* pstart; const pg8::MoeTab T = moe_tables(C, cntg, &pstart);
                    pg8::Gemm g{(const bf16_t*)(C.ws + WS_ACT), DEXP, DM, DEXP};
                    pg8::MoeDownSched S; S.T = T; S.Bt = (const bf16_t*)(C.ws + WS_WED); S.nN = 4; S.G = C.G; S.c = C.bid; S.lda = DEXP; S.ldb = DEXP; S.bstride = (size_t)DM * DEXP;
                    pg8::EpiY E{C.ws + WS_Y, T, ROWW};
                    pg8::gemm_phase(C.lds, g, S, E);
                }
                SEAM(pa + 1);
            }
        }
    }
#undef IN
#undef SEAM
}

extern "C" void kernel_launch(void* const* d_in, const int* in_sizes, int n_in, void* d_out, int out_size, void* d_ws, size_t ws_size, hipStream_t stream) {
    static int grid = 0;
    if (grid == 0) {
        if (n_in != N_IN || in_sizes[0] != NTOK * DM || out_size != NTOK * DM || ws_size < WS_END) { fprintf(stderr, "kernel_launch: unexpected shapes (n_in %d, ws %zu < %zu)\n", n_in, ws_size, (size_t)WS_END); grid = -1; return; }
        int dev = 0, cus = 0, per_cu = 0;
        if (hipGetDevice(&dev) != hipSuccess || hipDeviceGetAttribute(&cus, hipDeviceAttributeMultiprocessorCount, dev) != hipSuccess) { grid = -1; return; }
        if (hipFuncSetAttribute((const void*)fwd_kernel, hipFuncAttributeMaxDynamicSharedMemorySize, LDS_BYTES) != hipSuccess) { fprintf(stderr, "kernel_launch: hipFuncSetAttribute failed\n"); grid = -1; return; }
        if (hipOccupancyMaxActiveBlocksPerMultiprocessor(&per_cu, (const void*)fwd_kernel, NTHREADS, LDS_BYTES) != hipSuccess || per_cu < 1) { fprintf(stderr, "kernel_launch: occupancy query says %d\n", per_cu); }
        (void)hipGetLastError();
        grid = cus;
    }
    if (grid < 0) return;
    (void)hipMemsetAsync((char*)d_ws + WS_CTL, 0, CTL_ZERO_BYTES, stream);
    Args a{};
    for (int i = 0; i < N_IN; ++i) a.in[i] = (const float*)d_in[i];
    a.out = (float*)d_out; a.ws = (unsigned char*)d_ws;
#if MK_ONE_LAUNCH
    a.ph_lo = 0; a.ph_hi = N_PHASES;
    hipLaunchKernelGGL(fwd_kernel, dim3(grid), dim3(NTHREADS), LDS_BYTES, stream, a);
#else
    for (int p = 0; p < N_PHASES; ++p) { a.ph_lo = p; a.ph_hi = p + 1; hipLaunchKernelGGL(fwd_kernel, dim3(grid), dim3(NTHREADS), LDS_BYTES, stream, a); }
#endif
}
```

```cpp
#include <hip/hip_runtime.h>
#include <cstdint>
#include <cstdio>

#define LAS __attribute__((address_space(3)))
#define GAS __attribute__((address_space(1)))
typedef unsigned short bf16_t;
typedef short bf16x8 __attribute__((ext_vector_type(8)));
typedef short s16x4 __attribute__((ext_vector_type(4)));
typedef float f32x4 __attribute__((ext_vector_type(4)));
typedef float f32x2 __attribute__((ext_vector_type(2)));
typedef float f32x16 __attribute__((ext_vector_type(16)));
typedef unsigned u32x4 __attribute__((ext_vector_type(4)));
typedef unsigned u32x2 __attribute__((ext_vector_type(2)));
typedef int i32x4 __attribute__((ext_vector_type(4)));

constexpr int DM = 1024, NB = 4, SEQ = 8192, NTOK = NB * SEQ;
constexpr int NH = 16, HD = 64, NG = 4;
constexpr int NEXP = 64, TOPK = 8, DEXP = 256;
constexpr int NCH = 2, CHTOK = NTOK / NCH;
constexpr int CH_ROWS = CHTOK * TOPK + NEXP * 256;
constexpr int NCMPB = SEQ / 64;
constexpr float EPSN = 1e-6f;
constexpr float LOG2E = 1.4426950408889634f;
constexpr float C2 = 0.125f * LOG2E;
constexpr int NWAVES = 8, NTHREADS = 512;
constexpr float YSCALE = 16.f;

enum { I_X = 0, I_C, I_POS, I_WADA, I_BADA, I_NMIX, I_NFFN, I_WINA, I_BFA, I_QNA, I_KNA, I_WOA, I_NKV, I_WADAKV, I_BADAKV, I_WKVB, I_PEK, I_PEV,
       I_WCK1, I_WCK2, I_WCV1, I_WCV2, I_KNB, I_WINB, I_BGB, I_QNB, I_WOB, I_WR, I_BR, I_WEG, I_WEU, I_WED, I_WSG, I_WSU, I_WSD, N_IN };

constexpr size_t MiB = 1u << 20;
constexpr size_t WS_CTL = 0, CTL_ZERO_BYTES = 1 * MiB;
constexpr size_t WS_ADA = 1 * MiB;
constexpr size_t WS_ADAKV = WS_ADA + 2 * 4 * 6144 * 4;
constexpr size_t WS_MF = WS_ADAKV + 4 * 2048 * 4;
constexpr size_t WS_ROPE = 2 * MiB;
constexpr size_t WS_LOGF = 4 * MiB;
constexpr size_t WS_CUM = 6 * MiB;
constexpr size_t WS_GATES = 8 * MiB;
constexpr size_t WS_TOKE = 14 * MiB;
constexpr size_t WS_TOKP = 15 * MiB;
constexpr size_t WS_ROWTOK = 16 * MiB;
constexpr size_t WS_ROWW = 24 * MiB;
constexpr size_t WS_KCMP = 32 * MiB;
constexpr size_t WS_VCMP = WS_KCMP + 512 * 1024;
constexpr size_t WS_WB = 33 * MiB;
constexpr size_t WS_WQKV = WS_WB;
constexpr size_t WS_WOA = WS_WQKV + 6 * MiB;
constexpr size_t WS_WKV = WS_WOA + 2 * MiB;
constexpr size_t WS_WQB = WS_WKV + 3 * MiB;
constexpr size_t WS_WOB = WS_WQB + 2 * MiB;
constexpr size_t WS_WC1K = WS_WOB + 2 * MiB;
constexpr size_t WS_WC1V = WS_WC1K + 2 * MiB;
constexpr size_t WS_WSGU = WS_WC1V + 2 * MiB;
constexpr size_t WS_WSD = WS_WSGU + 2 * MiB;
constexpr size_t WS_WEGU = WS_WSD + 1 * MiB;
constexpr size_t WS_WED = WS_WEGU + 64 * MiB;
constexpr size_t WS_U = WS_WED + 32 * MiB;
constexpr size_t WS_D = WS_U + 64 * MiB;
constexpr size_t WS_Q = WS_D, WS_K = WS_D + 64 * MiB, WS_V = WS_D + 128 * MiB, WS_O = WS_D + 192 * MiB;
constexpr size_t WS_ACT = WS_D;
constexpr size_t WS_ACTS = WS_D + 72 * MiB;
constexpr size_t WS_ACTS1 = WS_D + 224 * MiB;
constexpr size_t WS_Y = WS_D + 80 * MiB;
constexpr size_t WS_SKV = WS_D;
constexpr size_t WS_QP = WS_D + 64 * MiB, WS_QR = WS_D + 128 * MiB;
constexpr size_t WS_KSEL = WS_D + 192 * MiB, WS_VSEL = WS_KSEL + 16 * MiB, WS_KWIN = WS_VSEL + 16 * MiB, WS_VWIN = WS_KWIN + 16 * MiB;
constexpr size_t WS_ACK = WS_D + 256 * MiB, WS_ACV = WS_ACK + 16 * MiB;
constexpr size_t WS_SLAB = WS_D + 288 * MiB;
constexpr size_t WS_ONSA = WS_U;
constexpr size_t WS_END = WS_D + 368 * MiB;
static_assert((size_t)CH_ROWS * 512 <= 72 * MiB && (size_t)CH_ROWS * 2048 <= 288 * MiB, "moe chunk buffers");
static_assert(WS_END <= 612 * MiB, "workspace");

constexpr int CW_TMO = 0;
constexpr int CW_CNT = 1024;
constexpr int CW_BAR = 4096;

constexpr int RING_BYTES = 131072;
constexpr int MISC_OFF = 143360;
constexpr int LDS_BYTES = 147456;

__device__ __forceinline__ unsigned f2bf(float f) { unsigned u = __builtin_bit_cast(unsigned, f); return (u + 0x7fffu + ((u >> 16) & 1u)) >> 16; }
__device__ __forceinline__ unsigned pk2(float lo, float hi) { return f2bf(lo) | (f2bf(hi) << 16); }
__device__ __forceinline__ float bf2f(unsigned short v) { return __builtin_bit_cast(float, (unsigned)v << 16); }
__device__ __forceinline__ unsigned cvt_pk_bf16(float lo, float hi) { unsigned r; asm("v_cvt_pk_bf16_f32 %0, %1, %2" : "=v"(r) : "v"(lo), "v"(hi)); return r; }
__device__ __forceinline__ float wave_sum(float v) {
#pragma unroll
    for (int o = 1; o < 64; o <<= 1) v += __shfl_xor(v, o);
    return v;
}
__device__ __forceinline__ int crow(int r, int hi) { return (r & 3) + 8 * (r >> 2) + 4 * hi; }
__device__ __forceinline__ float sigmoidf_(float x) { return 1.f / (1.f + __expf(-x)); }
__device__ __forceinline__ float siluf_(float x) { return x / (1.f + __expf(-x)); }
__device__ __forceinline__ float siluf_fast(float x) { return x * __builtin_amdgcn_rcpf(1.f + __expf(-x)); }
#define LDS_WAIT() asm volatile("s_waitcnt lgkmcnt(0)" ::: "memory")
#define VM_WAIT() asm volatile("s_waitcnt vmcnt(0)" ::: "memory")
namespace pg8 {
constexpr int BM = 256, BK = 64, HALF = 128, HTB = HALF * BK * 2, STAGE_BYTES = 8 * HTB;
__device__ __forceinline__ int lds_byte(int r, int c) { const int st = (r >> 4) * 2 + (c >> 5), rr = r & 15, cc = c & 31, ob = rr * 64 + cc * 2; return st * 1024 + (ob ^ (((ob >> 9) & 1) << 5)); }
__device__ __forceinline__ void stage_rc(int b, int& R, int& C) { const int st = b / 1024, sb = b % 1024, swz = sb ^ (((sb >> 9) & 1) << 5); R = (st >> 1) * 16 + swz / 64; C = (st & 1) * 32 + (swz % 64) / 2; }
__device__ __forceinline__ int perm32(int rho) { const int n = rho >> 4, i = rho & 15; return 8 * (i >> 2) + 4 * n + (i & 3); }

struct Unit { int pm, pn, aux; };
struct Gemm { const bf16_t* A; int lda; int ldb; int K; };

template <class Epi, class Sched>
__device__ __forceinline__ void gemm_phase(LAS unsigned char* lds, const Gemm g, const Sched& S, const Epi& E) {
    int tid_ = threadIdx.x; asm volatile("" : "+v"(tid_));
    const int tid = tid_, wid = __builtin_amdgcn_readfirstlane(tid >> 6), lane = tid & 63, wr = wid >> 2, wc = wid & 3, fr = lane & 15, fq = lane >> 4;
    const int nt = g.K / BK;
    int RA[2], CA[2]; unsigned voffB[2];
#pragma unroll
    for (int i = 0; i < 2; ++i) { int R, C; stage_rc(tid * 16 + i * 8192, R, C); RA[i] = R; CA[i] = C;
        if constexpr (Sched::BCH) { const int b = tid * 16 + i * 8192, st = b >> 10, sb = b & 1023; R = (st >> 1) * 16 + ((sb & 255) >> 4); C = (st & 1) * 32 + (sb >> 8) * 8; }
        const int Rb = (R & ~31) + perm32(R & 31); voffB[i] = Sched::BCH ? (unsigned)((C >> 3) * g.ldb + Rb) * 16u : (unsigned)(Rb * g.ldb + C) * 2u; }
    const size_t hstepB = Sched::BCH ? (size_t)HALF * 16 : (size_t)HALF * g.ldb * 2;
    const unsigned ldsw = (unsigned)wid * 1024u;
    const int aoff = lds_byte(wr * 64 + fr, fq * 8), boff = Sched::BCH ? wc * 4096 + fq * 256 + fr * 16 : lds_byte(wc * 32 + fr, fq * 8);
#define PG8_SA(b, h) (((b) * 2 + (h)) * HTB)
#define PG8_SB(b, h) ((4 + (b) * 2 + (h)) * HTB)
#define PG8_STAGEB(bufoff, gbase) do { _Pragma("unroll") for (int _i = 0; _i < 2; ++_i) \
        __builtin_amdgcn_global_load_lds((const unsigned*)((const char*)(gbase) + voffB[_i]), (LAS unsigned*)(lds + (bufoff) + ldsw + _i * 8192), 16, 0, 0); } while (0)
#define PG8_STAGEA(bufoff, o0, o1, kb) do { \
        __builtin_amdgcn_global_load_lds((const unsigned*)((const char*)g.A + (size_t)(o0) + (size_t)(kb)), (LAS unsigned*)(lds + (bufoff) + ldsw), 16, 0, 0); \
        __builtin_amdgcn_global_load_lds((const unsigned*)((const char*)g.A + (size_t)(o1) + (size_t)(kb)), (LAS unsigned*)(lds + (bufoff) + ldsw + 8192), 16, 0, 0); } while (0)
#define PG8_LDA(dst, b, h) do { _Pragma("unroll") for (int m = 0; m < 4; ++m) _Pragma("unroll") for (int k = 0; k < 2; ++k) dst[m][k] = *(const LAS bf16x8*)(lds + PG8_SA(b, h) + aoff + m * 2048 + k * 1024); } while (0)
#define PG8_LDB(dst, b, h) do { _Pragma("unroll") for (int n = 0; n < 2; ++n) _Pragma("unroll") for (int k = 0; k < 2; ++k) dst[n][k] = *(const LAS bf16x8*)(lds + PG8_SB(b, h) + boff + n * 2048 + k * 1024); } while (0)
#define PG8_MMA(ai, bj, At, Bt) do { __builtin_amdgcn_s_setprio(1); _Pragma("unroll") for (int m = 0; m < 4; ++m) _Pragma("unroll") for (int n = 0; n < 2; ++n) _Pragma("unroll") for (int k = 0; k < 2; ++k) \
        acc[ai][bj][m][n] = __builtin_amdgcn_mfma_f32_16x16x32_bf16(Bt[n][k], At[m][k], acc[ai][bj][m][n], 0, 0, 0); __builtin_amdgcn_s_setprio(0); } while (0)
#define PG8_WAIT_V(n) asm volatile("s_waitcnt vmcnt(" #n ")" ::: "memory")
#define PG8_WAIT_L(n) asm volatile("s_waitcnt lgkmcnt(" #n ")" ::: "memory")
#define PG8_BAR __builtin_amdgcn_s_barrier()
#define PG8_SCHED __builtin_amdgcn_sched_barrier(0)
    Unit cur, nxt; int ui = 0;
    if (!S.next(0, cur)) return;
    f32x4 acc[2][2][4][2];
#pragma unroll
    for (int a = 0; a < 2; ++a)
#pragma unroll
        for (int b = 0; b < 2; ++b)
#pragma unroll
            for (int m = 0; m < 4; ++m)
#pragma unroll
                for (int n = 0; n < 2; ++n) acc[a][b][m][n] = (f32x4){0.f, 0.f, 0.f, 0.f};
    bf16x8 At[4][2], B0[2][2], B1[2][2];
    float pf[Epi::NPF > 0 ? Epi::NPF : 1];
    if constexpr (Epi::NPF > 0) E.pre(cur, wr, fr, pf);
    unsigned c00 = 0, c01 = 0, c10 = 0, c11 = 0, n00 = 0, n01 = 0, n10 = 0, n11 = 0;
    size_t cAu = 0, nAu = 0; const size_t hstepA = (size_t)HALF * g.lda * 2;
    if constexpr (Sched::GATHER) {
        c00 = S.a_off(cur, RA[0]) + CA[0] * 2u; c01 = S.a_off(cur, RA[1]) + CA[1] * 2u; c10 = S.a_off(cur, HALF + RA[0]) + CA[0] * 2u; c11 = S.a_off(cur, HALF + RA[1]) + CA[1] * 2u;
    } else {
        c00 = c10 = (unsigned)(RA[0] * g.lda + CA[0]) * 2u; c01 = c11 = (unsigned)(RA[1] * g.lda + CA[1]) * 2u; cAu = S.a_base(cur);
    }
#define PG8_STAGEA_H(bufoff, h, kb) do { if constexpr (Sched::GATHER) { if ((h) == 0) PG8_STAGEA(bufoff, c00, c01, kb); else PG8_STAGEA(bufoff, c10, c11, kb); } \
        else { PG8_STAGEA(bufoff, c00, c01, cAu + (h) * hstepA + (kb)); } } while (0)
    const char* cB = S.b_ptr(cur);
    const unsigned kstep = BK * 2;
    const unsigned kstepB = Sched::BCH ? (unsigned)g.ldb * 128u : kstep;
    PG8_STAGEB(PG8_SB(0, 0), cB); PG8_STAGEB(PG8_SB(0, 1), cB + hstepB); PG8_STAGEA_H(PG8_SA(0, 0), 0, 0); PG8_STAGEA_H(PG8_SA(0, 1), 1, 0);
    if (wr == 1) PG8_BAR;
    PG8_WAIT_V(2); PG8_BAR;
    PG8_STAGEB(PG8_SB(1, 0), cB + kstepB); PG8_STAGEA_H(PG8_SA(1, 0), 0, kstep); PG8_STAGEB(PG8_SB(1, 1), cB + hstepB + kstepB);
    PG8_WAIT_V(6); PG8_BAR;
    for (;;) {
        const bool has_next = S.next(ui + 1, nxt);
        const char* nB = cB; nAu = cAu;
        if constexpr (Sched::GATHER) { n00 = c00; n01 = c01; n10 = c10; n11 = c11; }
        if (has_next) { nB = S.b_ptr(nxt);
            if constexpr (Sched::GATHER) { n00 = S.a_off(nxt, RA[0]) + CA[0] * 2u; n01 = S.a_off(nxt, RA[1]) + CA[1] * 2u; n10 = S.a_off(nxt, HALF + RA[0]) + CA[0] * 2u; n11 = S.a_off(nxt, HALF + RA[1]) + CA[1] * 2u; }
            else nAu = S.a_base(nxt); }
#pragma unroll 1
        for (int t = 0; t < nt; t += 2) {
            const bool last = (t == nt - 2);
            const unsigned k1 = (unsigned)(t + 1) * kstep;
            const unsigned k2 = last ? 0u : (unsigned)(t + 2) * kstep, k3 = k2 + kstep;
            const unsigned k2B = Sched::BCH ? (last ? 0u : (unsigned)(t + 2) * kstepB) : k2;
            const char* bb = last ? nB : cB; const char* b2 = bb + k2B; const char* b3 = b2 + kstepB;
            PG8_LDB(B0, 0, 0); PG8_LDB(B1, 0, 1); PG8_SCHED; PG8_LDA(At, 0, 0); PG8_STAGEA_H(PG8_SA(1, 1), 1, k1);
            if (last) { if constexpr (Sched::GATHER) { c00 = n00; c01 = n01; c10 = n10; c11 = n11; } else cAu = nAu; }
            PG8_WAIT_V(8); PG8_WAIT_L(0); PG8_BAR; PG8_MMA(0, 0, At, B0); PG8_MMA(0, 1, At, B1); PG8_BAR; PG8_SCHED;
            PG8_LDA(At, 0, 1); PG8_STAGEB(PG8_SB(0, 0), b2); PG8_STAGEB(PG8_SB(0, 1), b2 + hstepB); PG8_STAGEA_H(PG8_SA(0, 0), 0, k2);
            PG8_WAIT_V(8); PG8_WAIT_L(0); PG8_BAR; PG8_MMA(1, 0, At, B0); PG8_MMA(1, 1, At, B1); PG8_BAR; PG8_SCHED;
            PG8_LDB(B0, 1, 0); PG8_LDB(B1, 1, 1); PG8_SCHED; PG8_LDA(At, 1, 0); PG8_STAGEA_H(PG8_SA(0, 1), 1, k2);
            PG8_WAIT_V(8); PG8_WAIT_L(0); PG8_BAR; PG8_MMA(0, 0, At, B0); PG8_MMA(0, 1, At, B1); PG8_BAR; PG8_SCHED;
            PG8_LDA(At, 1, 1); PG8_STAGEB(PG8_SB(1, 0), b3); PG8_STAGEB(PG8_SB(1, 1), b3 + hstepB); PG8_STAGEA_H(PG8_SA(1, 0), 0, k3);
            PG8_WAIT_V(8); PG8_WAIT_L(0); PG8_BAR; PG8_MMA(1, 0, At, B0); PG8_MMA(1, 1, At, B1); PG8_BAR; PG8_SCHED;
        }
        if (wr == 0) PG8_BAR;
        if constexpr (Epi::NPF > 0) E(acc, cur, wr, wc, fr, fq, pf); else E(acc, cur, wr, wc, fr, fq);
        if (!has_next) break;
#pragma unroll
        for (int a = 0; a < 2; ++a)
#pragma unroll
            for (int b = 0; b < 2; ++b)
#pragma unroll
                for (int m = 0; m < 4; ++m)
#pragma unroll
                    for (int n = 0; n < 2; ++n) acc[a][b][m][n] = (f32x4){0.f, 0.f, 0.f, 0.f};
        cur = nxt; cB = nB; ++ui;
        if constexpr (Epi::NPF > 0) E.pre(cur, wr, fr, pf);
        if (wr == 1) PG8_BAR;
    }
    PG8_WAIT_V(0);
    PG8_BAR;
#undef PG8_SA
#undef PG8_SB
#undef PG8_STAGEA
#undef PG8_STAGEA_H
#undef PG8_STAGEB
#undef PG8_LDA
#undef PG8_LDB
#undef PG8_MMA
#undef PG8_WAIT_V
#undef PG8_WAIT_L
#undef PG8_BAR
#undef PG8_SCHED
}

struct DenseSched {
    static constexpr bool GATHER = false, BCH = false;
    const bf16_t* Bt; int lda, ldb; int nM, nN, nwg, G, c; int rowbase;
    __device__ void init(const bf16_t* Bt_, int lda_, int ldb_, int M, int N, int G_, int c_, int rowbase_ = 0) { Bt = Bt_; lda = lda_; ldb = ldb_; nM = M / BM; nN = N / BM; nwg = nM * nN; G = G_; c = c_; rowbase = rowbase_; }
    __device__ __forceinline__ bool next(int i, Unit& u) const {
        const long L = (long)i * G + c; if (L >= nwg) return false;
        int wgid = (int)L; { const int q = nwg / 8, r = nwg % 8, xcd = wgid % 8, off = wgid / 8; wgid = (xcd < r ? xcd * (q + 1) : r * (q + 1) + (xcd - r) * q) + off; }
        const int nig = 8 * nN, gid = wgid / nig, fm = gid * 8, gsz = (nM - fm) < 8 ? (nM - fm) : 8;
        u.pm = fm + ((wgid % nig) % gsz); u.pn = (wgid % nig) / gsz; u.aux = 0; return true;
    }
    __device__ __forceinline__ size_t a_base(const Unit& u) const { return (size_t)(rowbase + u.pm * BM) * (size_t)lda * 2u; }
    __device__ __forceinline__ unsigned a_off(const Unit&, int) const { return 0u; }
    __device__ __forceinline__ const char* b_ptr(const Unit& u) const { return (const char*)(Bt + (size_t)u.pn * BM * ldb); }
};
struct SplitKSched {
    static constexpr bool GATHER = false, BCH = false;
    const bf16_t* Bt; int lda, ldb, Kc; int nM, nS, nwg, G, c;
    __device__ void init(const bf16_t* Bt_, int lda_, int ldb_, int Kc_, int M, int nS_, int G_, int c_) { Bt = Bt_; lda = lda_; ldb = ldb_; Kc = Kc_; nM = M / BM; nS = nS_; nwg = nM * nS; G = G_; c = c_; }
    __device__ __forceinline__ bool next(int i, Unit& u) const { const int L = i * G + c; if (L >= nwg) return false; u.pm = L % nM; u.aux = L / nM; u.pn = 0; return true; }
    __device__ __forceinline__ size_t a_base(const Unit& u) const { return ((size_t)(u.pm * BM) * (size_t)lda + (size_t)(u.aux * Kc)) * 2u; }
    __device__ __forceinline__ unsigned a_off(const Unit&, int) const { return 0u; }
    __device__ __forceinline__ const char* b_ptr(const Unit& u) const { return (const char*)(Bt + (size_t)u.aux * Kc); }
};
struct MoeTab { const LAS int* tstart; const LAS int* cnt; const LAS unsigned char* tile_e; int ntiles; };
struct MoeGatherSched {
    static constexpr bool GATHER = true, BCH = true;
    __device__ __forceinline__ size_t a_base(const Unit&) const { return 0; }
    MoeTab T; const bf16_t* Bt; const bf16_t* Bsh; const int* rowtok; int nN, G, c; int ldb; size_t bstride; int tokbase;
    __device__ __forceinline__ bool next(int i, Unit& u) const {
        if ((G & 7) == 0) { const int x = c & 7, j = i * (G >> 3) + (c >> 3); const int ts = (T.ntiles * x) >> 3, te = (T.ntiles * (x + 1)) >> 3; const int tile = ts + j / nN; if (tile >= te) return false; u.pm = tile; u.pn = j % nN; }
        else { const int L = i * G + c; if (L >= T.ntiles * nN) return false; u.pm = L / nN; u.pn = L % nN; }
        u.aux = T.tile_e[u.pm]; return true; }
    __device__ __forceinline__ unsigned a_off(const Unit& u, int row) const {
        const int e = u.aux; int lr = (u.pm - T.tstart[e]) * BM + row; const int cn = T.cnt[e]; lr = lr < cn ? lr : cn - 1;
        const int tok = (e == NEXP) ? tokbase + lr : rowtok[(size_t)e * CHTOK + lr]; return (unsigned)tok * (unsigned)(DM * 2); }
    __device__ __forceinline__ const char* b_ptr(const Unit& u) const { return (const char*)((u.aux == NEXP ? Bsh : Bt + (size_t)u.aux * bstride) + (size_t)u.pn * BM * 8); }
};
struct MoeDownSched {
    static constexpr bool GATHER = false, BCH = true;
    MoeTab T; const bf16_t* Bt; int nN, G, c; int lda, ldb; size_t bstride;
    __device__ __forceinline__ bool next(int i, Unit& u) const {
        if ((G & 7) == 0) { const int x = c & 7, j = i * (G >> 3) + (c >> 3); const int ts = (T.ntiles * x) >> 3, te = (T.ntiles * (x + 1)) >> 3; const int tile = ts + j / nN; if (tile >= te) return false; u.pm = tile; u.pn = j % nN; }
        else { const int L = i * G + c; if (L >= T.ntiles * nN) return false; u.pm = L / nN; u.pn = L % nN; }
        u.aux = T.tile_e[u.pm]; return true; }
    __device__ __forceinline__ size_t a_base(const Unit& u) const { return (size_t)(u.pm * BM) * (size_t)lda * 2u; }
    __device__ __forceinline__ unsigned a_off(const Unit&, int) const { return 0u; }
    __device__ __forceinline__ const char* b_ptr(const Unit& u) const { return (const char*)(Bt + (size_t)u.aux * bstride + (size_t)u.pn * BM * 8); }
};
}
namespace pg8 {
template <class T> __device__ __forceinline__ T* at(const void* base, unsigned byteoff) { return (T*)((const char*)base + (size_t)byteoff); }

struct EpiQKV {
    static constexpr int NPF = 0;
    static constexpr int NTRAIL = 0;
    bf16_t* Q; size_t kvstride; const float* qg; const float* kg;
    __device__ __forceinline__ void operator()(const f32x4 (&acc)[2][2][4][2], const Unit& u, int wr, int wc, int fr, int fq) const {
        const int kind = u.pn >> 2;
        bf16_t* base = Q + (size_t)kind * kvstride;
        const float* gn = kind == 0 ? qg : kg;
        const float osc = kind == 0 ? C2 : 1.f;
        f32x4 gv[2][2];
#pragma unroll
        for (int bj = 0; bj < 2; ++bj)
#pragma unroll
            for (int n = 0; n < 2; ++n) gv[bj][n] = *(const f32x4*)(gn + 32 * bj + 8 * fq + 4 * n);
        const int colbase = (u.pn & 3) * 256 + wc * 64 + 8 * fq;
#pragma unroll
        for (int ai = 0; ai < 2; ++ai)
#pragma unroll
            for (int m = 0; m < 4; ++m) {
                const int row = u.pm * BM + ai * HALF + wr * 64 + m * 16 + fr;
                float rs = 1.f;
                if (kind < 2) {
                    float ss = 0.f;
#pragma unroll
                    for (int bj = 0; bj < 2; ++bj)
#pragma unroll
                        for (int n = 0; n < 2; ++n) { const f32x4 x = acc[ai][bj][m][n]; ss += (x[0] * x[0] + x[1] * x[1]) + (x[2] * x[2] + x[3] * x[3]); }
                    ss += __shfl_xor(ss, 16); ss += __shfl_xor(ss, 32);
                    rs = rsqrtf(ss * (1.f / 64.f) + EPSN) * osc;
                }
                const unsigned ro = (unsigned)(row * DM + colbase) * 2u;
#pragma unroll
                for (int bj = 0; bj < 2; ++bj) {
                    f32x4 v0 = acc[ai][bj][m][0], v1 = acc[ai][bj][m][1];
                    if (kind < 2) { v0 = v0 * gv[bj][0] * rs; v1 = v1 * gv[bj][1] * rs; }
                    u32x4 w; w.x = cvt_pk_bf16(v0[0], v0[1]); w.y = cvt_pk_bf16(v0[2], v0[3]); w.z = cvt_pk_bf16(v1[0], v1[1]); w.w = cvt_pk_bf16(v1[2], v1[3]);
                    *at<u32x4>(base, ro + 64 * bj) = w;
                }
            }
    }
};

struct EpiResid {
    static constexpr int NPF = 0;
    static constexpr int NTRAIL = 0;
    const float* base; float* out; const float* gate;
    __device__ __forceinline__ void operator()(const f32x4 (&acc)[2][2][4][2], const Unit& u, int wr, int wc, int fr, int fq) const {
        const int col0 = u.pn * BM + wc * 32 + 8 * fq;
        const int b = (u.pm * BM) / SEQ;
        f32x4 gv[2][2];
#pragma unroll
        for (int bj = 0; bj < 2; ++bj)
#pragma unroll
            for (int n = 0; n < 2; ++n) gv[bj][n] = *(const f32x4*)(gate + (size_t)b * 6144 + col0 + bj * HALF + 4 * n);
#pragma unroll
        for (int ai = 0; ai < 2; ++ai) {
            f32x4 bv[4][2][2];
#pragma unroll
            for (int m = 0; m < 4; ++m) { const unsigned ro = (unsigned)((u.pm * BM + ai * HALF + wr * 64 + m * 16 + fr) * DM + col0) * 4u;
#pragma unroll
                for (int bj = 0; bj < 2; ++bj)
#pragma unroll
                    for (int n = 0; n < 2; ++n) bv[m][bj][n] = *at<const f32x4>(base, ro + (bj * HALF + 4 * n) * 4); }
#pragma unroll
            for (int m = 0; m < 4; ++m) { const unsigned ro = (unsigned)((u.pm * BM + ai * HALF + wr * 64 + m * 16 + fr) * DM + col0) * 4u;
#pragma unroll
                for (int bj = 0; bj < 2; ++bj)
#pragma unroll
                    for (int n = 0; n < 2; ++n) *at<f32x4>(out, ro + (bj * HALF + 4 * n) * 4) = bv[m][bj][n] + gv[bj][n] * acc[ai][bj][m][n]; }
        }
    }
};

struct EpiKV {
    static constexpr int NPF = 0;
    static constexpr int NTRAIL = 0;
    bf16_t *ack, *ksel; size_t acstride, kvstride; const float* pek;
    const float* pev; const float* kgain; const float* rope;
    LAS unsigned char* lds;
    __device__ __forceinline__ void operator()(const f32x4 (&acc)[2][2][4][2], const Unit& u, int wr, int wc, int fr, int fq) const {
        const int kind = u.pn, g = wc;
        const bool donorm = (kind == 2 || kind == 4);
        const float* gn = kgain + (kind == 2 ? 64 : 128);
        f32x4 gv[2][2];
#pragma unroll
        for (int bj = 0; bj < 2; ++bj)
#pragma unroll
            for (int n = 0; n < 2; ++n) gv[bj][n] = donorm ? *(const f32x4*)(gn + 32 * bj + 8 * fq + 4 * n) : (f32x4){1.f, 1.f, 1.f, 1.f};
#pragma unroll
        for (int ai = 0; ai < 2; ++ai)
#pragma unroll
            for (int m = 0; m < 4; ++m) {
                const int row = u.pm * BM + ai * HALF + wr * 64 + m * 16 + fr;
                f32x4 v[2][2];
#pragma unroll
                for (int bj = 0; bj < 2; ++bj)
#pragma unroll
                    for (int n = 0; n < 2; ++n) v[bj][n] = acc[ai][bj][m][n];
                if (kind < 2) {
                    const int b = row / SEQ, s = row % SEQ, nb = s >> 6, pos = s & 63;
                    const float* pe = (kind == 0 ? pek : pev) + pos * 64;
                    bf16_t* dbase = ack + (size_t)kind * acstride; const unsigned dofs = (unsigned)(((b * NCMPB + nb) * NG + g) * 4096 + pos * 64 + 8 * fq) * 2u;
#pragma unroll
                    for (int bj = 0; bj < 2; ++bj) {
                        const f32x4 p0 = *(const f32x4*)(pe + 32 * bj + 8 * fq), p1 = *(const f32x4*)(pe + 32 * bj + 8 * fq + 4);
                        const f32x4 v0 = v[bj][0] + p0, v1 = v[bj][1] + p1;
                        u32x4 w; w.x = cvt_pk_bf16(v0[0], v0[1]); w.y = cvt_pk_bf16(v0[2], v0[3]); w.z = cvt_pk_bf16(v1[0], v1[1]); w.w = cvt_pk_bf16(v1[2], v1[3]);
                        *at<u32x4>(dbase, dofs + 64 * bj) = w;
                    }
                } else {
                    if (donorm) {
                        float ss = 0.f;
#pragma unroll
                        for (int bj = 0; bj < 2; ++bj)
#pragma unroll
                            for (int n = 0; n < 2; ++n) { const f32x4 x = v[bj][n]; ss += (x[0] * x[0] + x[1] * x[1]) + (x[2] * x[2] + x[3] * x[3]); }
                        ss += __shfl_xor(ss, 16); ss += __shfl_xor(ss, 32);
                        const float rs = rsqrtf(ss * (1.f / 64.f) + EPSN);
#pragma unroll
                        for (int bj = 0; bj < 2; ++bj)
#pragma unroll
                            for (int n = 0; n < 2; ++n) v[bj][n] = v[bj][n] * gv[bj][n] * rs;
#pragma unroll
                        for (int n = 0; n < 2; ++n) {
                            const f32x4 cs = *(const f32x4*)(rope + (size_t)row * 16 + 4 * n), sn = *(const f32x4*)(rope + (size_t)row * 16 + 8 + 4 * n);
                            f32x4 mine = v[0][n], oth;
#pragma unroll
                            for (int j = 0; j < 4; ++j) oth[j] = __shfl_xor(mine[j], 16);
                            const f32x4 r0 = mine * cs - oth * sn, r1 = mine * cs + oth * sn;
                            if (fq == 0) v[0][n] = r0; else if (fq == 1) v[0][n] = r1;
                        }
                    }
                    bf16_t* dbase = ksel + (size_t)(kind - 2) * kvstride;
                    const unsigned blk = (unsigned)(((row >> 6) * NG + g) * 4096), key = (unsigned)(row & 63);
                    if (kind == 2) {
#pragma unroll
                        for (int bj = 0; bj < 2; ++bj) {
                            const f32x4 v0 = v[bj][0], v1 = v[bj][1];
                            u32x4 w; w.x = cvt_pk_bf16(v0[0], v0[1]); w.y = cvt_pk_bf16(v0[2], v0[3]); w.z = cvt_pk_bf16(v1[0], v1[1]); w.w = cvt_pk_bf16(v1[2], v1[3]);
                            *at<u32x4>(dbase, (blk + ((unsigned)(4 * bj + fq) * 64u + key) * 8u) * 2u) = w;
                        }
                    } else if (kind == 3) {
                        LAS unsigned char* stv = lds + 131072 + (wr * 4 + wc) * 1024;
                        const unsigned ks = key >> 4;
                        const int ln = fq * 16 + fr, dd_ = ln & 31, hh = ln >> 5;
#pragma unroll
                        for (int bj = 0; bj < 2; ++bj) {
                            const f32x4 v0 = v[bj][0], v1 = v[bj][1];
                            u32x4 w; w.x = cvt_pk_bf16(v0[0], v0[1]); w.y = cvt_pk_bf16(v0[2], v0[3]); w.z = cvt_pk_bf16(v1[0], v1[1]); w.w = cvt_pk_bf16(v1[2], v1[3]);
                            *(LAS u32x4*)(stv + fr * 64 + fq * 16) = w;
                            unsigned e8[8];
#pragma unroll
                            for (int j = 0; j < 8; ++j) e8[j] = *(const LAS unsigned short*)(stv + ((j & 3) + 8 * (j >> 2) + 4 * hh) * 64 + dd_ * 2);
                            u32x4 o; o.x = e8[0] | (e8[1] << 16); o.y = e8[2] | (e8[3] << 16); o.z = e8[4] | (e8[5] << 16); o.w = e8[6] | (e8[7] << 16);
                            *at<u32x4>(dbase, (blk + ((((ks * 2u + (unsigned)bj) * 2u + (unsigned)hh) * 32u + (unsigned)dd_) * 8u)) * 2u) = o;
                        }
                    } else {
                        const unsigned dofs = (unsigned)(row * 256 + g * 64 + 8 * fq) * 2u;
#pragma unroll
                        for (int bj = 0; bj < 2; ++bj) {
                            const f32x4 v0 = v[bj][0], v1 = v[bj][1];
                            u32x4 w; w.x = cvt_pk_bf16(v0[0], v0[1]); w.y = cvt_pk_bf16(v0[2], v0[3]); w.z = cvt_pk_bf16(v1[0], v1[1]); w.w = cvt_pk_bf16(v1[2], v1[3]);
                            *at<u32x4>(dbase, dofs + 64 * bj) = w;
                        }
                    }
                }
            }
    }
};

struct EpiQB {
    static constexpr int NPF = 0;
    static constexpr int NTRAIL = 0;
    bf16_t *qp, *qr; const float* qgain; const float* rope;
    __device__ __forceinline__ void operator()(const f32x4 (&acc)[2][2][4][2], const Unit& u, int wr, int wc, int fr, int fq) const {
        f32x4 gv[2][2];
#pragma unroll
        for (int bj = 0; bj < 2; ++bj)
#pragma unroll
            for (int n = 0; n < 2; ++n) gv[bj][n] = *(const f32x4*)(qgain + 32 * bj + 8 * fq + 4 * n);
        const int colbase = u.pn * 256 + wc * 64 + 8 * fq;
#pragma unroll
        for (int ai = 0; ai < 2; ++ai)
#pragma unroll
            for (int m = 0; m < 4; ++m) {
                const int row = u.pm * BM + ai * HALF + wr * 64 + m * 16 + fr;
                f32x4 v[2][2]; float ss = 0.f;
#pragma unroll
                for (int bj = 0; bj < 2; ++bj)
#pragma unroll
                    for (int n = 0; n < 2; ++n) { const f32x4 x = acc[ai][bj][m][n]; v[bj][n] = x; ss += (x[0] * x[0] + x[1] * x[1]) + (x[2] * x[2] + x[3] * x[3]); }
                ss += __shfl_xor(ss, 16); ss += __shfl_xor(ss, 32);
                const float rs = rsqrtf(ss * (1.f / 64.f) + EPSN) * C2;
#pragma unroll
                for (int bj = 0; bj < 2; ++bj)
#pragma unroll
                    for (int n = 0; n < 2; ++n) v[bj][n] = v[bj][n] * gv[bj][n] * rs;
                const unsigned ro = (unsigned)(row * DM + colbase) * 2u;
#pragma unroll
                for (int bj = 0; bj < 2; ++bj) {
                    const f32x4 v0 = v[bj][0], v1 = v[bj][1];
                    u32x4 w; w.x = cvt_pk_bf16(v0[0], v0[1]); w.y = cvt_pk_bf16(v0[2], v0[3]); w.z = cvt_pk_bf16(v1[0], v1[1]); w.w = cvt_pk_bf16(v1[2], v1[3]);
                    *at<u32x4>(qp, ro + 64 * bj) = w;
                }
#pragma unroll
                for (int n = 0; n < 2; ++n) {
                    const f32x4 cs = *(const f32x4*)(rope + (size_t)row * 16 + 4 * n), sn = *(const f32x4*)(rope + (size_t)row * 16 + 8 + 4 * n);
                    f32x4 mine = v[0][n], oth;
#pragma unroll
                    for (int j = 0; j < 4; ++j) oth[j] = __shfl_xor(mine[j], 16);
                    const f32x4 r0 = mine * cs - oth * sn, r1 = mine * cs + oth * sn;
                    if (fq == 0) v[0][n] = r0; else if (fq == 1) v[0][n] = r1;
                }
#pragma unroll
                for (int bj = 0; bj < 2; ++bj) {
                    const f32x4 v0 = v[bj][0], v1 = v[bj][1];
                    u32x4 w; w.x = cvt_pk_bf16(v0[0], v0[1]); w.y = cvt_pk_bf16(v0[2], v0[3]); w.z = cvt_pk_bf16(v1[0], v1[1]); w.w = cvt_pk_bf16(v1[2], v1[3]);
                    *at<u32x4>(qr, ro + 64 * bj) = w;
                }
            }
    }
};

struct EpiGU {
    static constexpr int NPF = 0;
    static constexpr int NTRAIL = 8;
    bf16_t* act; bf16_t* acts; MoeTab T;
    __device__ __forceinline__ void operator()(const f32x4 (&acc)[2][2][4][2], const Unit& u, int wr, int wc, int fr, int fq) const {
        const int col0 = u.pn * 128 + wc * 32 + 8 * fq;
        const bool sh = (u.aux == NEXP);
        bf16_t* base = sh ? acts : act; const int tile0 = sh ? (u.pm - T.tstart[NEXP]) : u.pm;
#pragma unroll
        for (int ai = 0; ai < 2; ++ai)
#pragma unroll
            for (int m = 0; m < 4; ++m) {
                const unsigned row = (unsigned)(tile0 * BM + ai * HALF + wr * 64 + m * 16 + fr);
                f32x4 o[2];
#pragma unroll
                for (int n = 0; n < 2; ++n) { const f32x4 gt = acc[ai][0][m][n], up = acc[ai][1][m][n];
#pragma unroll
                    for (int j = 0; j < 4; ++j) o[n][j] = siluf_fast(gt[j]) * up[j]; }
                u32x4 w; w.x = cvt_pk_bf16(o[0][0], o[0][1]); w.y = cvt_pk_bf16(o[0][2], o[0][3]); w.z = cvt_pk_bf16(o[1][0], o[1][1]); w.w = cvt_pk_bf16(o[1][2], o[1][3]);
                *at<u32x4>(base, (row * DEXP + col0) * 2u) = w;
            }
    }
};

__device__ __forceinline__ unsigned pk4_fp8(const f32x4 v) {
    const float lim = 440.f;
    int p = __builtin_amdgcn_cvt_pk_fp8_f32(__builtin_amdgcn_fmed3f(v[0], -lim, lim), __builtin_amdgcn_fmed3f(v[1], -lim, lim), 0, false);
    p = __builtin_amdgcn_cvt_pk_fp8_f32(__builtin_amdgcn_fmed3f(v[2], -lim, lim), __builtin_amdgcn_fmed3f(v[3], -lim, lim), p, true);
    return (unsigned)p;
}
struct EpiY {
    static constexpr int NPF = 8;
    static constexpr int NTRAIL = 0;
    unsigned char* Y; MoeTab T; const float* roww;
    __device__ __forceinline__ void pre(const Unit& u, int wr, int fr, float (&pf)[8]) const {
        const int e = u.aux, lbase = (u.pm - T.tstart[e]) * BM;
#pragma unroll
        for (int ai = 0; ai < 2; ++ai)
#pragma unroll
            for (int m = 0; m < 4; ++m) pf[ai * 4 + m] = *at<const float>(roww, (unsigned)(e * CHTOK + lbase + ai * HALF + wr * 64 + m * 16 + fr) * 4u);
    }
    __device__ __forceinline__ void operator()(const f32x4 (&acc)[2][2][4][2], const Unit& u, int wr, int wc, int fr, int fq, const float (&pf)[8]) const {
        const int col0 = u.pn * BM + wc * 64 + 16 * fq;
#pragma unroll
        for (int ai = 0; ai < 2; ++ai)
#pragma unroll
            for (int m = 0; m < 4; ++m) {
                const int r = ai * HALF + wr * 64 + m * 16 + fr;
                const float w8 = pf[ai * 4 + m] * YSCALE;
                u32x4 w; w.x = pk4_fp8(acc[ai][0][m][0] * w8); w.y = pk4_fp8(acc[ai][0][m][1] * w8); w.z = pk4_fp8(acc[ai][1][m][0] * w8); w.w = pk4_fp8(acc[ai][1][m][1] * w8);
                *at<u32x4>(Y, (unsigned)((u.pm * BM + r) * DM + col0)) = w;
            }
    }
};

struct EpiCombine {
    static constexpr int NPF = 0;
    static constexpr int NTRAIL = 0;
    float* h; const unsigned char* Y; const int* toke; const int* tokp; const LAS int* pstart; const float* gate; int tokbase;
    __device__ __forceinline__ void operator()(const f32x4 (&acc)[2][2][4][2], const Unit& u, int wr, int wc, int fr, int fq) const {
        const int col0 = u.pn * BM + wc * 64 + 16 * fq;
        const int b = (tokbase + u.pm * BM) / SEQ;
        const float* gp = gate + (size_t)b * 6144 + u.pn * BM + wc * 64 + 4 * fq;
        const int t0 = tokbase + u.pm * BM + wr * 64 + fr;
        i32x4 e0 = *at<const i32x4>(toke, (unsigned)t0 * 32u), e1 = *at<const i32x4>(toke, (unsigned)t0 * 32u + 16u);
        i32x4 p0 = *at<const i32x4>(tokp, (unsigned)t0 * 32u), p1 = *at<const i32x4>(tokp, (unsigned)t0 * 32u + 16u);
#pragma unroll
        for (int ai = 0; ai < 2; ++ai)
#pragma unroll
            for (int m = 0; m < 4; ++m) {
                const int t = t0 + ai * HALF + m * 16;
                int yr[8];
#pragma unroll
                for (int k = 0; k < 4; ++k) { yr[k] = pstart[e0[k]] + p0[k]; yr[4 + k] = pstart[e1[k]] + p1[k]; }
                u32x4 yw[8];
#pragma unroll
                for (int k = 0; k < 8; ++k) yw[k] = *at<const u32x4>(Y, (unsigned)(yr[k] * DM + col0));
                const unsigned ho = (unsigned)(t * DM + u.pn * BM + wc * 64 + 4 * fq) * 4u;
                f32x4 hv[4];
#pragma unroll
                for (int q = 0; q < 4; ++q) hv[q] = *at<const f32x4>(h, ho + 64u * q);
                if (ai * 4 + m < 7) { const int tn = t0 + ((ai * 4 + m + 1) >> 2) * HALF + ((ai * 4 + m + 1) & 3) * 16;
                    e0 = *at<const i32x4>(toke, (unsigned)tn * 32u); e1 = *at<const i32x4>(toke, (unsigned)tn * 32u + 16u);
                    p0 = *at<const i32x4>(tokp, (unsigned)tn * 32u); p1 = *at<const i32x4>(tokp, (unsigned)tn * 32u + 16u); }
                f32x4 s[2][2];
#pragma unroll
                for (int bj = 0; bj < 2; ++bj)
#pragma unroll
                    for (int n = 0; n < 2; ++n) s[bj][n] = (f32x4){0.f, 0.f, 0.f, 0.f};
#pragma unroll
                for (int k = 0; k < 8; ++k) {
#pragma unroll
                    for (int q = 0; q < 4; ++q) { const unsigned ww = q == 0 ? yw[k].x : q == 1 ? yw[k].y : q == 2 ? yw[k].z : yw[k].w;
                        const f32x2 lo = __builtin_amdgcn_cvt_pk_f32_fp8((int)ww, false), hi2 = __builtin_amdgcn_cvt_pk_f32_fp8((int)ww, true);
                        s[q >> 1][q & 1][0] += lo.x; s[q >> 1][q & 1][1] += lo.y; s[q >> 1][q & 1][2] += hi2.x; s[q >> 1][q & 1][3] += hi2.y; }
                }
#pragma unroll
                for (int bj = 0; bj < 2; ++bj)
#pragma unroll
                    for (int n = 0; n < 2; ++n) {
                        const f32x4 gvv = *(const f32x4*)(gp + 32 * bj + 16 * n);
                        __builtin_nontemporal_store(hv[2 * bj + n] + gvv * (acc[ai][bj][m][n] + s[bj][n] * (1.f / YSCALE)), at<f32x4>(h, ho + (32 * bj + 16 * n) * 4));
                    }
                asm volatile("" ::: "memory");
            }
    }
};

struct EpiSlab {
    static constexpr int NPF = 0;
    static constexpr int NTRAIL = 0;
    float* slab;
    __device__ __forceinline__ void operator()(const f32x4 (&acc)[2][2][4][2], const Unit& u, int wr, int wc, int fr, int fq) const {
        const int col0 = wc * 32 + 8 * fq;
#pragma unroll
        for (int ai = 0; ai < 2; ++ai)
#pragma unroll
            for (int m = 0; m < 4; ++m) {
                const unsigned ro = (unsigned)((u.aux * 2048 + u.pm * BM + ai * HALF + wr * 64 + m * 16 + fr) * 256 + col0) * 4u;
#pragma unroll
                for (int bj = 0; bj < 2; ++bj)
#pragma unroll
                    for (int n = 0; n < 2; ++n) *at<f32x4>(slab, ro + (bj * HALF + 4 * n) * 4) = acc[ai][bj][m][n];
            }
    }
};
}
namespace att {
constexpr int NSLOT = 4;
constexpr int L_K = 0, L_V = 32768, L_CK = 65536, L_WSF = 73728, L_UNI = 75776, L_LIST = 75840, L_OS = 76800;
__device__ __forceinline__ s16x4 vtr(const LAS char* p) { typedef short v4i16_t __attribute__((ext_vector_type(4))); return __builtin_bit_cast(s16x4, __builtin_amdgcn_ds_read_tr16_b64_v4i16((LAS v4i16_t*)p)); }
__device__ __forceinline__ int dppx1(int x) { return __builtin_amdgcn_update_dpp(0, x, 0xB1, 0xF, 0xF, false); }
__device__ __forceinline__ int dppx2(int x) { return __builtin_amdgcn_update_dpp(0, x, 0x4E, 0xF, 0xF, false); }
__device__ __forceinline__ float dppx1f(float x) { return __int_as_float(dppx1(__float_as_int(x))); }
__device__ __forceinline__ float dppx2f(float x) { return __int_as_float(dppx2(__float_as_int(x))); }

__device__ __forceinline__ void glds16(const void* gsrc, unsigned lds_dst) { unsigned keep;
    asm volatile("s_mov_b32 %0, m0\n\ts_mov_b32 m0, %2\n\ts_nop 0\n\tglobal_load_lds_dwordx4 %1, off\n\ts_mov_b32 m0, %0" : "=&s"(keep) : "v"(gsrc), "s"(lds_dst) : "memory"); }
__device__ __forceinline__ void glds4(const void* gsrc, unsigned lds_dst) { unsigned keep;
    asm volatile("s_mov_b32 %0, m0\n\ts_mov_b32 m0, %2\n\ts_nop 0\n\tglobal_load_lds_dword %1, off\n\ts_mov_b32 m0, %0" : "=&s"(keep) : "v"(gsrc), "s"(lds_dst) : "memory"); }
template <bool HAS_CK>
__device__ __forceinline__ void ring_issue(LAS char* lds, int slot, const bf16_t* Kg, const bf16_t* Vg, int pitch, int key0, const float* ckg, int wid, int lane) {
    const unsigned l0 = (unsigned)(uintptr_t)lds;
    { const int krow = 8 * wid + (lane >> 3);
      glds16(Kg + (size_t)(key0 + krow) * pitch + ((lane & 7) ^ ((krow >> 1) & 7)) * 8, (unsigned)__builtin_amdgcn_readfirstlane((int)(l0 + L_K + slot * 8192 + wid * 1024))); }
    { const int vrow = 8 * wid + (lane >> 3);
      glds16(Vg + (size_t)(key0 + vrow) * pitch + ((lane & 7) ^ (4 * ((vrow >> 1) & 1))) * 8, (unsigned)__builtin_amdgcn_readfirstlane((int)(l0 + L_V + slot * 8192 + wid * 1024))); }
    if (HAS_CK) glds4(ckg + key0 + lane, (unsigned)__builtin_amdgcn_readfirstlane((int)(l0 + L_CK + (slot * 8 + wid) * 256)));
}
#define RING_WAIT_BAR(N) asm volatile("s_waitcnt vmcnt(%0) lgkmcnt(0)\n\ts_barrier" :: "i"(N) : "memory")
#define SCHED_FENCE() __builtin_amdgcn_sched_barrier(0)
__device__ __forceinline__ void kfrag_load(bf16x8 (&kf)[8], const LAS char* kb, int r32, int hi) {
    const int sw = (r32 >> 1) & 7;
#pragma unroll
    for (int d0 = 0; d0 < 4; ++d0) { const int ch = ((2 * d0 + hi) ^ sw) * 16; kf[2 * d0] = *(const LAS bf16x8*)(kb + r32 * 128 + ch); kf[2 * d0 + 1] = *(const LAS bf16x8*)(kb + (r32 + 32) * 128 + ch); }
}
__device__ __forceinline__ void qk_mma(f32x16& p0, f32x16& p1, const bf16x8 (&kf)[8], const bf16x8 (&qf)[4]) {
#pragma unroll
    for (int d0 = 0; d0 < 4; ++d0) { p0 = __builtin_amdgcn_mfma_f32_32x32x16_bf16(kf[2 * d0], qf[d0], p0, 0, 0, 0); p1 = __builtin_amdgcn_mfma_f32_32x32x16_bf16(kf[2 * d0 + 1], qf[d0], p1, 0, 0, 0); }
}
__device__ __forceinline__ void qk_mma_c(f32x16& p0, f32x16& p1, const f32x16& cinit, const bf16x8 (&kf)[8], const bf16x8 (&qf)[4]) {
    p0 = __builtin_amdgcn_mfma_f32_32x32x16_bf16(kf[0], qf[0], cinit, 0, 0, 0); p1 = __builtin_amdgcn_mfma_f32_32x32x16_bf16(kf[1], qf[0], cinit, 0, 0, 0);
#pragma unroll
    for (int d0 = 1; d0 < 4; ++d0) { p0 = __builtin_amdgcn_mfma_f32_32x32x16_bf16(kf[2 * d0], qf[d0], p0, 0, 0, 0); p1 = __builtin_amdgcn_mfma_f32_32x32x16_bf16(kf[2 * d0 + 1], qf[d0], p1, 0, 0, 0); }
}
__device__ __forceinline__ void vfrag_load(s16x4 (&vlo)[8], s16x4 (&vhi)[8], const LAS char* vb, int lane, int hi) {
    const int x = ((lane >> 3) & 1) * 64;
    const LAS char* vq = vb + (4 * hi + ((lane & 15) >> 2)) * 128 + ((lane >> 4) & 1) * 32 + (lane & 3) * 8;
    const LAS char* v0 = vq + x; const LAS char* v1 = vq + (64 ^ x);
#pragma unroll
    for (int ks = 0; ks < 4; ++ks) { vlo[ks] = vtr(v0 + ks * 2048); vhi[ks] = vtr(v0 + ks * 2048 + 1024); vlo[4 + ks] = vtr(v1 + ks * 2048); vhi[4 + ks] = vtr(v1 + ks * 2048 + 1024); }
}
typedef __bf16 bf16v2 __attribute__((ext_vector_type(2)));
__device__ __forceinline__ unsigned pkbf(float lo, float hi) { const f32x2 v = {lo, hi}; return __builtin_bit_cast(unsigned, __builtin_convertvector(v, bf16v2)); }
__device__ __forceinline__ void pv_mma(f32x16 (&o)[2], const f32x16& p0, const f32x16& p1, const s16x4 (&vlo)[8], const s16x4 (&vhi)[8]) {
    u32x4 pa[4];
#pragma unroll
    for (int i = 0; i < 4; ++i) { pa[0][i] = pkbf(p0[2 * i], p0[2 * i + 1]); pa[1][i] = pkbf(p0[8 + 2 * i], p0[8 + 2 * i + 1]);
                                  pa[2][i] = pkbf(p1[2 * i], p1[2 * i + 1]); pa[3][i] = pkbf(p1[8 + 2 * i], p1[8 + 2 * i + 1]); }
    LDS_WAIT(); SCHED_FENCE();
#pragma unroll
    for (int d0 = 0; d0 < 2; ++d0)
#pragma unroll
        for (int ks = 0; ks < 4; ++ks) {
            const s16x4 lo = vlo[4 * d0 + ks], hh = vhi[4 * d0 + ks];
            const bf16x8 vf = __builtin_shufflevector(lo, hh, 0, 1, 2, 3, 4, 5, 6, 7);
            o[d0] = __builtin_amdgcn_mfma_f32_32x32x16_bf16(__builtin_bit_cast(bf16x8, pa[ks]), vf, o[d0], 0, 0, 0);
        }
}
__device__ __forceinline__ void pv_mma_m(f32x16 (&o)[2], const f32x16& p0, const f32x16& p1, const s16x4 (&vlo)[8], const s16x4 (&vhi)[8], unsigned mw) {
    u32x4 pa[4];
#pragma unroll
    for (int i = 0; i < 4; ++i) { pa[0][i] = pkbf(p0[2 * i], p0[2 * i + 1]) & mw; pa[1][i] = pkbf(p0[8 + 2 * i], p0[8 + 2 * i + 1]) & mw;
                                  pa[2][i] = pkbf(p1[2 * i], p1[2 * i + 1]) & mw; pa[3][i] = pkbf(p1[8 + 2 * i], p1[8 + 2 * i + 1]) & mw; }
    LDS_WAIT(); SCHED_FENCE();
#pragma unroll
    for (int d0 = 0; d0 < 2; ++d0)
#pragma unroll
        for (int ks = 0; ks < 4; ++ks) {
            const s16x4 lo = vlo[4 * d0 + ks], hh = vhi[4 * d0 + ks];
            const bf16x8 vf = __builtin_shufflevector(lo, hh, 0, 1, 2, 3, 4, 5, 6, 7);
            o[d0] = __builtin_amdgcn_mfma_f32_32x32x16_bf16(__builtin_bit_cast(bf16x8, pa[ks]), vf, o[d0], 0, 0, 0);
        }
}
#define TILE_QK(p0, p1, kb, vb) \
    bf16x8 kf_[8]; s16x4 vlo_[8], vhi_[8]; \
    kfrag_load(kf_, (kb), r32, hi); LDS_WAIT(); SCHED_FENCE(); \
    qk_mma(p0, p1, kf_, qf); SCHED_FENCE(); \
    vfrag_load(vlo_, vhi_, (vb), lane, hi); SCHED_FENCE(); \
    exp_sum(p0, p1);
#define TILE_PV(o, p0, p1) pv_mma(o, p0, p1, vlo_, vhi_); SCHED_FENCE();
#define TILE_QK_C(p0, p1, cinit, kb, vb) \
    bf16x8 kf_[8]; s16x4 vlo_[8], vhi_[8]; \
    kfrag_load(kf_, (kb), r32, hi); LDS_WAIT(); SCHED_FENCE(); \
    qk_mma_c(p0, p1, cinit, kf_, qf); SCHED_FENCE(); \
    vfrag_load(vlo_, vhi_, (vb), lane, hi); SCHED_FENCE(); \
    exp_sum(p0, p1);
#define QK_ONLY(p0, p1, kb) { bf16x8 kf_[8]; kfrag_load(kf_, (kb), r32, hi); LDS_WAIT(); SCHED_FENCE(); qk_mma(p0, p1, kf_, qf); SCHED_FENCE(); } exp_sum(p0, p1);
#define PV_ONLY(o, p0, p1, vb) { s16x4 vlo_[8], vhi_[8]; vfrag_load(vlo_, vhi_, (vb), lane, hi); pv_mma(o, p0, p1, vlo_, vhi_); SCHED_FENCE(); }
#define HALF_BAR() asm volatile("s_waitcnt lgkmcnt(0)\n\ts_barrier" ::: "memory")
__device__ __forceinline__ void exp_sum(f32x16& p0, f32x16& p1) {
#pragma unroll
    for (int r = 0; r < 16; ++r) { p0[r] = __builtin_amdgcn_exp2f(p0[r]); p1[r] = __builtin_amdgcn_exp2f(p1[r]); }
}
#define OPQ(x) asm("" : "+v"(x))
__device__ __forceinline__ float psum(const f32x16& p0, const f32x16& p1) {
    float s0 = p0[0], s1 = p1[0], s2 = p0[8], s3 = p1[8];
#pragma unroll
    for (int r = 1; r < 8; ++r) { s0 += p0[r]; OPQ(s0); s1 += p1[r]; OPQ(s1); s2 += p0[r + 8]; OPQ(s2); s3 += p1[r + 8]; OPQ(s3); }
    s0 += s2; OPQ(s0); s1 += s3; OPQ(s1);
    return s0 + s1;
}
__device__ __forceinline__ void p_pack(u32x4 (&pa)[4], const f32x16& p0, const f32x16& p1) {
#pragma unroll
    for (int i = 0; i < 4; ++i) { pa[0][i] = pkbf(p0[2 * i], p0[2 * i + 1]); pa[1][i] = pkbf(p0[8 + 2 * i], p0[8 + 2 * i + 1]); pa[2][i] = pkbf(p1[2 * i], p1[2 * i + 1]); pa[3][i] = pkbf(p1[8 + 2 * i], p1[8 + 2 * i + 1]); }
}
__device__ __forceinline__ void pv_mma_p(f32x16 (&o)[2], const u32x4 (&pa)[4], const s16x4 (&vlo)[8], const s16x4 (&vhi)[8]) {
#pragma unroll
    for (int ks = 0; ks < 4; ++ks)
#pragma unroll
        for (int d0 = 0; d0 < 2; ++d0) {
            const bf16x8 vf = __builtin_shufflevector(vlo[4 * d0 + ks], vhi[4 * d0 + ks], 0, 1, 2, 3, 4, 5, 6, 7);
            o[d0] = __builtin_amdgcn_mfma_f32_32x32x16_bf16(__builtin_bit_cast(bf16x8, pa[ks]), vf, o[d0], 0, 0, 0);
        }
}
#define SG_PAIR(nv) do { _Pragma("unroll") for (int g_ = 0; g_ < 8; ++g_) { __builtin_amdgcn_sched_group_barrier(0x008, 1, 0); __builtin_amdgcn_sched_group_barrier(0x402, (nv), 0); } } while (0)
__device__ __forceinline__ void rows_from_cols(float s, LAS float* wsf, int r32, int hi, float (&out)[16]) {
    LDS_WAIT();
    if (hi == 0) wsf[r32] = s;
    LDS_WAIT();
#pragma unroll
    for (int m = 0; m < 4; ++m) { const f32x4 t = *(const LAS f32x4*)(wsf + 8 * m + 4 * hi); out[4 * m] = t[0]; out[4 * m + 1] = t[1]; out[4 * m + 2] = t[2]; out[4 * m + 3] = t[3]; }
    LDS_WAIT();
}

__device__ __forceinline__ void fox_unit(LAS char* lds, int b, int h, int qb, const bf16_t* Q, const bf16_t* K, const bf16_t* V, bf16_t* O, const float* CUM, float M2) {
    int tid_ = threadIdx.x; asm volatile("" : "+v"(tid_));
    const int tid = tid_, lane = tid & 63, r32 = lane & 31, hi = lane >> 5, wid = __builtin_amdgcn_readfirstlane(tid >> 6);
    const int q0 = qb * 256, qpos = q0 + 32 * wid + r32;
    const size_t rowbase = (size_t)b * SEQ;
    const bf16_t* Kg = K + rowbase * DM + h * HD; const bf16_t* Vg = V + rowbase * DM + h * HD;
    const float* ckg = CUM + (size_t)(b * NH + h) * SEQ;
    const int NT = (q0 + 256) / 64;
    ring_issue<true>(lds, 0, Kg, Vg, DM, 64 * (NT - 2), ckg, wid, lane); ring_issue<true>(lds, 1, Kg, Vg, DM, 64 * (NT - 1), ckg, wid, lane);
    ring_issue<true>(lds, 2, Kg, Vg, DM, 64 * (NT - 4), ckg, wid, lane); ring_issue<true>(lds, 3, Kg, Vg, DM, 64 * (NT - 3), ckg, wid, lane);
    bf16x8 qf[4];
    { const bf16_t* qp = Q + (rowbase + qpos) * DM + h * HD;
#pragma unroll
      for (int d0 = 0; d0 < 4; ++d0) qf[d0] = *(const bf16x8*)(qp + d0 * 16 + hi * 8); }
    const float cq = ckg[qpos] - M2;
    f32x16 o[2]; o[0] = (f32x16){}; o[1] = (f32x16){}; float lsum = 0.f;
    const int wave_last = (q0 + 32 * wid + 31) >> 6;
    int t0 = 0;
    { const float c0 = ckg[q0];
      int t = NT - 5;
#pragma unroll 1
      for (int base = NT - 5; base >= 0; base -= 64) {
          const int tt = base - lane; const float ce = ckg[64 * (tt >= 0 ? tt : 0) + 63]; const float lim = c0 + (46.f + 2.f * M2); const bool skip = (tt >= 0) && (ce > lim);
          const unsigned long long bm = __ballot(skip);
          if (bm) { t = base - (int)__builtin_ctzll(bm); break; }
          t = base - 64;
      }
      t0 = __builtin_amdgcn_readfirstlane(t < 0 ? 0 : t + 1); }
#define FOX_TILE(t_, slot_) do { if ((t_) <= wave_last) { \
            f32x16 p0, p1; \
            const LAS float* ck = (const LAS float*)(lds + L_CK + ((slot_) * 8 + wid) * 256); \
            _Pragma("unroll") for (int m = 0; m < 4; ++m) { const f32x4 a = *(const LAS f32x4*)(ck + 8 * m + 4 * hi), c = *(const LAS f32x4*)(ck + 32 + 8 * m + 4 * hi); \
                _Pragma("unroll") for (int j = 0; j < 4; ++j) { p0[4 * m + j] = cq - a[j]; p1[4 * m + j] = cq - c[j]; } } \
            TILE_QK(p0, p1, lds + L_K + (slot_) * 8192, lds + L_V + (slot_) * 8192) \
            if (64 * (t_) + 63 > q0 + 32 * wid) { const int kb = 64 * (t_) + 4 * hi; \
                _Pragma("unroll") for (int r = 0; r < 16; ++r) { const int kv = kb + (r & 3) + 8 * (r >> 2); if (kv > qpos) p0[r] = 0.f; if (kv + 32 > qpos) p1[r] = 0.f; } } \
            lsum += psum(p0, p1); \
            TILE_PV(o, p0, p1) } } while (0)
#define FOX_INIT(p0, p1, slot_) do { const LAS float* ck = (const LAS float*)(lds + L_CK + ((slot_) * 8 + wid) * 256); \
            _Pragma("unroll") for (int m = 0; m < 4; ++m) { const f32x4 a = *(const LAS f32x4*)(ck + 8 * m + 4 * hi), c = *(const LAS f32x4*)(ck + 32 + 8 * m + 4 * hi); \
                _Pragma("unroll") for (int j = 0; j < 4; ++j) { p0[4 * m + j] = cq - a[j]; p1[4 * m + j] = cq - c[j]; } } } while (0)
#define FOX_PAIR(sa, sb) do { \
            f32x16 a0, a1, b0, b1; u32x4 pa[4], pb[4]; \
            { bf16x8 kfa[8]; FOX_INIT(a0, a1, sa); kfrag_load(kfa, lds + L_K + (sa) * 8192, r32, hi); LDS_WAIT(); SCHED_FENCE(); \
              qk_mma(a0, a1, kfa, qf); SCHED_FENCE(); } \
            { bf16x8 kfb[8]; s16x4 val[8], vah[8]; \
              FOX_INIT(b0, b1, sb); kfrag_load(kfb, lds + L_K + (sb) * 8192, r32, hi); LDS_WAIT(); SCHED_FENCE(); \
              vfrag_load(val, vah, lds + L_V + (sa) * 8192, lane, hi); SCHED_FENCE(); \
              qk_mma(b0, b1, kfb, qf); exp_sum(a0, a1); lsum += psum(a0, a1); p_pack(pa, a0, a1); SCHED_FENCE(); \
              LDS_WAIT(); SCHED_FENCE(); \
              pv_mma_p(o, pa, val, vah); exp_sum(b0, b1); lsum += psum(b0, b1); p_pack(pb, b0, b1); SCHED_FENCE(); } \
            { s16x4 vbl[8], vbh[8]; vfrag_load(vbl, vbh, lds + L_V + (sb) * 8192, lane, hi); LDS_WAIT(); SCHED_FENCE(); \
              pv_mma_p(o, pb, vbl, vbh); SCHED_FENCE(); } } while (0)
    int sp = 0;
#pragma unroll 1
    for (int ta = NT - 2; ta + 1 >= t0; ta -= 2) {
        RING_WAIT_BAR(0);
        if (ta != NT - 2) {
            const int na = ta - 2;
            if (na + 1 >= t0) { if (na >= t0) ring_issue<true>(lds, 2 * (sp ^ 1), Kg, Vg, DM, 64 * na, ckg, wid, lane);
                                ring_issue<true>(lds, 2 * (sp ^ 1) + 1, Kg, Vg, DM, 64 * (na + 1), ckg, wid, lane); }
        }
        if (ta >= t0 && ta + 1 < wave_last) { FOX_PAIR(2 * sp, 2 * sp + 1); }
        else { if (ta >= t0) FOX_TILE(ta, 2 * sp);
               FOX_TILE(ta + 1, 2 * sp + 1); }
        sp ^= 1;
    }
#undef FOX_TILE
#undef FOX_PAIR
#undef FOX_INIT
    RING_WAIT_BAR(0);
    lsum += __shfl_xor(lsum, 32);
    float sc[16];
    rows_from_cols(1.f / lsum, (LAS float*)(lds + L_WSF) + wid * 64, r32, hi, sc);
    { LAS bf16_t* stg = (LAS bf16_t*)(lds + wid * 4096);
#pragma unroll
      for (int r = 0; r < 16; ++r) { const int q = crow(r, hi); stg[q * 64 + r32] = (bf16_t)f2bf(o[0][r] * sc[r]); stg[q * 64 + 32 + r32] = (bf16_t)f2bf(o[1][r] * sc[r]); }
      LDS_WAIT();
      bf16_t* Ow = O + (rowbase + q0 + 32 * wid) * DM + h * HD;
#pragma unroll
      for (int i = 0; i < 4; ++i) { const int rw = (lane >> 3) + 8 * i, ch = lane & 7; const u32x4 v = *(const LAS u32x4*)(stg + rw * 64 + ch * 8); *(u32x4*)(Ow + (size_t)rw * DM + ch * 8) = v; } }
    __syncthreads();
}

struct NsaArgs { const bf16_t *QP, *QR, *KCMP, *VCMP, *KSEL, *VSEL, *KWIN, *VWIN; const float* GATES; bf16_t* O; float Mcmp, Msel, Mwin; };

__device__ __forceinline__ int next_bit4(unsigned u0, unsigned u1, unsigned u2, unsigned u3, int from) {
    if (from >= 128) return 128;
    const int w = from >> 5; const unsigned mlow = ~0u << (from & 31);
    unsigned x;
    x = (w == 0) ? (u0 & mlow) : 0u;                         if (x) return __builtin_ctz(x);
    x = (w == 1) ? (u1 & mlow) : (w < 1 ? u1 : 0u);          if (x) return 32 + __builtin_ctz(x);
    x = (w == 2) ? (u2 & mlow) : (w < 2 ? u2 : 0u);          if (x) return 64 + __builtin_ctz(x);
    x = (w == 3) ? (u3 & mlow) : (w < 3 ? u3 : 0u);          if (x) return 96 + __builtin_ctz(x);
    return 128;
}

__device__ __forceinline__ void nsa_unit(LAS char* lds, int b, int g, int c, const NsaArgs& A) {
    int tid_ = threadIdx.x; asm volatile("" : "+v"(tid_));
    const int tid = tid_, lane = tid & 63, r32 = lane & 31, hi = lane >> 5, wid = __builtin_amdgcn_readfirstlane(tid >> 6);
    const int q0 = 64 * c, ti = 8 * wid + (r32 >> 2);
    const int head = 4 * g + (r32 & 3);
    const size_t row = (size_t)b * SEQ + q0 + ti;
    LAS float* wsf = (LAS float*)(lds + L_WSF) + wid * 64;

    LAS float* osl = (LAS float*)(lds + L_OS) + wid * 2048 + lane;

    unsigned mw0 = 0u, mw1 = 0u, mw2 = 0u, mw3 = 0u;
    const float gate_c = A.GATES[row * 48 + head * 3 + 0], gate_s = A.GATES[row * 48 + head * 3 + 1], gate_w = A.GATES[row * 48 + head * 3 + 2];
    bf16x8 qf[4];
    { const bf16_t* qp = A.QR + row * DM + head * HD;
#pragma unroll
      for (int d0 = 0; d0 < 4; ++d0) qf[d0] = *(const bf16x8*)(qp + d0 * 16 + hi * 8); }
    {
        bf16x8 qfp[4];
        { const bf16_t* qp = A.QP + row * DM + head * HD;
#pragma unroll
          for (int d0 = 0; d0 < 4; ++d0) qfp[d0] = *(const bf16x8*)(qp + d0 * 16 + hi * 8); }
        const bf16_t* Kg = A.KCMP + (size_t)b * NCMPB * 256 + g * HD; const bf16_t* Vg = A.VCMP + (size_t)b * NCMPB * 256 + g * HD;
        const int nvis = (q0 + ti + 1) >> 6;
        const int ntl = (c + 1 > 64) ? 2 : 1;
        { const bf16_t* Kw = A.KWIN + (size_t)b * SEQ * 256 + g * HD; const bf16_t* Vw = A.VWIN + (size_t)b * SEQ * 256 + g * HD; const int tlo = c >= 8 ? c - 8 : 0;
          ring_issue<false>(lds, 2, Kw, Vw, 256, 64 * tlo, nullptr, wid, lane);
          if (tlo + 1 <= c) ring_issue<false>(lds, 3, Kw, Vw, 256, 64 * (tlo + 1), nullptr, wid, lane); }
        ring_issue<false>(lds, 0, Kg, Vg, 256, 0, nullptr, wid, lane);
        if (ntl == 2) ring_issue<false>(lds, 1, Kg, Vg, 256, 64, nullptr, wid, lane);
        RING_WAIT_BAR(0);
        float lsum = 0.f;
#pragma unroll 1
        for (int t = 0; t < ntl; ++t) {
            f32x16 p0, p1;
#pragma unroll
            for (int r = 0; r < 16; ++r) { p0[r] = -A.Mcmp; p1[r] = -A.Mcmp; }
            { bf16x8 kf_[8]; kfrag_load(kf_, lds + L_K + t * 8192, r32, hi); LDS_WAIT(); SCHED_FENCE(); qk_mma(p0, p1, kf_, qfp); SCHED_FENCE(); }
            exp_sum(p0, p1);
#pragma unroll
            for (int r = 0; r < 16; ++r) { const int n = 64 * t + crow(r, hi); if (n >= nvis) p0[r] = 0.f; if (n + 32 >= nvis) p1[r] = 0.f; }
            lsum += psum(p0, p1);
        }
        lsum += __shfl_xor(lsum, 32);
        const float inv = lsum > 0.f ? 1.f / lsum : 0.f;
        const int k4 = lane & 3;
        unsigned keys[16];
#pragma unroll
        for (int i = 0; i < 16; ++i) keys[i] = 0u;
        f32x16 o[2]; o[0] = (f32x16){}; o[1] = (f32x16){};
#pragma unroll
        for (int t = 0; t < 2; ++t) {
            if (t < ntl) {
                f32x16 p0, p1;
#pragma unroll
                for (int r = 0; r < 16; ++r) { p0[r] = -A.Mcmp; p1[r] = -A.Mcmp; }
                bf16x8 kf_[8]; s16x4 vlo_[8], vhi_[8];
                kfrag_load(kf_, lds + L_K + t * 8192, r32, hi); LDS_WAIT(); SCHED_FENCE();
                qk_mma(p0, p1, kf_, qfp); SCHED_FENCE();
                vfrag_load(vlo_, vhi_, lds + L_V + t * 8192, lane, hi); SCHED_FENCE();
                exp_sum(p0, p1);
#pragma unroll
                for (int r = 0; r < 16; ++r) { const int n = 64 * t + crow(r, hi); if (n >= nvis) p0[r] = 0.f; if (n + 32 >= nvis) p1[r] = 0.f; }
                TILE_PV(o, p0, p1)
#pragma unroll
                for (int jj = 0; jj < 2; ++jj)
#pragma unroll
                    for (int m4 = 0; m4 < 4; ++m4) {
                        const float v0 = (jj ? p1[4 * m4] : p0[4 * m4]) * inv, v1 = (jj ? p1[4 * m4 + 1] : p0[4 * m4 + 1]) * inv, v2 = (jj ? p1[4 * m4 + 2] : p0[4 * m4 + 2]) * inv, v3 = (jj ? p1[4 * m4 + 3] : p0[4 * m4 + 3]) * inv;
                        const float s01 = (k4 & 1) ? v0 : v1, k01 = (k4 & 1) ? v1 : v0; const float a01 = k01 + dppx1f(s01);
                        const float s23 = (k4 & 1) ? v2 : v3, k23 = (k4 & 1) ? v3 : v2; const float a23 = k23 + dppx1f(s23);
                        const float s2 = (k4 & 2) ? a01 : a23, k2 = (k4 & 2) ? a23 : a01; const float imp = k2 + dppx2f(s2);
                        const int j = 2 * t + jj;
                        const int n = 32 * j + 8 * m4 + 4 * hi + k4;
                        const bool valid = (n >= 1) && (n <= c - 2);
                        keys[4 * j + m4] = valid ? ((__float_as_uint(imp) & ~127u) | (unsigned)(127 - n) | 0x80000000u) : 0u;
                    }
            }
        }
        { float sc[16]; rows_from_cols(inv * gate_c, wsf, r32, hi, sc);
#pragma unroll
          for (int r = 0; r < 16; ++r) { osl[r * 64] = o[0][r] * sc[r]; osl[(16 + r) * 64] = o[1][r] * sc[r]; } }
        if (c + 1 <= 16) {
            mw0 = (1u << (c + 1)) - 1u;
        } else {
#pragma unroll 1
            for (int round = 0; round < 13; ++round) {
                unsigned mx = keys[0];
#pragma unroll
                for (int i = 1; i < 16; ++i) mx = mx > keys[i] ? mx : keys[i];
                { const unsigned t1 = (unsigned)dppx1((int)mx); mx = mx > t1 ? mx : t1; }
                { const unsigned t2 = (unsigned)dppx2((int)mx); mx = mx > t2 ? mx : t2; }
                { const auto rr = __builtin_amdgcn_permlane32_swap(mx, mx, false, false); const unsigned t3 = rr[0] > rr[1] ? rr[0] : rr[1]; mx = mx > t3 ? mx : t3; }
#pragma unroll
                for (int i = 0; i < 16; ++i) keys[i] = (keys[i] == mx) ? 0u : keys[i];
            }
#pragma unroll
            for (int j = 0; j < 4; ++j) {
                unsigned wbits = 0u;
#pragma unroll
                for (int m4 = 0; m4 < 4; ++m4) {
                    const int n = 32 * j + 8 * m4 + 4 * hi + k4;
                    const bool valid = (n >= 1) && (n <= c - 2);
                    if (valid && keys[4 * j + m4] == 0u) wbits |= 1u << (8 * m4 + 4 * hi + k4);
                }
                wbits |= (unsigned)dppx1((int)wbits); wbits |= (unsigned)dppx2((int)wbits); wbits |= (unsigned)__shfl_xor((int)wbits, 32);
                if (j == 0) mw0 = wbits; else if (j == 1) mw1 = wbits; else if (j == 2) mw2 = wbits; else mw3 = wbits;
            }
            mw0 |= 1u;
            { const int n = c - 1; const unsigned bt = 1u << (n & 31); if ((n >> 5) == 0) mw0 |= bt; else if ((n >> 5) == 1) mw1 |= bt; else if ((n >> 5) == 2) mw2 |= bt; else mw3 |= bt; }
            { const int n = c;     const unsigned bt = 1u << (n & 31); if ((n >> 5) == 0) mw0 |= bt; else if ((n >> 5) == 1) mw1 |= bt; else if ((n >> 5) == 2) mw2 |= bt; else mw3 |= bt; }
        }
    }
    __syncthreads();
    {
        const bf16_t* Kg = A.KWIN + (size_t)b * SEQ * 256 + g * HD; const bf16_t* Vg = A.VWIN + (size_t)b * SEQ * 256 + g * HD;
        const int tlo = c >= 8 ? c - 8 : 0;
        f32x16 o[2]; o[0] = (f32x16){}; o[1] = (f32x16){}; float lsum = 0.f;
        f32x16 negm;
        { float mv_ = -A.Mwin; asm volatile("" : "+v"(mv_));
#pragma unroll
          for (int r = 0; r < 16; ++r) negm[r] = mv_; }
#define WIN_TILE(t_, slot_) do { f32x16 p0, p1; \
            TILE_QK_C(p0, p1, negm, lds + L_K + (slot_) * 8192, lds + L_V + (slot_) * 8192) \
            if ((t_) == c) { _Pragma("unroll") for (int r = 0; r < 16; ++r) { const int kl = crow(r, hi); if (kl > ti) p0[r] = 0.f; if (kl + 32 > ti) p1[r] = 0.f; } } \
            else if ((t_) == c - 8) { _Pragma("unroll") for (int r = 0; r < 16; ++r) { const int kl = crow(r, hi); if (kl <= ti) p0[r] = 0.f; if (kl + 32 <= ti) p1[r] = 0.f; } } \
            lsum += psum(p0, p1); \
            TILE_PV(o, p0, p1) } while (0)
        int sp = 1;
#pragma unroll 1
        for (int t = tlo; t <= c; t += 2) {
            RING_WAIT_BAR(0);
            if (t + 2 <= c) ring_issue<false>(lds, 2 * (sp ^ 1), Kg, Vg, 256, 64 * (t + 2), nullptr, wid, lane);
            if (t + 3 <= c) ring_issue<false>(lds, 2 * (sp ^ 1) + 1, Kg, Vg, 256, 64 * (t + 3), nullptr, wid, lane);
            WIN_TILE(t, 2 * sp);
            if (t + 1 <= c) WIN_TILE(t + 1, 2 * sp + 1);
            sp ^= 1;
        }
        RING_WAIT_BAR(0);
#undef WIN_TILE
        lsum += __shfl_xor(lsum, 32);
        float sc[16]; rows_from_cols(gate_w / lsum, wsf, r32, hi, sc);
#pragma unroll
        for (int r = 0; r < 16; ++r) { osl[r * 64] += o[0][r] * sc[r]; osl[(16 + r) * 64] += o[1][r] * sc[r]; }
    }
    {
        f32x16 o[2]; o[0] = (f32x16){}; o[1] = (f32x16){}; float lsum = 0.f;
        f32x16 negm;
        { float mv_ = -A.Msel; asm volatile("" : "+v"(mv_));
#pragma unroll
          for (int r = 0; r < 16; ++r) negm[r] = mv_; }
        const bf16_t* Kb = A.KSEL + (size_t)(b * NCMPB) * NG * 4096 + g * 4096; const bf16_t* Vb = A.VSEL + (size_t)(b * NCMPB) * NG * 4096 + g * 4096;
        unsigned U0 = mw0, U1 = mw1, U2 = mw2, U3 = mw3;
#pragma unroll
        for (int s = 4; s <= 16; s <<= 1) { U0 |= (unsigned)__shfl_xor((int)U0, s); U1 |= (unsigned)__shfl_xor((int)U1, s); U2 |= (unsigned)__shfl_xor((int)U2, s); U3 |= (unsigned)__shfl_xor((int)U3, s); }
        U0 = __builtin_amdgcn_readfirstlane(U0); U1 = __builtin_amdgcn_readfirstlane(U1); U2 = __builtin_amdgcn_readfirstlane(U2); U3 = __builtin_amdgcn_readfirstlane(U3);
        bf16x8 kf[8], vf[8];
#define SEL_LOADK(n_) do { const bf16_t* kp = Kb + (size_t)(n_) * (NG * 4096) + (hi * 64 + r32) * 8; \
            _Pragma("unroll") for (int d0 = 0; d0 < 4; ++d0) { kf[2 * d0] = *(const bf16x8*)(kp + d0 * 1024); kf[2 * d0 + 1] = *(const bf16x8*)(kp + d0 * 1024 + 256); } } while (0)
#define SEL_LOADV(n_) do { const bf16_t* vp = Vb + (size_t)(n_) * (NG * 4096) + (hi * 32 + r32) * 8; \
            _Pragma("unroll") for (int ks = 0; ks < 4; ++ks) _Pragma("unroll") for (int d0 = 0; d0 < 2; ++d0) vf[2 * ks + d0] = *(const bf16x8*)(vp + (ks * 2 + d0) * 512); } while (0)
        LAS unsigned char* blist = (LAS unsigned char*)(lds + L_CK + wid * 256);
        { const unsigned b0 = ((lane < 32 ? U0 : U1) >> (lane & 31)) & 1u, b1 = ((lane < 32 ? U2 : U3) >> (lane & 31)) & 1u;
          const int c01 = __builtin_popcount(U0) + __builtin_popcount(U1), c23 = __builtin_popcount(U2) + __builtin_popcount(U3);
          const int p0_ = (int)__builtin_amdgcn_mbcnt_hi(U1, __builtin_amdgcn_mbcnt_lo(U0, 0u)), p1_ = c01 + (int)__builtin_amdgcn_mbcnt_hi(U3, __builtin_amdgcn_mbcnt_lo(U2, 0u));
          if (b0) blist[p0_] = (unsigned char)lane;
          if (b1) blist[p1_] = (unsigned char)(64 + lane);
          if (lane < 4) blist[c01 + c23 + lane] = 255; }
        int n = __builtin_amdgcn_readfirstlane((int)blist[0]), n2 = __builtin_amdgcn_readfirstlane((int)blist[1]);
        int li = 2; int nxv = (int)blist[2];
        SEL_LOADK(n); SEL_LOADV(n);
#pragma unroll 1
        while (n < 128) {
            const unsigned wn = (n >> 5) == 0 ? mw0 : (n >> 5) == 1 ? mw1 : (n >> 5) == 2 ? mw2 : mw3;
            const bool mine = (wn >> (n & 31)) & 1u;
            f32x16 p0, p1;
            qk_mma_c(p0, p1, negm, kf, qf); SCHED_FENCE();
            if (n2 < 128) SEL_LOADK(n2);
            SCHED_FENCE();
            exp_sum(p0, p1);
            if (n == c) {
#pragma unroll
                for (int r = 0; r < 16; ++r) { const int kl = crow(r, hi); if (kl > ti) p0[r] = 0.f; if (kl + 32 > ti) p1[r] = 0.f; }
            }
            const unsigned keepw = mine ? 0xffffffffu : 0u; const float keep = mine ? 1.f : 0.f;
            lsum += keep * psum(p0, p1);
            u32x4 pa[4];
#pragma unroll
            for (int i = 0; i < 4; ++i) { pa[0][i] = pkbf(p0[2 * i], p0[2 * i + 1]) & keepw; pa[1][i] = pkbf(p0[8 + 2 * i], p0[8 + 2 * i + 1]) & keepw;
                                          pa[2][i] = pkbf(p1[2 * i], p1[2 * i + 1]) & keepw; pa[3][i] = pkbf(p1[8 + 2 * i], p1[8 + 2 * i + 1]) & keepw; }
#pragma unroll
            for (int ks = 0; ks < 4; ++ks) { o[0] = __builtin_amdgcn_mfma_f32_32x32x16_bf16(__builtin_bit_cast(bf16x8, pa[ks]), vf[2 * ks], o[0], 0, 0, 0);
                                             o[1] = __builtin_amdgcn_mfma_f32_32x32x16_bf16(__builtin_bit_cast(bf16x8, pa[ks]), vf[2 * ks + 1], o[1], 0, 0, 0); }
            SCHED_FENCE();
            if (n2 < 128) SEL_LOADV(n2);
            SCHED_FENCE();
            n = n2; n2 = __builtin_amdgcn_readfirstlane(nxv); ++li; nxv = (int)blist[li];
        }
#undef SEL_LOADK
#undef SEL_LOADV
        lsum += __shfl_xor(lsum, 32);
        float sc[16]; rows_from_cols(gate_s / lsum, wsf, r32, hi, sc);
        bf16_t* Ob = A.O + ((size_t)b * SEQ + q0 + 8 * wid) * DM + 4 * g * HD;
        { LAS bf16_t* stg = (LAS bf16_t*)(lds + wid * 4096);
#pragma unroll
          for (int r = 0; r < 16; ++r) { const int q = crow(r, hi); stg[q * 64 + r32] = (bf16_t)f2bf(osl[r * 64] + o[0][r] * sc[r]); stg[q * 64 + 32 + r32] = (bf16_t)f2bf(osl[(16 + r) * 64] + o[1][r] * sc[r]); }
          LDS_WAIT();
#pragma unroll
          for (int i = 0; i < 4; ++i) { const int rw = (lane >> 3) + 8 * i, ch = lane & 7; const u32x4 v = *(const LAS u32x4*)(stg + rw * 64 + ch * 8);
              *(u32x4*)(Ob + (size_t)(rw >> 2) * DM + (rw & 3) * HD + ch * 8) = v; } }
    }
    __syncthreads();
}
}
struct Args { const float* in[N_IN]; float* out; unsigned char* ws; int ph_lo, ph_hi; };
#define AS4 __attribute__((address_space(4)))
typedef const float* const AS4* KIn;
struct Ctx {
    const int* pos; float* out; unsigned char* ws;
    LAS unsigned char* lds; unsigned* ctl; int tid, lane, wave, G, bid;
};

enum { MAP_ID = 0, MAP_HPERM = 1, MAP_IL8 = 2 };
template <int MAP> __device__ __forceinline__ int rowmap(int s) {
    if (MAP == MAP_HPERM) return (s & ~255) + 128 * ((s >> 5) & 1) + 32 * ((s >> 6) & 3) + (s & 31);
    if (MAP == MAP_IL8) return (s & ~255) + 128 * ((s >> 5) & 1) + 32 * ((s >> 6) & 3) + 8 * ((s >> 2) & 3) + 4 * ((s >> 4) & 1) + (s & 3);
    return s;
}
template <int MAP>
__device__ __forceinline__ void xitem64(const float* W, int ld, int sc0, int k0, bf16_t* WT, int Kd, int rowoff, int mapbase, LAS float* scr, int lane, bool probe_rep = false) {
    f32x4 v[16];
#pragma unroll
    for (int i = 0; i < 16; ++i) { const int kk = 4 * i + (lane >> 4);
        v[i] = *(const f32x4*)(W + (size_t)(k0 + kk) * ld + sc0 + 4 * (lane & 15)); }
#pragma unroll
    for (int i = 0; i < 16; ++i) { const int kk = 4 * i + (lane >> 4); *(LAS f32x4*)(scr + kk * 64 + 4 * ((lane & 15) ^ ((kk >> 3) & 7))) = v[i]; }
    LDS_WAIT(); asm volatile("" ::: "memory");
    const int c = lane & 7;
#pragma unroll
    for (int j = 0; j < 8; ++j) { const int n = (lane >> 3) + 8 * j; const LAS float* sp = scr + (8 * c) * 64 + 4 * ((n >> 2) ^ c) + (n & 3);
        u32x4 o; o.x = cvt_pk_bf16(sp[0 * 64], sp[1 * 64]); o.y = cvt_pk_bf16(sp[2 * 64], sp[3 * 64]); o.z = cvt_pk_bf16(sp[4 * 64], sp[5 * 64]); o.w = cvt_pk_bf16(sp[6 * 64], sp[7 * 64]);
        *(u32x4*)(WT + (size_t)(rowoff + rowmap<MAP>(mapbase + n)) * Kd + k0 + 8 * c) = o; }
    LDS_WAIT(); asm volatile("" ::: "memory");
}
template <int MAP>
__device__ __forceinline__ void conv_dense(Ctx& C, const float* src, int ld, int K, int N, bf16_t* dst, int gw, int ngw) {
    LAS float* scr = (LAS float*)(C.lds + C.wave * 16384);
    const int nkb = K / 64, nnb = N / 64;
    for (int it = gw; it < nkb * nnb; it += ngw) { const int kb = it / nnb, nb = it % nnb; xitem64<MAP>(src, ld, 64 * nb, 64 * kb, dst, K, 0, 64 * nb, scr, C.lane); }
}
template <int KT>
__device__ __forceinline__ void xsub64(const float* W, int ld, int sc0, int k0, LAS bf16_t* tile, int nt0, int k0t, int lane) {
    f32x4 v[16];
#pragma unroll
    for (int i = 0; i < 16; ++i) { const int kk = 4 * i + (lane >> 4); v[i] = *(const f32x4*)(W + (size_t)(k0 + kk) * ld + sc0 + 4 * (lane & 15)); }
#pragma unroll
    for (int i = 0; i < 16; ++i) { const int kt = k0t + 4 * i + (lane >> 4);
        const unsigned w01 = cvt_pk_bf16(v[i][0], v[i][1]), w23 = cvt_pk_bf16(v[i][2], v[i][3]);
#pragma unroll
        for (int j = 0; j < 4; ++j) { const int n = nt0 + 4 * (lane & 15) + j; const unsigned ww = (j < 2) ? w01 : w23;
            tile[n * KT + 8 * ((kt >> 3) ^ ((n >> 2) & 7)) + (kt & 7)] = (bf16_t)((j & 1) ? (ww >> 16) : (ww & 0xffffu)); } }
}
__device__ __forceinline__ void conv_experts(Ctx& C, const float* wg, const float* wu, const float* wd, int nexp, bf16_t* dgu, bf16_t* dd, int gw, int ngw, bool down_only = false) {
    (void)gw; (void)ngw;
    LAS bf16_t* tile = (LAS bf16_t*)C.lds;
    const int per_e = 8 + 4;
    const int w = C.wave, lane = C.lane;
    __syncthreads();
    for (int bi = C.bid; bi < nexp * per_e; bi += C.G) {
        const int e = bi / per_e, r = bi % per_e;
        if (r < 8 && down_only) continue;
        if (r < 8) {
            const int bj = r >> 2, kq = r & 3;
            const float* src = (bj ? wu : wg) + (size_t)e * DM * DEXP;
#pragma unroll 1
            for (int s2 = 0; s2 < 2; ++s2) { const int st = w + 8 * s2, nb = st >> 2, kb = st & 3;
                xsub64<256>(src, DEXP, 64 * nb, 256 * kq + 64 * kb, tile, 64 * nb, 64 * kb, lane); }
            __syncthreads();
            bf16_t* dst = dgu + (size_t)e * 512 * DM + 256 * kq;
#pragma unroll 8
            for (int i = 0; i < 16; ++i) { const int n = 32 * w + 2 * i + (lane >> 5), c8 = lane & 31;
                const u32x4 v = *(const LAS u32x4*)(tile + n * 256 + 8 * (c8 ^ ((n >> 2) & 7)));
                *(u32x4*)(dst + (size_t)(256 * (n >> 7) + 128 * bj + (n & 127)) * DM + 8 * c8) = v; }
            __syncthreads();
        } else {
            const int cg = r - 8;
            const float* src = wd + (size_t)e * DEXP * DM;
#pragma unroll 1
            for (int s2 = 0; s2 < 2; ++s2) { const int st = w + 8 * s2, nb = st >> 2, kb = st & 3;
                xsub64<256>(src, DM, 256 * cg + 64 * nb, 64 * kb, tile, 64 * nb, 64 * kb, lane); }
            __syncthreads();
            bf16_t* dst = dd + (size_t)e * DM * DEXP;
#pragma unroll 8
            for (int i = 0; i < 16; ++i) { const int n = 32 * w + 2 * i + (lane >> 5), c8 = lane & 31;
                const u32x4 v = *(const LAS u32x4*)(tile + n * 256 + 8 * (c8 ^ ((n >> 2) & 7)));
                *(u32x4*)(dst + (size_t)rowmap<MAP_IL8>(256 * cg + n) * DEXP + 8 * c8) = v; }
            __syncthreads();
        }
    }
}

struct CvAddr { const float* s; u32x4* d[4]; int ld; };
__device__ __forceinline__ void cv_addr(CvAddr& a, int t, int ngu, const float* wg, const float* wu, const float* wd, bf16_t* dgu, bf16_t* dd, int lane) {
    if (t < ngu) { const int e = t >> 8, bj = (t >> 7) & 1, k8 = t & 127;
        a.s = (bj ? wu : wg) + (size_t)e * DM * DEXP + (size_t)(8 * k8) * DEXP + lane; a.ld = DEXP;
        u32x4* db = (u32x4*)(dgu + (size_t)e * 512 * DM) + (k8 * 512 + 128 * bj + lane);
#pragma unroll
        for (int i = 0; i < 4; ++i) a.d[i] = db + 256 * (i >> 1) + 64 * (i & 1); }
    else { const int r = t - ngu, e = r >> 7, k8 = (r >> 2) & 31, cg = r & 3;
        a.s = wd + (size_t)e * DEXP * DM + (size_t)(8 * k8) * DM + 256 * cg + lane; a.ld = DM;
        u32x4* db = (u32x4*)(dd + (size_t)e * DM * DEXP) + k8 * 1024;
#pragma unroll
        for (int i = 0; i < 4; ++i) a.d[i] = db + rowmap<MAP_IL8>(256 * cg + 64 * i + lane); }
}
__device__ __forceinline__ void conv_experts_ch(Ctx& C, const float* wg, const float* wu, const float* wd, int nexp, bf16_t* dgu, bf16_t* dd, bool with_down) {
    int lane_ = (int)threadIdx.x; asm volatile("" : "+v"(lane_)); lane_ &= 63;
    const int gw = C.bid * NWAVES + __builtin_amdgcn_readfirstlane((int)threadIdx.x >> 6), ngw = C.G * NWAVES, lane = lane_;
    const int ngu = nexp * 256, ntask = ngu + (with_down ? nexp * 128 : 0);
#pragma unroll 1
    for (int t0 = gw; t0 < ntask; t0 += 2 * ngw) {
        const int t1 = t0 + ngw; const bool has1 = t1 < ntask;
        CvAddr a0, a1; cv_addr(a0, t0, ngu, wg, wu, wd, dgu, dd, lane); cv_addr(a1, has1 ? t1 : t0, ngu, wg, wu, wd, dgu, dd, lane);
        float v0[8][4], v1[8][4];
#pragma unroll
        for (int j = 0; j < 8; ++j)
#pragma unroll
            for (int i = 0; i < 4; ++i) v0[j][i] = a0.s[(size_t)j * a0.ld + 64 * i];
        if (has1) {
#pragma unroll
            for (int j = 0; j < 8; ++j)
#pragma unroll
                for (int i = 0; i < 4; ++i) v1[j][i] = a1.s[(size_t)j * a1.ld + 64 * i];
        } else {
#pragma unroll
            for (int j = 0; j < 8; ++j)
#pragma unroll
                for (int i = 0; i < 4; ++i) v1[j][i] = 0.f;
        }
#pragma unroll
        for (int i = 0; i < 4; ++i) { u32x4 o; o.x = cvt_pk_bf16(v0[0][i], v0[1][i]); o.y = cvt_pk_bf16(v0[2][i], v0[3][i]); o.z = cvt_pk_bf16(v0[4][i], v0[5][i]); o.w = cvt_pk_bf16(v0[6][i], v0[7][i]); *a0.d[i] = o; }
        if (has1) {
#pragma unroll
            for (int i = 0; i < 4; ++i) { u32x4 o; o.x = cvt_pk_bf16(v1[0][i], v1[1][i]); o.y = cvt_pk_bf16(v1[2][i], v1[3][i]); o.z = cvt_pk_bf16(v1[4][i], v1[5][i]); o.w = cvt_pk_bf16(v1[6][i], v1[7][i]); *a1.d[i] = o; }
        }
    }
}

__device__ __forceinline__ void ada_units(Ctx& C, KIn kin) {
    LAS float* cond = (LAS float*)C.lds;
    LAS float* part = cond + 4096;
    for (int i = C.tid; i < 4096; i += NTHREADS) cond[i] = siluf_(kin[I_C][i]);
    __syncthreads();
    float* ADA = (float*)(C.ws + WS_ADA); float* ADAKV = (float*)(C.ws + WS_ADAKV);
    for (int u = C.bid; u < 224; u += C.G) {
        const int col0 = 64 * u; const float* W; const float* bias; float* outp; int ld, ostride;
        if (col0 < 12288) { const int l = col0 / 6144, c = col0 % 6144; W = kin[I_WADA] + (size_t)l * DM * 6144 + c; ld = 6144; bias = kin[I_BADA] + l * 6144 + c; outp = ADA + (size_t)l * 4 * 6144 + c; ostride = 6144; }
        else { const int c = col0 - 12288; W = kin[I_WADAKV] + c; ld = 2048; bias = kin[I_BADAKV] + c; outp = ADAKV + c; ostride = 2048; }
        const int kq = C.tid >> 6, cl = C.tid & 63;
        float a0 = 0.f, a1 = 0.f, a2 = 0.f, a3 = 0.f;
#pragma unroll 16
        for (int k = 128 * kq; k < 128 * kq + 128; ++k) { const float w = W[(size_t)k * ld + cl]; a0 += cond[k] * w; a1 += cond[1024 + k] * w; a2 += cond[2048 + k] * w; a3 += cond[3072 + k] * w; }
        part[(kq * 4 + 0) * 64 + cl] = a0; part[(kq * 4 + 1) * 64 + cl] = a1; part[(kq * 4 + 2) * 64 + cl] = a2; part[(kq * 4 + 3) * 64 + cl] = a3;
        __syncthreads();
        if (C.tid < 256) { const int b = C.tid >> 6; float s = bias[cl];
#pragma unroll
            for (int q = 0; q < 8; ++q) s += part[(q * 4 + b) * 64 + cl];
            outp[(size_t)b * ostride + cl] = s; }
        __syncthreads();
    }
}
__device__ __forceinline__ void misc_tables(Ctx& C, KIn kin) {
    float* ROPE = (float*)(C.ws + WS_ROPE);
    for (int i = C.bid * NTHREADS + C.tid; i < NTOK * 8; i += C.G * NTHREADS) { const int t = i >> 3, f = i & 7;
        const float invf = exp2f(-(float)f * (18.931568569324174f / 8.0f));
        const float ang = (float)C.pos[t] * invf; ROPE[(size_t)t * 16 + f] = cosf(ang); ROPE[(size_t)t * 16 + 8 + f] = sinf(ang); }
    if (C.bid == 0 && C.wave == 0) {
        float* MF = (float*)(C.ws + WS_MF);
        const int d = C.lane;
        float qa = fabsf(kin[I_QNA][d]), ka = fabsf(kin[I_KNA][d]), qb = fabsf(kin[I_QNB][d]), k0 = fabsf(kin[I_KNB][d]), k1 = fabsf(kin[I_KNB][64 + d]), k2 = fabsf(kin[I_KNB][128 + d]);
#pragma unroll
        for (int o = 1; o < 64; o <<= 1) { qa = fmaxf(qa, __shfl_xor(qa, o)); ka = fmaxf(ka, __shfl_xor(ka, o)); qb = fmaxf(qb, __shfl_xor(qb, o)); k0 = fmaxf(k0, __shfl_xor(k0, o)); k1 = fmaxf(k1, __shfl_xor(k1, o)); k2 = fmaxf(k2, __shfl_xor(k2, o)); }
        const float f = 8.f * LOG2E * 1.002f;
        if (d == 0) { MF[0] = f * qa * ka; MF[1] = f * qb * k0; MF[2] = f * qb * k1; MF[3] = f * qb * k2; }
    }
}

__device__ __forceinline__ void split8(const f32x4 a, const f32x4 b, u32x4& hi, u32x4& lo) {
    hi.x = cvt_pk_bf16(a[0], a[1]); hi.y = cvt_pk_bf16(a[2], a[3]); hi.z = cvt_pk_bf16(b[0], b[1]); hi.w = cvt_pk_bf16(b[2], b[3]);
    lo.x = cvt_pk_bf16(a[0] - __builtin_bit_cast(float, hi.x << 16), a[1] - __builtin_bit_cast(float, hi.x & 0xffff0000u));
    lo.y = cvt_pk_bf16(a[2] - __builtin_bit_cast(float, hi.y << 16), a[3] - __builtin_bit_cast(float, hi.y & 0xffff0000u));
    lo.z = cvt_pk_bf16(b[0] - __builtin_bit_cast(float, hi.z << 16), b[1] - __builtin_bit_cast(float, hi.z & 0xffff0000u));
    lo.w = cvt_pk_bf16(b[2] - __builtin_bit_cast(float, hi.w << 16), b[3] - __builtin_bit_cast(float, hi.w & 0xffff0000u));
}
struct NormVar { const float* gain; const float* shift; const float* scale; bf16_t* out; };
template <int NV, int NW  , class EpiS>
__device__ __forceinline__ void norm_tile(Ctx& C, int tok0, const float* h, const NormVar (&V)[NV], int skv, const float* W, int ldw, int c0, int ncols, const EpiS& ES) {
    LAS float* GV = (LAS float*)C.lds;
    LAS float* SV = GV + 1024;
    LAS float* RS = SV + 1024;
    LAS float* WL = RS + 128;
    int lane_ = C.lane; asm volatile("" : "+v"(lane_));
    const int lane = lane_, wid = C.wave;
    {
        f32x4 G[NV][4], S[NV][4];
#pragma unroll
        for (int v = 0; v < NV; ++v)
#pragma unroll
            for (int j = 0; j < 4; ++j) { const int k = (64 * j + lane) * 4; const f32x4 gn = *(const f32x4*)(V[v].gain + k), sc = *(const f32x4*)(V[v].scale + k); G[v][j] = gn * (sc + 1.f); S[v][j] = *(const f32x4*)(V[v].shift + k);
                if (v == skv && wid == 0) { *(LAS f32x4*)(GV + k) = G[v][j]; *(LAS f32x4*)(SV + k) = S[v][j]; } }
#pragma unroll 4
        for (int i = 0; i < 16; ++i) {
            const int row = tok0 + 16 * wid + i;
            const f32x4* xr = (const f32x4*)(h + (size_t)row * DM) + lane;
            f32x4 x[4]; float ss = 0.f;
#pragma unroll
            for (int j = 0; j < 4; ++j) { x[j] = xr[64 * j]; ss += (x[j][0] * x[j][0] + x[j][1] * x[j][1]) + (x[j][2] * x[j][2] + x[j][3] * x[j][3]); }
            const float rstd = rsqrtf(wave_sum(ss) * (1.f / DM) + EPSN);
            if (lane == 0) RS[16 * wid + i] = rstd;
#pragma unroll
            for (int v = 0; v < NV; ++v) { u32x2* o8 = (u32x2*)(V[v].out + (size_t)row * DM) + lane;
#pragma unroll
                for (int j = 0; j < 4; ++j) { const f32x4 uu = x[j] * rstd * G[v][j] + S[v][j]; u32x2 w; w.x = cvt_pk_bf16(uu[0], uu[1]); w.y = cvt_pk_bf16(uu[2], uu[3]); o8[64 * j] = w; } }
        }
    }
    __syncthreads();
    f32x16 acc0 = (f32x16){}, acc1 = (f32x16){};
    const int tl = 32 * wid + (lane & 31), half = lane >> 5;
    const float rstd = (wid < 4) ? RS[tl] : 0.f;
    const float* hrow = h + (size_t)(tok0 + (wid < 4 ? tl : 0)) * DM;
    LAS unsigned char* WHI = (LAS unsigned char*)WL; LAS unsigned char* WLO = WHI + 32 * NW * 16;
#pragma unroll 1
    for (int kc = 0; kc < 4; ++kc) {
        {
            constexpr int NP = 32 * NW / NTHREADS;
            float wv[NP][8];
#pragma unroll
            for (int q = 0; q < NP; ++q) { const int p = C.tid + q * NTHREADS, n = p % NW, kg = p / NW;
#pragma unroll
                for (int i = 0; i < 8; ++i) wv[q][i] = (n < ncols) ? W[(size_t)(kc * 256 + 8 * kg + i) * ldw + c0 + n] : 0.f; }
#pragma unroll
            for (int q = 0; q < NP; ++q) { const int p = C.tid + q * NTHREADS;
                u32x4 hw, lw; split8((f32x4){wv[q][0], wv[q][1], wv[q][2], wv[q][3]}, (f32x4){wv[q][4], wv[q][5], wv[q][6], wv[q][7]}, hw, lw);
                *(LAS u32x4*)(WHI + p * 16) = hw; *(LAS u32x4*)(WLO + p * 16) = lw; }
        }
        __syncthreads();
        if (wid < 4) {
#pragma unroll 1
            for (int ks4 = 0; ks4 < 16; ks4 += 4) {
                f32x4 hv[4][2];
#pragma unroll
                for (int jj = 0; jj < 4; ++jj) { const float* hp = hrow + kc * 256 + 16 * (ks4 + jj) + 8 * half; hv[jj][0] = *(const f32x4*)hp; hv[jj][1] = *(const f32x4*)(hp + 4); }
#pragma unroll
                for (int jj = 0; jj < 4; ++jj) {
                    const int ks = ks4 + jj, k = kc * 256 + 16 * ks + 8 * half;
                    const f32x4 u0 = hv[jj][0] * rstd * *(const LAS f32x4*)(GV + k) + *(const LAS f32x4*)(SV + k), u1 = hv[jj][1] * rstd * *(const LAS f32x4*)(GV + k + 4) + *(const LAS f32x4*)(SV + k + 4);
                    u32x4 hw, lw; split8(u0, u1, hw, lw);
                    const bf16x8 bhi = __builtin_bit_cast(bf16x8, hw), blo = __builtin_bit_cast(bf16x8, lw);
                    const int fo = ((2 * ks + half) * NW + (lane & 31)) * 16;
                    const bf16x8 ah0 = *(const LAS bf16x8*)(WHI + fo), al0 = *(const LAS bf16x8*)(WLO + fo);
                    acc0 = __builtin_amdgcn_mfma_f32_32x32x16_bf16(ah0, bhi, acc0, 0, 0, 0); acc0 = __builtin_amdgcn_mfma_f32_32x32x16_bf16(ah0, blo, acc0, 0, 0, 0); acc0 = __builtin_amdgcn_mfma_f32_32x32x16_bf16(al0, bhi, acc0, 0, 0, 0);
                    if (NW == 64) { const bf16x8 ah1 = *(const LAS bf16x8*)(WHI + fo + 512), al1 = *(const LAS bf16x8*)(WLO + fo + 512);
                        acc1 = __builtin_amdgcn_mfma_f32_32x32x16_bf16(ah1, bhi, acc1, 0, 0, 0); acc1 = __builtin_amdgcn_mfma_f32_32x32x16_bf16(ah1, blo, acc1, 0, 0, 0); acc1 = __builtin_amdgcn_mfma_f32_32x32x16_bf16(al1, bhi, acc1, 0, 0, 0); }
                }
            }
        }
        __syncthreads();
    }
    ES(C, tok0, acc0, acc1);
}

struct EpiForget { float* logf; const float* bf;
    __device__ __forceinline__ void operator()(Ctx& C, int tok0, const f32x16& a0, const f32x16&) const {
        if (C.wave >= 4) return;
        const int t = tok0 + 32 * C.wave + (C.lane & 31), hi = C.lane >> 5;
#pragma unroll
        for (int r = 0; r < 16; ++r) { const int n = crow(r, hi); if (n < 16) { const float x = a0[r] + bf[n]; logf[(size_t)n * NTOK + t] = fminf(x, 0.f) - log1pf(__expf(-fabsf(x))); } }
    } };
struct EpiGates { float* gates; const float* bg;
    __device__ __forceinline__ void operator()(Ctx& C, int tok0, const f32x16& a0, const f32x16& a1) const {
        if (C.wave >= 4) return;
        const int t = tok0 + 32 * C.wave + (C.lane & 31), hi = C.lane >> 5;
#pragma unroll
        for (int r = 0; r < 16; ++r) { const int n = crow(r, hi); gates[(size_t)t * 48 + n] = sigmoidf_(a0[r] + bg[n]); if (n + 32 < 48) gates[(size_t)t * 48 + n + 32] = sigmoidf_(a1[r] + bg[n + 32]); }
    } };
struct EpiRoute { const float* brout; unsigned* cnt; int* toke; int* tokp; int* rowtok; float* roww;
    __device__ __forceinline__ void operator()(Ctx& C, int tok0, const f32x16& a0, const f32x16& a1) const {
        LAS int* hist = (LAS int*)(C.lds + 100000); LAS int* base = hist + 64;
        const int lane = C.lane, hi = lane >> 5, t = tok0 + 32 * C.wave + (lane & 31);
        const int ch = tok0 / CHTOK;
        if (C.tid < 64) hist[C.tid] = 0;
        int te[8]; float tw[8]; int rk[8];
        if (C.wave < 4) {
            float sc[32]; unsigned key[32];
#pragma unroll
            for (int r = 0; r < 16; ++r) { const int e = crow(r, hi);
                sc[r] = sigmoidf_(a0[r]); sc[16 + r] = sigmoidf_(a1[r]);
                const float v0 = sc[r] + brout[e], v1 = sc[16 + r] + brout[e + 32];
                const unsigned u0 = __float_as_uint(v0), u1 = __float_as_uint(v1);
                key[r] = (u0 & 0x80000000u) ? ~u0 : (u0 | 0x80000000u); key[16 + r] = (u1 & 0x80000000u) ? ~u1 : (u1 | 0x80000000u); }
            float ssum = 0.f;
#pragma unroll
            for (int k = 0; k < 8; ++k) {
                unsigned mx = 0u;
#pragma unroll
                for (int i = 0; i < 32; ++i) mx = mx > key[i] ? mx : key[i];
                { const unsigned o = (unsigned)__shfl_xor((int)mx, 32); mx = mx > o ? mx : o; }
                int idx = 64;
#pragma unroll
                for (int i = 0; i < 32; ++i) { const int e = crow(i & 15, hi) + 32 * (i >> 4); idx = (key[i] == mx && e < idx) ? e : idx; }
                { const int o = __shfl_xor(idx, 32); idx = o < idx ? o : idx; }
                float sk = -1.f;
#pragma unroll
                for (int i = 0; i < 32; ++i) { const int e = crow(i & 15, hi) + 32 * (i >> 4); const bool hit = (e == idx); sk = hit ? sc[i] : sk; key[i] = hit ? 0u : key[i]; }
                { const float o = __shfl_xor(sk, 32); sk = fmaxf(sk, o); }
                te[k] = idx; tw[k] = sk; ssum += sk;
            }
            const float inv = 2.5f / ssum;
#pragma unroll
            for (int k = 0; k < 8; ++k) tw[k] *= inv;
        }
        __syncthreads();
        if (C.wave < 4 && hi == 0) {
#pragma unroll
            for (int k = 0; k < 8; ++k) rk[k] = atomicAdd((int*)(hist + te[k]), 1);
        }
        __syncthreads();
        if (C.tid < 64) base[C.tid] = (int)atomicAdd(cnt + ch * 64 + C.tid, (unsigned)hist[C.tid]);
        __syncthreads();
        if (C.wave < 4 && hi == 0) {
            i32x4 e0, e1, p0, p1;
#pragma unroll
            for (int k = 0; k < 8; ++k) { const int e = te[k], p = base[e] + rk[k];
                if (k < 4) { e0[k] = e; p0[k] = p; } else { e1[k - 4] = e; p1[k - 4] = p; }
                rowtok[((size_t)ch * 64 + e) * CHTOK + p] = t; roww[((size_t)ch * 64 + e) * CHTOK + p] = tw[k]; }
            *(i32x4*)(toke + (size_t)t * 8) = e0; *(i32x4*)(toke + (size_t)t * 8 + 4) = e1; *(i32x4*)(tokp + (size_t)t * 8) = p0; *(i32x4*)(tokp + (size_t)t * 8 + 4) = p1;
        }
        __syncthreads();
    } };

__device__ __forceinline__ pg8::MoeTab moe_tables(Ctx& C, const unsigned* cnt_g, const LAS int** pstart_out, bool with_shared = false) {
    LAS int* cnt = (LAS int*)(C.lds + MISC_OFF + 1024); LAS int* tstart = cnt + 68; LAS int* pstart = tstart + 68; LAS unsigned char* tile_e = (LAS unsigned char*)(pstart + 68);
    const int ne = with_shared ? NEXP + 1 : NEXP;
    __syncthreads();
    if (C.tid < 64) cnt[C.tid] = (int)__hip_atomic_load(cnt_g + C.tid, __ATOMIC_RELAXED, __HIP_MEMORY_SCOPE_AGENT);
    if (C.tid == 64) cnt[64] = with_shared ? CHTOK : 0;
    __syncthreads();
    if (C.tid < 64) {
        const int e = C.tid; const int nt = (cnt[e] + 255) >> 8;
        int inc = nt;
#pragma unroll
        for (int o = 1; o < 64; o <<= 1) { const int v = __shfl_up(inc, o); if (C.lane >= o) inc += v; }
        if (e == 63) tstart[67] = inc;
        asm volatile("s_waitcnt lgkmcnt(0)" ::: "memory");
        if (e < 64) { tstart[e] = inc - nt; pstart[e] = (inc - nt) * 256; if (e == 63 && ne == 64) { tstart[64] = inc; pstart[64] = inc * 256; } }
    }
    __syncthreads();
    if (ne > 64 && C.tid == 0) { const int base = tstart[67], n64 = (cnt[64] + 255) >> 8; tstart[64] = base; pstart[64] = base * 256; tstart[65] = base + n64; pstart[65] = (base + n64) * 256; }
    __syncthreads();
    if (C.tid < ne) { for (int m = tstart[C.tid]; m < tstart[C.tid + 1]; ++m) tile_e[m] = (unsigned char)C.tid; }
    __syncthreads();
    pg8::MoeTab T; T.tstart = tstart; T.cnt = cnt; T.tile_e = tile_e; T.ntiles = tstart[ne];
    *pstart_out = pstart;
    return T;
}

__device__ __forceinline__ void cumsum_unit(Ctx& C, int bh) {
    const float* LOGF = (const float*)(C.ws + WS_LOGF); float* CUM = (float*)(C.ws + WS_CUM);
    LAS float* wt = (LAS float*)(C.lds + MISC_OFF + 3072);
    const int b = bh >> 4, hh = bh & 15;
    float v[16]; float run = 0.f;
#pragma unroll
    for (int i = 0; i < 16; ++i) { run += LOGF[(size_t)hh * NTOK + (size_t)b * SEQ + 16 * C.tid + i]; v[i] = run; }
    float inc = run;
#pragma unroll
    for (int o = 1; o < 64; o <<= 1) { const float n = __shfl_up(inc, o); if (C.lane >= o) inc += n; }
    if (C.lane == 63) wt[C.wave] = inc;
    __syncthreads();
    float pre = inc - run;
    for (int w = 0; w < C.wave; ++w) pre += wt[w];
#pragma unroll
    for (int i = 0; i < 16; ++i) CUM[(size_t)bh * SEQ + 16 * C.tid + i] = (pre + v[i]) * LOG2E;
    __syncthreads();
}

__device__ __forceinline__ void compress2(Ctx& C, KIn kin) {
    LAS float* w2l = (LAS float*)C.lds;
    LAS float* hl = (LAS float*)(C.lds + 65536) + C.wave * 256;
    const float* SLAB = (const float*)(C.ws + WS_SLAB);
    const int gw = C.bid * NWAVES + C.wave, ngw = C.G * NWAVES;
#pragma unroll 1
    for (int kind = 0; kind < 2; ++kind) {
        const float* w2 = kin[kind == 0 ? I_WCK2 : I_WCV2];
        __syncthreads();
        { f32x4 wv[8];
#pragma unroll
          for (int q = 0; q < 8; ++q) wv[q] = *(const f32x4*)(w2 + 4 * (C.tid + q * NTHREADS));
#pragma unroll
          for (int q = 0; q < 8; ++q) *(LAS f32x4*)(w2l + 4 * (C.tid + q * NTHREADS)) = wv[q]; }
        __syncthreads();
        bf16_t* dst = (bf16_t*)(C.ws + (kind == 0 ? WS_KCMP : WS_VCMP));
        for (int row = gw; row < 2048; row += ngw) {
            const float* sl = SLAB + (size_t)kind * 8 * 2048 * 256 + (size_t)row * 256;
            float sv[4][8];
#pragma unroll
            for (int i = 0; i < 4; ++i)
#pragma unroll
                for (int ks = 0; ks < 8; ++ks) sv[i][ks] = sl[(size_t)ks * 2048 * 256 + C.lane + 64 * i];
#pragma unroll
            for (int i = 0; i < 4; ++i) { float s = 0.f;
#pragma unroll
                for (int ks = 0; ks < 8; ++ks) s += sv[i][ks];
                hl[C.lane + 64 * i] = siluf_(s); }
            LDS_WAIT();
            float a0 = 0.f, a1 = 0.f, a2 = 0.f, a3 = 0.f;
#pragma unroll 8
            for (int j = 0; j < 256; j += 4) { const f32x4 hv = *(const LAS f32x4*)(hl + j);
                a0 += hv[0] * w2l[j * 64 + C.lane]; a1 += hv[1] * w2l[(j + 1) * 64 + C.lane]; a2 += hv[2] * w2l[(j + 2) * 64 + C.lane]; a3 += hv[3] * w2l[(j + 3) * 64 + C.lane]; }
            const float acc = (a0 + a1) + (a2 + a3);
            float o = acc;
            if (kind == 0) { const float ss = wave_sum(acc * acc); o = acc * rsqrtf(ss * (1.f / 64.f) + EPSN) * kin[I_KNB][C.lane]; }
            dst[(size_t)row * 64 + C.lane] = (bf16_t)f2bf(o);
            LDS_WAIT();
        }
    }
    __syncthreads();
}
#define XB_TMO      128
#define XB_XCNT(j)  (256  + 64 * (j))
#define XB_XSUB(j)  (1280 + 64 * (j))
#define XB_XGEN(j)  (2304 + 64 * (j))
#define XB_TOP      3328
#define XB_TOPGEN   3392
#define XCD_BAR_WORDS 3456
#define XB_SPIN_CAP (1u << 22)
__device__ __forceinline__ unsigned xb_ld(unsigned* p)              { return __hip_atomic_load(p, __ATOMIC_RELAXED, __HIP_MEMORY_SCOPE_AGENT); }
__device__ __forceinline__ unsigned xb_add(unsigned* p, unsigned v) { return __hip_atomic_fetch_add(p, v, __ATOMIC_RELAXED, __HIP_MEMORY_SCOPE_AGENT); }
__device__ __forceinline__ unsigned xb_xcc_id() { return (unsigned)__builtin_amdgcn_s_getreg((3 << 11) | 20) & 0xFu; }
#define XB_SPIN(cond, bar) do { unsigned _sp = 0; while (cond) { __builtin_amdgcn_s_sleep(1); \
    if ((++_sp & 255u) == 0u) { if (xb_ld(&(bar)[XB_TMO])) break; if (_sp > XB_SPIN_CAP) { atomicAdd(&(bar)[XB_TMO], 1u); break; } } } } while (0)
struct XcdBarrier { unsigned* bar; unsigned x; volatile LAS unsigned* st; };
__device__ __forceinline__ XcdBarrier xcd_barrier_post(unsigned* bar, volatile LAS unsigned* st) {
    XcdBarrier b; b.bar = bar; b.x = xb_xcc_id(); b.st = st;
    if (threadIdx.x == 0) (void)xb_add(&bar[XB_XCNT(b.x)], 1u);
    return b;
}
__device__ __forceinline__ void xcd_barrier_complete(unsigned* bar, unsigned x, unsigned& nloc, unsigned& nx) {
    const unsigned G = gridDim.x * gridDim.y * gridDim.z;
    unsigned sum, cnt, mine, sp = 0u;
    for (;;) {
        sum = 0u; cnt = 0u; mine = 0u;
#pragma unroll
        for (unsigned j = 0; j < 16; ++j) { const unsigned c = xb_ld(&bar[XB_XCNT(j)]); sum += c; cnt += (c > 0u) ? 1u : 0u; mine = (j == x) ? c : mine; }
        if (sum == G) break;
        __builtin_amdgcn_s_sleep(1);
        if ((++sp & 255u) == 0u) { if (xb_ld(&bar[XB_TMO])) break; if (sp > XB_SPIN_CAP) { atomicAdd(&bar[XB_TMO], 1u); break; } }
    }
    nloc = mine > 0u ? mine : 1u; nx = cnt > 0u ? cnt : 1u;
}
__device__ __forceinline__ void xcd_barrier(const XcdBarrier& b) {
    asm volatile("s_waitcnt vmcnt(0)" ::: "memory");
    __syncthreads();
    if (threadIdx.x == 0) {
        unsigned* bar = b.bar;
        __builtin_amdgcn_s_waitcnt(0);
        unsigned nloc = b.st[0], nx = b.st[1];
        if (nloc == 0u) { xcd_barrier_complete(bar, b.x, nloc, nx); b.st[0] = nloc; b.st[1] = nx; }
        const unsigned old = xb_add(&bar[XB_XSUB(b.x)], 1u);
        const unsigned gen = old / nloc;
        if (old + 1u == (gen + 1u) * nloc) {
            __builtin_amdgcn_fence(__ATOMIC_RELEASE, "agent");
            asm volatile("s_waitcnt vmcnt(0)" ::: "memory");
            const unsigned og = xb_add(&bar[XB_TOP], 1u);
            const unsigned tg = og / nx;
            if (og + 1u == (tg + 1u) * nx) xb_add(&bar[XB_TOPGEN], 1u);
            else XB_SPIN(xb_ld(&bar[XB_TOPGEN]) == tg, bar);
            __builtin_amdgcn_fence(__ATOMIC_ACQUIRE, "agent");
            xb_add(&bar[XB_XGEN(b.x)], 1u);
            asm volatile("s_waitcnt vmcnt(0)" ::: "memory");
        } else {
            XB_SPIN(xb_ld(&bar[XB_XGEN(b.x)]) == gen, bar);
            __builtin_amdgcn_fence(__ATOMIC_ACQUIRE, "agent");
            asm volatile("s_waitcnt vmcnt(0)" ::: "memory");
        }
    }
    __syncthreads();
}

#ifndef MK_ONE_LAUNCH
#define MK_ONE_LAUNCH 1
#endif
constexpr int N_PHASES = 25;

__global__ void __launch_bounds__(NTHREADS, 2) fwd_kernel(Args args) {
    extern __shared__ __attribute__((aligned(16))) unsigned char lds_raw[];
    { volatile LAS unsigned* MISC0 = (volatile LAS unsigned*)((LAS unsigned char*)lds_raw + MISC_OFF); if (threadIdx.x < 16) MISC0[threadIdx.x] = 0u; }
    __syncthreads();
#if MK_ONE_LAUNCH
    XcdBarrier bar = xcd_barrier_post((unsigned*)(args.ws + WS_CTL) + CW_BAR, (volatile LAS unsigned*)((LAS unsigned char*)lds_raw + MISC_OFF) + 8);
#define GRID_BAR() xcd_barrier(bar)
#else
#define GRID_BAR() do {} while (0)
#endif
#if MK_ONE_LAUNCH
    constexpr int lo = 0, hi = N_PHASES;
#else
    const int lo = args.ph_lo, hi = args.ph_hi;
#endif
#ifndef PHMASK
#define PHMASK 0x1ffffffu
#endif
#define INR(k) (lo <= (k) && (k) < hi)
#define PHB(b) ((PHMASK >> (b)) & 1u)
#define IN(k) (PHB(k) && INR(k))
#define SEAM(k) do { if (INR(k) && INR((k) + 1)) GRID_BAR(); } while (0)
#ifndef REPMASK
#define REPMASK 0u
#endif
#define NREP(b) (((REPMASK >> (b)) & 1u) ? 2 : 1)
#define PH_BEGIN \
    unsigned zo_; asm volatile("s_mov_b32 %0, 0" : "=s"(zo_)); \
    const AS4 char* kb_ = (const AS4 char*)__builtin_amdgcn_kernarg_segment_ptr() + zo_; \
    KIn kin = (KIn)kb_; \
    Ctx C; C.out = *(float* const AS4*)(kb_ + 8 * N_IN); C.ws = *(unsigned char* const AS4*)(kb_ + 8 * N_IN + 8); C.pos = (const int*)kin[I_POS]; \
    C.lds = (LAS unsigned char*)lds_raw; C.ctl = (unsigned*)(C.ws + WS_CTL); \
    { int t_ = threadIdx.x; asm volatile("" : "+v"(t_)); C.tid = t_; } C.lane = C.tid & 63; C.wave = __builtin_amdgcn_readfirstlane(C.tid >> 6); C.G = gridDim.x; C.bid = blockIdx.x; \
    const int vcu = (C.G % 8 == 0) ? (C.bid % 8) * (C.G / 8) + C.bid / 8 : C.bid; (void)vcu; \
    const float* ADA0 = (const float*)(C.ws + WS_ADA); (void)ADA0; const float* ADAKV = (const float*)(C.ws + WS_ADAKV); (void)ADAKV; const float* MF = (const float*)(C.ws + WS_MF); (void)MF; \
    bf16_t* U = (bf16_t*)(C.ws + WS_U); (void)U;

    for (int rp_ = 0; rp_ < NREP(0); ++rp_) if (IN(0)) { PH_BEGIN
        ada_units(C, kin);
        misc_tables(C, kin);
        const int gw = C.bid * NWAVES + C.wave, ngw = C.G * NWAVES;
        {
            LAS float* scr = (LAS float*)(C.lds + C.wave * 16384);
            constexpr int N0 = 16 * 48, N1 = N0 + 256, N2 = N1 + 16 * 24, N3 = N2 + 256, N4 = N3 + 256, N5 = N4 + 64 * 4, N6 = N5 + 64 * 4;
            for (int it = gw; it < N6; it += ngw) {
                if (it < N0)      { const int r = it,      kb = r / 48, nb = r % 48; xitem64<MAP_HPERM>(kin[I_WINA], 3088, 64 * nb, 64 * kb, (bf16_t*)(C.ws + WS_WQKV), DM, 0, 64 * nb, scr, C.lane); }
                else if (it < N1) { const int r = it - N0, kb = r / 16, nb = r % 16; xitem64<MAP_ID>(kin[I_WOA], DM, 64 * nb, 64 * kb, (bf16_t*)(C.ws + WS_WOA), DM, 0, 64 * nb, scr, C.lane); }
                else if (it < N2) { const int r = it - N1, kb = r / 24, nb = r % 24; xitem64<MAP_HPERM>(kin[I_WKVB], 1536, 64 * nb, 64 * kb, (bf16_t*)(C.ws + WS_WKV), DM, 0, 64 * nb, scr, C.lane); }
                else if (it < N3) { const int r = it - N2, kb = r / 16, nb = r % 16; xitem64<MAP_HPERM>(kin[I_WINB], 1072, 64 * nb, 64 * kb, (bf16_t*)(C.ws + WS_WQB), DM, 0, 64 * nb, scr, C.lane); }
                else if (it < N4) { const int r = it - N3, kb = r / 16, nb = r % 16; xitem64<MAP_ID>(kin[I_WOB], DM, 64 * nb, 64 * kb, (bf16_t*)(C.ws + WS_WOB), DM, 0, 64 * nb, scr, C.lane); }
                else if (it < N5) { const int r = it - N4, kb = r / 4,  nb = r % 4;  xitem64<MAP_ID>(kin[I_WCK1], 256, 64 * nb, 64 * kb, (bf16_t*)(C.ws + WS_WC1K), 4096, 0, 64 * nb, scr, C.lane); }
                else              { const int r = it - N5, kb = r / 4,  nb = r % 4;  xitem64<MAP_ID>(kin[I_WCV1], 256, 64 * nb, 64 * kb, (bf16_t*)(C.ws + WS_WC1V), 4096, 0, 64 * nb, scr, C.lane); }
            }
        }
        conv_experts_ch(C, kin[I_WSG], kin[I_WSU], kin[I_WSD], 2, (bf16_t*)(C.ws + WS_WSGU), (bf16_t*)(C.ws + WS_WSD), false);
        conv_experts(C, kin[I_WSG], kin[I_WSU], kin[I_WSD], 2, (bf16_t*)(C.ws + WS_WSGU), (bf16_t*)(C.ws + WS_WSD), gw, ngw, true);
        __syncthreads();
    }
#pragma unroll 1
    for (int layer = 0; layer < 2; ++layer) {
#define CONV_LAYER_EXPERTS() conv_experts_ch(C, kin[I_WEG] + (size_t)layer * NEXP * DM * DEXP, kin[I_WEU] + (size_t)layer * NEXP * DM * DEXP, kin[I_WED] + (size_t)layer * NEXP * DEXP * DM, NEXP, (bf16_t*)(C.ws + WS_WEGU), (bf16_t*)(C.ws + WS_WED), true)
        if (layer == 0) {
            SEAM(0);
            for (int rp_ = 0; rp_ < NREP(1); ++rp_) if (IN(1)) { PH_BEGIN const float* ADA = ADA0 + (size_t)layer * 4 * 6144; (void)ADA;
                for (int tile = C.bid; tile < NTOK / 128; tile += C.G) {
                    const int tok0 = tile * 128, b = tok0 / SEQ;
                    const NormVar V[1] = {{kin[I_NMIX], ADA + (size_t)b * 6144, ADA + (size_t)b * 6144 + 1024, U}};
                    EpiForget ES{(float*)(C.ws + WS_LOGF), kin[I_BFA]};
                    norm_tile<1, 32>(C, tok0, kin[I_X], V, 0, kin[I_WINA], 3088, 3072, 16, ES);
                    __syncthreads();
                }
            }
            SEAM(1);
            for (int rp_ = 0; rp_ < NREP(2); ++rp_) if (IN(2)) { PH_BEGIN const float* ADA = ADA0 + (size_t)layer * 4 * 6144; (void)ADA;
                { pg8::Gemm g{U, DM, DM, DM};
                  pg8::DenseSched S; S.init((const bf16_t*)(C.ws + WS_WQKV), DM, DM, NTOK, 3072, C.G, C.bid);
                  pg8::EpiQKV E{(bf16_t*)(C.ws + WS_Q), (size_t)(WS_K - WS_Q) / 2, kin[I_QNA], kin[I_KNA]};
                  pg8::gemm_phase(C.lds, g, S, E); }
                for (int bh = C.bid; bh < NB * NH; bh += C.G) cumsum_unit(C, bh);
            }
            SEAM(2);
            for (int rp_ = 0; rp_ < NREP(3); ++rp_) if (IN(3)) { PH_BEGIN const float* ADA = ADA0 + (size_t)layer * 4 * 6144; (void)ADA;
                const float M2 = MF[0];
                const int cslot = (C.G == 256) ? ((C.bid >> 3) & 7) : 0;
                for (int i = 0;; ++i) {
                    int bh, qb;
                    if (C.G == 256) { if (i >= 8) break; bh = vcu >> 2; const int c4 = vcu & 3, k = i >> 1; qb = (i & 1) ? (8 * k + 7 - c4) : (8 * k + c4); }
                    else { const int u = i * C.G + C.bid; if (u >= NB * NH * 32) break; bh = u >> 5; qb = u & 31; }
                    if (i == cslot) CONV_LAYER_EXPERTS();
                    att::fox_unit((LAS char*)C.lds, bh >> 4, bh & 15, qb, (const bf16_t*)(C.ws + WS_Q), (const bf16_t*)(C.ws + WS_K), (const bf16_t*)(C.ws + WS_V), (bf16_t*)(C.ws + WS_O), (const float*)(C.ws + WS_CUM), M2);
                }
            }
            SEAM(3);
            for (int rp_ = 0; rp_ < NREP(4); ++rp_) if (IN(4)) { PH_BEGIN const float* ADA = ADA0 + (size_t)layer * 4 * 6144; (void)ADA;
                pg8::Gemm g{(const bf16_t*)(C.ws + WS_O), DM, DM, DM};
                pg8::DenseSched S; S.init((const bf16_t*)(C.ws + WS_WOA), DM, DM, NTOK, DM, C.G, C.bid);
                pg8::EpiResid E{kin[I_X], C.out, ADA + 2048};
                pg8::gemm_phase(C.lds, g, S, E);
            }
            SEAM(4);
        } else {
            if (IN(12)) { PH_BEGIN const float* ADA = ADA0 + (size_t)layer * 4 * 6144; (void)ADA;
                for (int tile = C.bid; tile < NTOK / 128; tile += C.G) {
                    const int tok0 = tile * 128, b = tok0 / SEQ;
                    const NormVar V[2] = {{kin[I_NKV], ADAKV + (size_t)b * 2048, ADAKV + (size_t)b * 2048 + 1024, (bf16_t*)(C.ws + WS_SKV)},
                                          {kin[I_NMIX] + DM, ADA + (size_t)b * 6144, ADA + (size_t)b * 6144 + 1024, U}};
                    EpiGates ES{(float*)(C.ws + WS_GATES), kin[I_BGB]};
                    norm_tile<2, 64>(C, tok0, C.out, V, 1, kin[I_WINB], 1072, 1024, 48, ES);
                    __syncthreads();
                }
            }
            SEAM(12);
            for (int rp_ = 0; rp_ < NREP(13); ++rp_) if (IN(13)) { PH_BEGIN const float* ADA = ADA0 + (size_t)layer * 4 * 6144; (void)ADA;
                pg8::Gemm g{(const bf16_t*)(C.ws + WS_SKV), DM, DM, DM};
                pg8::DenseSched S; S.init((const bf16_t*)(C.ws + WS_WKV), DM, DM, NTOK, 1536, C.G, C.bid);
                pg8::EpiKV E{(bf16_t*)(C.ws + WS_ACK), (bf16_t*)(C.ws + WS_KSEL), (size_t)(WS_ACV - WS_ACK) / 2, (size_t)(WS_VSEL - WS_KSEL) / 2,
                              kin[I_PEK], kin[I_PEV], kin[I_KNB], (const float*)(C.ws + WS_ROPE), C.lds};
                pg8::gemm_phase(C.lds, g, S, E);
            }
            SEAM(13);
            for (int rp_ = 0; rp_ < NREP(14); ++rp_) if (IN(14)) { PH_BEGIN const float* ADA = ADA0 + (size_t)layer * 4 * 6144; (void)ADA;
                { pg8::Gemm g{U, DM, DM, DM};
                  pg8::DenseSched S; S.init((const bf16_t*)(C.ws + WS_WQB), DM, DM, NTOK, DM, C.G, C.bid);
                  pg8::EpiQB E{(bf16_t*)(C.ws + WS_QP), (bf16_t*)(C.ws + WS_QR), kin[I_QNB], (const float*)(C.ws + WS_ROPE)};
                  pg8::gemm_phase(C.lds, g, S, E); }
#pragma unroll 1
                for (int kind = 0; kind < 2; ++kind) {
                    pg8::Gemm g{(const bf16_t*)(C.ws + (kind == 0 ? WS_ACK : WS_ACV)), 4096, 4096, 512};
                    pg8::SplitKSched S; S.init((const bf16_t*)(C.ws + (kind == 0 ? WS_WC1K : WS_WC1V)), 4096, 4096, 512, 2048, 8, C.G, (C.bid + 128 * kind) % C.G);
                    pg8::EpiSlab E{(float*)(C.ws + WS_SLAB) + (size_t)kind * 8 * 2048 * 256};
                    pg8::gemm_phase(C.lds, g, S, E);
                }
            }
            SEAM(14);
            if (IN(15)) { PH_BEGIN compress2(C, kin); }
            SEAM(15);
            for (int rp_ = 0; rp_ < NREP(16); ++rp_) if (IN(16)) { PH_BEGIN const float* ADA = ADA0 + (size_t)layer * 4 * 6144; (void)ADA;
                att::NsaArgs A{(const bf16_t*)(C.ws + WS_QP), (const bf16_t*)(C.ws + WS_QR), (const bf16_t*)(C.ws + WS_KCMP), (const bf16_t*)(C.ws + WS_VCMP), (const bf16_t*)(C.ws + WS_KSEL), (const bf16_t*)(C.ws + WS_VSEL),
                               (const bf16_t*)(C.ws + WS_KWIN), (const bf16_t*)(C.ws + WS_VWIN), (const float*)(C.ws + WS_GATES), (bf16_t*)(C.ws + WS_ONSA), MF[1], MF[2], MF[3]};
                const int cslot = (C.G == 256) ? ((C.bid >> 3) & 7) : 0;
                for (int i = 0;; ++i) {
                    int bg, c;
                    if (C.G == 256) { if (i >= 8) break; bg = vcu >> 4; const int j = vcu & 15, k = i >> 1; c = (i & 1) ? (32 * k + 31 - j) : (32 * k + j); }
                    else { const int u = i * C.G + C.bid; if (u >= NB * NG * 128) break; bg = u >> 7; c = u & 127; }
                    if (i == cslot) CONV_LAYER_EXPERTS();
                    att::nsa_unit((LAS char*)C.lds, bg >> 2, bg & 3, c, A);
                }
            }
            SEAM(16);
            if (IN(17)) { PH_BEGIN const float* ADA = ADA0 + (size_t)layer * 4 * 6144; (void)ADA;
                pg8::Gemm g{(const bf16_t*)(C.ws + WS_ONSA), DM, DM, DM};
                pg8::DenseSched S; S.init((const bf16_t*)(C.ws + WS_WOB), DM, DM, NTOK, DM, C.G, C.bid);
                pg8::EpiResid E{C.out, C.out, ADA + 2048};
                pg8::gemm_phase(C.lds, g, S, E);
            }
            SEAM(17);
        }
        const int pm1 = layer == 0 ? 5 : 18;
        if (PHB(5) && INR(pm1)) { PH_BEGIN const float* ADA = ADA0 + (size_t)layer * 4 * 6144;
            for (int tile = C.bid; tile < NTOK / 128; tile += C.G) {
                const int tok0 = tile * 128, b = tok0 / SEQ; const float* ad = ADA + (size_t)b * 6144;
                const NormVar V[1] = {{kin[I_NFFN] + layer * DM, ad + 3072, ad + 4096, U}};
                EpiRoute ES{kin[I_BR] + layer * NEXP, C.ctl + CW_CNT + layer * NCH * 64, (int*)(C.ws + WS_TOKE), (int*)(C.ws + WS_TOKP), (int*)(C.ws + WS_ROWTOK), (float*)(C.ws + WS_ROWW)};
                norm_tile<1, 64>(C, tok0, C.out, V, 0, kin[I_WR] + (size_t)layer * DM * NEXP, NEXP, 0, NEXP, ES);
                __syncthreads();
            }
        }
        SEAM(pm1);
#pragma unroll 1
        for (int step = 0; step <= NCH; ++step) {
            const int pa = pm1 + 1 + 2 * step;
            for (int rp_ = 0; rp_ < NREP(6); ++rp_) if (PHB(6) && INR(pa)) { PH_BEGIN const float* ADA = ADA0 + (size_t)layer * 4 * 6144; (void)ADA;
                bf16_t* ACT = (bf16_t*)(C.ws + WS_ACT); unsigned char* Y = C.ws + WS_Y;
                if (step >= 1) {
                    const int ch = step - 1;
                    const unsigned* cntg = (const unsigned*)(C.ctl + CW_CNT + (layer * NCH + ch) * 64);
                    const LAS int* pstart; const pg8::MoeTab T = moe_tables(C, cntg, &pstart); (void)T;
                    pg8::Gemm g{(const bf16_t*)(C.ws + (ch & 1 ? WS_ACTS1 : WS_ACTS)), DEXP, DEXP, DEXP};
                    pg8::DenseSched S; S.init((const bf16_t*)(C.ws + WS_WSD) + (size_t)layer * DM * DEXP, DEXP, DEXP, CHTOK, DM, C.G, C.bid, 0);
                    pg8::EpiCombine E{C.out, Y, (const int*)(C.ws + WS_TOKE), (const int*)(C.ws + WS_TOKP), pstart, ADA + 5120, ch * CHTOK};
                    pg8::gemm_phase(C.lds, g, S, E);
                }
                if (step < NCH) {
                    const int ch = step;
                    const unsigned* cntg = (const unsigned*)(C.ctl + CW_CNT + (layer * NCH + ch) * 64);
                    const int* ROWTOK = (const int*)(C.ws + WS_ROWTOK) + (size_t)ch * 64 * CHTOK;
                    const LAS int* pstart; const pg8::MoeTab T = moe_tables(C, cntg, &pstart, true);
                    pg8::Gemm g{U, DM, 512, DM};
                    pg8::MoeGatherSched S; S.T = T; S.Bt = (const bf16_t*)(C.ws + WS_WEGU); S.Bsh = (const bf16_t*)(C.ws + WS_WSGU) + (size_t)layer * 512 * DM; S.rowtok = ROWTOK; S.nN = 2; S.G = C.G; S.c = C.bid; S.ldb = DM; S.bstride = (size_t)512 * DM; S.tokbase = ch * CHTOK;
                    pg8::EpiGU E{ACT, (bf16_t*)(C.ws + (ch & 1 ? WS_ACTS1 : WS_ACTS)), T};
                    pg8::gemm_phase(C.lds, g, S, E);
                }
            }
            if (!(layer == 1 && step == NCH)) SEAM(pa);
            if (step < NCH) {
                const int ch = step;
                for (int rp_ = 0; rp_ < NREP(7); ++rp_) if (PHB(7) && INR(pa + 1)) { PH_BEGIN
                    const unsigned* cntg = (const unsigned*)(C.ctl + CW_CNT + (layer * NCH + ch) * 64);
                    const float* ROWW = (const float*)(C.ws + WS_ROWW) + (size_t)ch * 64 * CHTOK;
                    const LAS int* pstart; const pg8::MoeTab T = moe_tables(C, cntg, &pstart);
                    pg8::Gemm g{(const bf16_t*)(C.ws + WS_ACT), DEXP, DM, DEXP};
                    pg8::MoeDownSched S; S.T = T; S.Bt = (const bf16_t*)(C.ws + WS_WED); S.nN = 4; S.G = C.G; S.c = C.bid; S.lda = DEXP; S.ldb = DEXP; S.bstride = (size_t)DM * DEXP;
                    pg8::EpiY E{C.ws + WS_Y, T, ROWW};
                    pg8::gemm_phase(C.lds, g, S, E);
                }
                SEAM(pa + 1);
            }
        }
    }
#undef IN
#undef SEAM
}

extern "C" void kernel_launch(void* const* d_in, const int* in_sizes, int n_in, void* d_out, int out_size, void* d_ws, size_t ws_size, hipStream_t stream) {
    static int grid = 0;
    if (grid == 0) {
        if (n_in != N_IN || in_sizes[0] != NTOK * DM || out_size != NTOK * DM || ws_size < WS_END) { fprintf(stderr, "kernel_launch: unexpected shapes (n_in %d, ws %zu < %zu)\n", n_in, ws_size, (size_t)WS_END); grid = -1; return; }
        int dev = 0, cus = 0, per_cu = 0;
        if (hipGetDevice(&dev) != hipSuccess || hipDeviceGetAttribute(&cus, hipDeviceAttributeMultiprocessorCount, dev) != hipSuccess) { grid = -1; return; }
        if (hipFuncSetAttribute((const void*)fwd_kernel, hipFuncAttributeMaxDynamicSharedMemorySize, LDS_BYTES) != hipSuccess) { fprintf(stderr, "kernel_launch: hipFuncSetAttribute failed\n"); grid = -1; return; }
        if (hipOccupancyMaxActiveBlocksPerMultiprocessor(&per_cu, (const void*)fwd_kernel, NTHREADS, LDS_BYTES) != hipSuccess || per_cu < 1) { fprintf(stderr, "kernel_launch: occupancy query says %d\n", per_cu); }
        (void)hipGetLastError();
        grid = cus;
    }
    if (grid < 0) return;
    (void)hipMemsetAsync((char*)d_ws + WS_CTL, 0, CTL_ZERO_BYTES, stream);
    Args a{};
    for (int i = 0; i < N_IN; ++i) a.in[i] = (const float*)d_in[i];
    a.out = (float*)d_out; a.ws = (unsigned char*)d_ws;
#if MK_ONE_LAUNCH
    a.ph_lo = 0; a.ph_hi = N_PHASES;
    hipLaunchKernelGGL(fwd_kernel, dim3(grid), dim3(NTHREADS), LDS_BYTES, stream, a);
#else
    for (int p = 0; p < N_PHASES; ++p) { a.ph_lo = p; a.ph_hi = p + 1; hipLaunchKernelGGL(fwd_kernel, dim3(grid), dim3(NTHREADS), LDS_BYTES, stream, a); }
#endif
}
```

```cpp
#include <hip/hip_runtime.h>
#include <cstdint>
#include <cstdio>

#define LAS __attribute__((address_space(3)))
#define GAS __attribute__((address_space(1)))
typedef unsigned short bf16_t;
typedef short bf16x8 __attribute__((ext_vector_type(8)));
typedef short s16x4 __attribute__((ext_vector_type(4)));
typedef float f32x4 __attribute__((ext_vector_type(4)));
typedef float f32x2 __attribute__((ext_vector_type(2)));
typedef float f32x16 __attribute__((ext_vector_type(16)));
typedef unsigned u32x4 __attribute__((ext_vector_type(4)));
typedef unsigned u32x2 __attribute__((ext_vector_type(2)));
typedef int i32x4 __attribute__((ext_vector_type(4)));

constexpr int DM = 1024, NB = 4, SEQ = 8192, NTOK = NB * SEQ;
constexpr int NH = 16, HD = 64, NG = 4;
constexpr int NEXP = 64, TOPK = 8, DEXP = 256;
constexpr int NCH = 1, CHTOK = NTOK / NCH;
constexpr int CH_ROWS = CHTOK * TOPK + NEXP * 256;
constexpr int NCMPB = SEQ / 64;
constexpr float EPSN = 1e-6f;
constexpr float LOG2E = 1.4426950408889634f;
constexpr float C2 = 0.125f * LOG2E;
constexpr int NWAVES = 8, NTHREADS = 512;
constexpr float USCALE = 8.f, WGSCALE = 64.f;
constexpr float ASCALE = 8.f, WDSCALE = 64.f;
constexpr float YSCALE = 16.f;

enum { I_X = 0, I_C, I_POS, I_WADA, I_BADA, I_NMIX, I_NFFN, I_WINA, I_BFA, I_QNA, I_KNA, I_WOA, I_NKV, I_WADAKV, I_BADAKV, I_WKVB, I_PEK, I_PEV,
       I_WCK1, I_WCK2, I_WCV1, I_WCV2, I_KNB, I_WINB, I_BGB, I_QNB, I_WOB, I_WR, I_BR, I_WEG, I_WEU, I_WED, I_WSG, I_WSU, I_WSD, N_IN };

constexpr size_t MiB = 1u << 20;
constexpr size_t WS_CTL = 0, CTL_ZERO_BYTES = 32 * 1024;
constexpr size_t WS_ADA = 1 * MiB;
constexpr size_t WS_ADAKV = WS_ADA + 2 * 4 * 6144 * 4;
constexpr size_t WS_MF = WS_ADAKV + 4 * 2048 * 4;
constexpr size_t WS_ROPE = 2 * MiB;
constexpr size_t WS_LOGF = 4 * MiB;
constexpr size_t WS_CUM = 6 * MiB;
constexpr size_t WS_GATES = 8 * MiB;
constexpr size_t WS_TOKE = 14 * MiB;
constexpr size_t WS_TOKP = 15 * MiB;
constexpr size_t WS_ROWTOK = 16 * MiB;
constexpr size_t WS_ROWW = 24 * MiB;
constexpr size_t WS_KCMP = 32 * MiB;
constexpr size_t WS_VCMP = WS_KCMP + 512 * 1024;
constexpr size_t WS_WB = 33 * MiB;
constexpr size_t WS_WQKV = WS_WB;
constexpr size_t WS_WOA = WS_WQKV + 6 * MiB;
constexpr size_t WS_WKV = WS_WOA + 2 * MiB;
constexpr size_t WS_WQB = WS_WKV + 3 * MiB;
constexpr size_t WS_WOB = WS_WQB + 2 * MiB;
constexpr size_t WS_WC1K = WS_WOB + 2 * MiB;
constexpr size_t WS_WC1V = WS_WC1K + 2 * MiB;
constexpr size_t WS_WSGU = WS_WC1V + 2 * MiB;
constexpr size_t WS_WSD = WS_WSGU + 2 * MiB;
constexpr size_t WS_WEGU = WS_WSD + 1 * MiB;
constexpr size_t WS_WED = WS_WEGU + 64 * MiB;
constexpr size_t WS_U = WS_WED + 32 * MiB;
constexpr size_t WS_D = WS_U + 64 * MiB;
constexpr size_t WS_Q = WS_D, WS_K = WS_D + 64 * MiB, WS_V = WS_D + 128 * MiB, WS_O = WS_D + 192 * MiB;
constexpr size_t WS_Y = WS_U;
constexpr size_t WS_ACT = WS_U + 272 * MiB;
constexpr size_t WS_ACTS = WS_ACT + 136 * MiB;
constexpr size_t WS_ACTS1 = WS_ACTS;
constexpr size_t WS_SKV = WS_D;
constexpr size_t WS_QP = WS_D + 64 * MiB, WS_QR = WS_D + 128 * MiB;
constexpr size_t WS_KSEL = WS_D + 192 * MiB, WS_VSEL = WS_KSEL + 16 * MiB, WS_KWIN = WS_VSEL + 16 * MiB, WS_VWIN = WS_KWIN + 16 * MiB;
constexpr size_t WS_ACK = WS_D + 256 * MiB, WS_ACV = WS_ACK + 16 * MiB;
constexpr size_t WS_SLAB = WS_D + 288 * MiB;
constexpr size_t WS_ONSA = WS_U;
constexpr size_t WS_END = WS_D + 368 * MiB;
static_assert(NCH == 1 && (size_t)CH_ROWS * 512 <= 136 * MiB && (size_t)CH_ROWS * 1024 <= 272 * MiB && WS_ACTS + (size_t)CHTOK * 512 <= WS_D + 368 * MiB, "moe chunk buffers");
static_assert(WS_END <= 612 * MiB, "workspace");

constexpr int CW_TMO = 0;
constexpr int CW_CNT = 1024;
constexpr int CW_BAR = 4096;

constexpr int RING_BYTES = 131072;
constexpr int MISC_OFF = 143360;
constexpr int LDS_BYTES = 147456;

__device__ __forceinline__ unsigned f2bf(float f) { unsigned u = __builtin_bit_cast(unsigned, f); return (u + 0x7fffu + ((u >> 16) & 1u)) >> 16; }
__device__ __forceinline__ unsigned pk2(float lo, float hi) { return f2bf(lo) | (f2bf(hi) << 16); }
__device__ __forceinline__ float bf2f(unsigned short v) { return __builtin_bit_cast(float, (unsigned)v << 16); }
__device__ __forceinline__ unsigned cvt_pk_bf16(float lo, float hi) { unsigned r; asm("v_cvt_pk_bf16_f32 %0, %1, %2" : "=v"(r) : "v"(lo), "v"(hi)); return r; }
__device__ __forceinline__ int lane_local() { int l = (int)__builtin_amdgcn_mbcnt_hi(~0u, __builtin_amdgcn_mbcnt_lo(~0u, 0u)); asm volatile("" : "+v"(l)); return l; }
__device__ __forceinline__ int shx_(int v, int o) { return __builtin_amdgcn_ds_bpermute((lane_local() ^ o) << 2, v); }
__device__ __forceinline__ unsigned shx_(unsigned v, int o) { return (unsigned)shx_((int)v, o); }
__device__ __forceinline__ float shx_(float v, int o) { return __int_as_float(shx_(__float_as_int(v), o)); }
__device__ __forceinline__ int shup_(int v, int o) { const int l = lane_local(); return __builtin_amdgcn_ds_bpermute((l >= o ? l - o : l) << 2, v); }
__device__ __forceinline__ float shup_(float v, int o) { return __int_as_float(shup_(__float_as_int(v), o)); }
#define __shfl_xor(v, o) shx_(v, o)
#define __shfl_up(v, o) shup_(v, o)
__device__ __forceinline__ float wave_sum(float v) {
#pragma unroll
    for (int o = 1; o < 64; o <<= 1) v += __shfl_xor(v, o);
    return v;
}
__device__ __forceinline__ int crow(int r, int hi) { return (r & 3) + 8 * (r >> 2) + 4 * hi; }
__device__ __forceinline__ float sigmoidf_(float x) { return 1.f / (1.f + __expf(-x)); }
__device__ __forceinline__ float siluf_(float x) { return x / (1.f + __expf(-x)); }
__device__ __forceinline__ float siluf_fast(float x) { return x * __builtin_amdgcn_rcpf(1.f + __expf(-x)); }
#define LDS_WAIT() asm volatile("s_waitcnt lgkmcnt(0)" ::: "memory")
#define VM_WAIT() asm volatile("s_waitcnt vmcnt(0)" ::: "memory")
namespace pg8 {
constexpr int BM = 256, BK = 64, HALF = 128, HTB = HALF * BK * 2, STAGE_BYTES = 8 * HTB;
typedef long l64x2 __attribute__((ext_vector_type(2)));
__device__ __forceinline__ int lds_byte(int r, int c) { const int st = (r >> 4) * 2 + (c >> 5), rr = r & 15, cc = c & 31, ob = rr * 64 + cc * 2; return st * 1024 + (ob ^ (((ob >> 9) & 1) << 5)); }
__device__ __forceinline__ void stage_rc(int b, int& R, int& C) { const int st = b / 1024, sb = b % 1024, swz = sb ^ (((sb >> 9) & 1) << 5); R = (st >> 1) * 16 + swz / 64; C = (st & 1) * 32 + (swz % 64) / 2; }
__device__ __forceinline__ int perm32(int rho) { const int n = rho >> 4, i = rho & 15; return 8 * (i >> 2) + 4 * n + (i & 3); }

struct Unit { int pm, pn, aux; };
struct Gemm { const bf16_t* A; int lda; int ldb; int K; };

template <class Epi, class Sched>
__device__ __forceinline__ void gemm_phase(LAS unsigned char* lds, const Gemm g, const Sched& S, const Epi& E, int wv_) {
    int tid_ = (wv_ << 6) | lane_local(); asm volatile("" : "+v"(tid_));
    const int tid = tid_, wid = __builtin_amdgcn_readfirstlane(tid >> 6), lane = tid & 63, wr = wid >> 2, wc = wid & 3, fr = lane & 15, fq = lane >> 4;
    const int nt = g.K / BK;
    int RA[2], CA[2]; unsigned voffB[2];
#pragma unroll
    for (int i = 0; i < 2; ++i) { int R, C; stage_rc(tid * 16 + i * 8192, R, C); RA[i] = R; CA[i] = C;
        if constexpr (Sched::BCH) { const int b = tid * 16 + i * 8192, st = b >> 10, sb = b & 1023; R = (st >> 1) * 16 + ((sb & 255) >> 4); C = (st & 1) * 32 + (sb >> 8) * 8; }
        const int Rb = (R & ~31) + perm32(R & 31); voffB[i] = Sched::BCH ? (unsigned)((C >> 3) * g.ldb + Rb) * 16u : (unsigned)(Rb * g.ldb + C) * 2u; }
    const size_t hstepB = Sched::BCH ? (size_t)HALF * 16 : (size_t)HALF * g.ldb * 2;
    const unsigned ldsw = (unsigned)wid * 1024u;
    const int aoff = lds_byte(wr * 64 + fr, fq * 8), boff = Sched::BCH ? wc * 4096 + fq * 256 + fr * 16 : lds_byte(wc * 32 + fr, fq * 8);
#define PG8_SA(b, h) (((b) * 2 + (h)) * HTB)
#define PG8_SB(b, h) ((4 + (b) * 2 + (h)) * HTB)
#define PG8_STAGEB(bufoff, gbase) do { _Pragma("unroll") for (int _i = 0; _i < 2; ++_i) \
        __builtin_amdgcn_global_load_lds((const unsigned*)((const char*)(gbase) + voffB[_i]), (LAS unsigned*)(lds + (bufoff) + ldsw + _i * 8192), 16, 0, 0); } while (0)
#define PG8_STAGEA(bufoff, o0, o1, kb) do { \
        __builtin_amdgcn_global_load_lds((const unsigned*)((const char*)g.A + (size_t)(o0) + (size_t)(kb)), (LAS unsigned*)(lds + (bufoff) + ldsw), 16, 0, 0); \
        __builtin_amdgcn_global_load_lds((const unsigned*)((const char*)g.A + (size_t)(o1) + (size_t)(kb)), (LAS unsigned*)(lds + (bufoff) + ldsw + 8192), 16, 0, 0); } while (0)
#define PG8_LDA(dst, b, h) do { _Pragma("unroll") for (int m = 0; m < 4; ++m) _Pragma("unroll") for (int k = 0; k < 2; ++k) dst[m][k] = *(const LAS bf16x8*)(lds + PG8_SA(b, h) + aoff + m * 2048 + k * 1024); } while (0)
#define PG8_LDB(dst, b, h) do { _Pragma("unroll") for (int n = 0; n < 2; ++n) _Pragma("unroll") for (int k = 0; k < 2; ++k) dst[n][k] = *(const LAS bf16x8*)(lds + PG8_SB(b, h) + boff + n * 2048 + k * 1024); } while (0)
#define PG8_MMA(ai, bj, At, Bt) do { __builtin_amdgcn_s_setprio(1); _Pragma("unroll") for (int m = 0; m < 4; ++m) _Pragma("unroll") for (int n = 0; n < 2; ++n) _Pragma("unroll") for (int k = 0; k < 2; ++k) { \
        if constexpr (Sched::F8) { const l64x2 bq = __builtin_bit_cast(l64x2, Bt[n][k]), aq = __builtin_bit_cast(l64x2, At[m][k]); \
            acc[ai][bj][m][n] = __builtin_amdgcn_mfma_f32_16x16x32_fp8_fp8(bq.x, aq.x, acc[ai][bj][m][n], 0, 0, 0); \
            acc[ai][bj][m][n] = __builtin_amdgcn_mfma_f32_16x16x32_fp8_fp8(bq.y, aq.y, acc[ai][bj][m][n], 0, 0, 0); } \
        else acc[ai][bj][m][n] = __builtin_amdgcn_mfma_f32_16x16x32_bf16(Bt[n][k], At[m][k], acc[ai][bj][m][n], 0, 0, 0); } __builtin_amdgcn_s_setprio(0); } while (0)
#define PG8_WAIT_V(n) asm volatile("s_waitcnt vmcnt(" #n ")" ::: "memory")
#define PG8_WAIT_L(n) asm volatile("s_waitcnt lgkmcnt(" #n ")" ::: "memory")
#define PG8_BAR __builtin_amdgcn_s_barrier()
#define PG8_SCHED __builtin_amdgcn_sched_barrier(0)
    Unit cur, nxt; int ui = 0;
    if (!S.next(0, cur)) return;
    f32x4 acc[2][2][4][2];
#pragma unroll
    for (int a = 0; a < 2; ++a)
#pragma unroll
        for (int b = 0; b < 2; ++b)
#pragma unroll
            for (int m = 0; m < 4; ++m)
#pragma unroll
                for (int n = 0; n < 2; ++n) acc[a][b][m][n] = (f32x4){0.f, 0.f, 0.f, 0.f};
    bf16x8 At[4][2], B0[2][2], B1[2][2];
    float pf[Epi::NPF > 0 ? Epi::NPF : 1];
    if constexpr (Epi::NPF > 0) E.pre(cur, wr, fr, pf);
    unsigned c00 = 0, c01 = 0, c10 = 0, c11 = 0, n00 = 0, n01 = 0, n10 = 0, n11 = 0;
    size_t cAu = 0, nAu = 0; const size_t hstepA = (size_t)HALF * g.lda * 2;
    if constexpr (Sched::GATHER) {
        c00 = S.a_off(cur, RA[0]) + CA[0] * 2u; c01 = S.a_off(cur, RA[1]) + CA[1] * 2u; c10 = S.a_off(cur, HALF + RA[0]) + CA[0] * 2u; c11 = S.a_off(cur, HALF + RA[1]) + CA[1] * 2u;
    } else {
        c00 = c10 = (unsigned)(RA[0] * g.lda + CA[0]) * 2u; c01 = c11 = (unsigned)(RA[1] * g.lda + CA[1]) * 2u; cAu = S.a_base(cur);
    }
#define PG8_STAGEA_H(bufoff, h, kb) do { if constexpr (Sched::GATHER) { if ((h) == 0) PG8_STAGEA(bufoff, c00, c01, kb); else PG8_STAGEA(bufoff, c10, c11, kb); } \
        else { PG8_STAGEA(bufoff, c00, c01, cAu + (h) * hstepA + (kb)); } } while (0)
    const char* cB = S.b_ptr(cur);
    const unsigned kstep = BK * 2;
    const unsigned kstepB = Sched::BCH ? (unsigned)g.ldb * 128u : kstep;
    PG8_STAGEB(PG8_SB(0, 0), cB); PG8_STAGEB(PG8_SB(0, 1), cB + hstepB); PG8_STAGEA_H(PG8_SA(0, 0), 0, 0); PG8_STAGEA_H(PG8_SA(0, 1), 1, 0);
    if (wr == 1) PG8_BAR;
    PG8_WAIT_V(2); PG8_BAR;
    PG8_STAGEB(PG8_SB(1, 0), cB + kstepB); PG8_STAGEA_H(PG8_SA(1, 0), 0, kstep); PG8_STAGEB(PG8_SB(1, 1), cB + hstepB + kstepB);
    PG8_WAIT_V(6); PG8_BAR;
    for (;;) {
        const bool has_next = S.next(ui + 1, nxt);
        const char* nB = cB; nAu = cAu;
        if constexpr (Sched::GATHER) { n00 = c00; n01 = c01; n10 = c10; n11 = c11; }
        if (has_next) { nB = S.b_ptr(nxt);
            if constexpr (Sched::GATHER) { n00 = S.a_off(nxt, RA[0]) + CA[0] * 2u; n01 = S.a_off(nxt, RA[1]) + CA[1] * 2u; n10 = S.a_off(nxt, HALF + RA[0]) + CA[0] * 2u; n11 = S.a_off(nxt, HALF + RA[1]) + CA[1] * 2u; }
            else nAu = S.a_base(nxt); }
#pragma unroll 1
        for (int t = 0; t < nt; t += 2) {
            const bool last = (t == nt - 2);
            const unsigned k1 = (unsigned)(t + 1) * kstep;
            const unsigned k2 = last ? 0u : (unsigned)(t + 2) * kstep, k3 = k2 + kstep;
            const unsigned k2B = Sched::BCH ? (last ? 0u : (unsigned)(t + 2) * kstepB) : k2;
            const char* bb = last ? nB : cB; const char* b2 = bb + k2B; const char* b3 = b2 + kstepB;
            PG8_LDB(B0, 0, 0); PG8_LDB(B1, 0, 1); PG8_SCHED; PG8_LDA(At, 0, 0); PG8_STAGEA_H(PG8_SA(1, 1), 1, k1);
            if (last) { if constexpr (Sched::GATHER) { c00 = n00; c01 = n01; c10 = n10; c11 = n11; } else cAu = nAu; }
            PG8_WAIT_V(8); PG8_WAIT_L(0); PG8_BAR; PG8_MMA(0, 0, At, B0); PG8_MMA(0, 1, At, B1); PG8_BAR; PG8_SCHED;
            PG8_LDA(At, 0, 1); PG8_STAGEB(PG8_SB(0, 0), b2); PG8_STAGEB(PG8_SB(0, 1), b2 + hstepB); PG8_STAGEA_H(PG8_SA(0, 0), 0, k2);
            PG8_WAIT_V(8); PG8_WAIT_L(0); PG8_BAR; PG8_MMA(1, 0, At, B0); PG8_MMA(1, 1, At, B1); PG8_BAR; PG8_SCHED;
            PG8_LDB(B0, 1, 0); PG8_LDB(B1, 1, 1); PG8_SCHED; PG8_LDA(At, 1, 0); PG8_STAGEA_H(PG8_SA(0, 1), 1, k2);
            PG8_WAIT_V(8); PG8_WAIT_L(0); PG8_BAR; PG8_MMA(0, 0, At, B0); PG8_MMA(0, 1, At, B1); PG8_BAR; PG8_SCHED;
            PG8_LDA(At, 1, 1); PG8_STAGEB(PG8_SB(1, 0), b3); PG8_STAGEB(PG8_SB(1, 1), b3 + hstepB); PG8_STAGEA_H(PG8_SA(1, 0), 0, k3);
            PG8_WAIT_V(8); PG8_WAIT_L(0); PG8_BAR; PG8_MMA(1, 0, At, B0); PG8_MMA(1, 1, At, B1); PG8_BAR; PG8_SCHED;
        }
        if (wr == 0) PG8_BAR;
        if constexpr (Epi::NPF > 0) E(acc, cur, wr, wc, fr, fq, pf); else E(acc, cur, wr, wc, fr, fq);
        if (!has_next) break;
#pragma unroll
        for (int a = 0; a < 2; ++a)
#pragma unroll
            for (int b = 0; b < 2; ++b)
#pragma unroll
                for (int m = 0; m < 4; ++m)
#pragma unroll
                    for (int n = 0; n < 2; ++n) acc[a][b][m][n] = (f32x4){0.f, 0.f, 0.f, 0.f};
        cur = nxt; cB = nB; ++ui;
        if constexpr (Epi::NPF > 0) E.pre(cur, wr, fr, pf);
        if (wr == 1) PG8_BAR;
    }
    PG8_WAIT_V(0);
    PG8_BAR;
#undef PG8_SA
#undef PG8_SB
#undef PG8_STAGEA
#undef PG8_STAGEA_H
#undef PG8_STAGEB
#undef PG8_LDA
#undef PG8_LDB
#undef PG8_MMA
#undef PG8_WAIT_V
#undef PG8_WAIT_L
#undef PG8_BAR
#undef PG8_SCHED
}

struct DenseSched {
    static constexpr bool GATHER = false, BCH = false, F8 = false;
    const bf16_t* Bt; int lda, ldb; int nM, nN, nwg, G, c; int rowbase;
    __device__ void init(const bf16_t* Bt_, int lda_, int ldb_, int M, int N, int G_, int c_, int rowbase_ = 0) { Bt = Bt_; lda = lda_; ldb = ldb_; nM = M / BM; nN = N / BM; nwg = nM * nN; G = G_; c = c_; rowbase = rowbase_; }
    __device__ __forceinline__ bool next(int i, Unit& u) const {
        const long L = (long)i * G + c; if (L >= nwg) return false;
        int wgid = (int)L; { const int q = nwg / 8, r = nwg % 8, xcd = wgid % 8, off = wgid / 8; wgid = (xcd < r ? xcd * (q + 1) : r * (q + 1) + (xcd - r) * q) + off; }
        const int nig = 8 * nN, gid = wgid / nig, fm = gid * 8, gsz = (nM - fm) < 8 ? (nM - fm) : 8;
        u.pm = fm + ((wgid % nig) % gsz); u.pn = (wgid % nig) / gsz; u.aux = 0; return true;
    }
    __device__ __forceinline__ size_t a_base(const Unit& u) const { return (size_t)(rowbase + u.pm * BM) * (size_t)lda * 2u; }
    __device__ __forceinline__ unsigned a_off(const Unit&, int) const { return 0u; }
    __device__ __forceinline__ const char* b_ptr(const Unit& u) const { return (const char*)(Bt + (size_t)u.pn * BM * ldb); }
};
struct SplitKSched {
    static constexpr bool GATHER = false, BCH = false, F8 = false;
    const bf16_t* Bt; int lda, ldb, Kc; int nM, nS, nwg, G, c;
    __device__ void init(const bf16_t* Bt_, int lda_, int ldb_, int Kc_, int M, int nS_, int G_, int c_) { Bt = Bt_; lda = lda_; ldb = ldb_; Kc = Kc_; nM = M / BM; nS = nS_; nwg = nM * nS; G = G_; c = c_; }
    __device__ __forceinline__ bool next(int i, Unit& u) const { const int L = i * G + c; if (L >= nwg) return false; u.pm = L % nM; u.aux = L / nM; u.pn = 0; return true; }
    __device__ __forceinline__ size_t a_base(const Unit& u) const { return ((size_t)(u.pm * BM) * (size_t)lda + (size_t)(u.aux * Kc)) * 2u; }
    __device__ __forceinline__ unsigned a_off(const Unit&, int) const { return 0u; }
    __device__ __forceinline__ const char* b_ptr(const Unit& u) const { return (const char*)(Bt + (size_t)u.aux * Kc); }
};
struct MoeTab { const LAS int* tstart; const LAS int* cnt; const LAS unsigned char* tile_e; int ntiles; };
struct MoeGatherSched {
    static constexpr bool GATHER = true, BCH = true, F8 = true;
    __device__ __forceinline__ size_t a_base(const Unit&) const { return 0; }
    MoeTab T; const bf16_t* Bt; const bf16_t* Bsh; const int* rowtok; int nN, G, c; int ldb; size_t bstride; int tokbase;
    __device__ __forceinline__ bool next(int i, Unit& u) const {
        if ((G & 7) == 0) { const int x = c & 7, j = i * (G >> 3) + (c >> 3); const int ts = (T.ntiles * x) >> 3, te = (T.ntiles * (x + 1)) >> 3; const int tile = ts + j / nN; if (tile >= te) return false; u.pm = tile; u.pn = j % nN; }
        else { const int L = i * G + c; if (L >= T.ntiles * nN) return false; u.pm = L / nN; u.pn = L % nN; }
        u.aux = T.tile_e[u.pm]; return true; }
    __device__ __forceinline__ unsigned a_off(const Unit& u, int row) const {
        const int e = u.aux; int lr = (u.pm - T.tstart[e]) * BM + row; const int cn = T.cnt[e]; lr = lr < cn ? lr : cn - 1;
        const int tok = (e == NEXP) ? tokbase + lr : rowtok[(size_t)e * CHTOK + lr]; return (unsigned)tok * (unsigned)DM; }
    __device__ __forceinline__ const char* b_ptr(const Unit& u) const { return (const char*)((u.aux == NEXP ? Bsh : Bt + (size_t)u.aux * bstride) + (size_t)u.pn * BM * 8); }
};
struct MoeDownSched {
    static constexpr bool GATHER = false, BCH = true, F8 = true;
    MoeTab T; const bf16_t* Bt; int nN, G, c; int lda, ldb; size_t bstride;
    __device__ __forceinline__ bool next(int i, Unit& u) const {
        if ((G & 7) == 0) { const int x = c & 7, j = i * (G >> 3) + (c >> 3); const int ts = (T.ntiles * x) >> 3, te = (T.ntiles * (x + 1)) >> 3; const int tile = ts + j / nN; if (tile >= te) return false; u.pm = tile; u.pn = j % nN; }
        else { const int L = i * G + c; if (L >= T.ntiles * nN) return false; u.pm = L / nN; u.pn = L % nN; }
        u.aux = T.tile_e[u.pm]; return true; }
    __device__ __forceinline__ size_t a_base(const Unit& u) const { return (size_t)(u.pm * BM) * (size_t)lda * 2u; }
    __device__ __forceinline__ unsigned a_off(const Unit&, int) const { return 0u; }
    __device__ __forceinline__ const char* b_ptr(const Unit& u) const { return (const char*)(Bt + (size_t)u.aux * bstride + (size_t)u.pn * BM * 8); }
};
}
namespace pg8 {
template <class T> __device__ __forceinline__ T* at(const void* base, unsigned byteoff) { return (T*)((const char*)base + (size_t)byteoff); }

struct EpiQKV {
    static constexpr int NPF = 0;
    static constexpr int NTRAIL = 0;
    bf16_t* Q; size_t kvstride; const float* qg; const float* kg;
    __device__ __forceinline__ void operator()(const f32x4 (&acc)[2][2][4][2], const Unit& u, int wr, int wc, int fr, int fq) const {
        const int kind = u.pn >> 2;
        bf16_t* base = Q + (size_t)kind * kvstride;
        const float* gn = kind == 0 ? qg : kg;
        const float osc = kind == 0 ? C2 : 1.f;
        f32x4 gv[2][2];
#pragma unroll
        for (int bj = 0; bj < 2; ++bj)
#pragma unroll
            for (int n = 0; n < 2; ++n) gv[bj][n] = *(const f32x4*)(gn + 32 * bj + 8 * fq + 4 * n);
        const int colbase = (u.pn & 3) * 256 + wc * 64 + 8 * fq;
#pragma unroll
        for (int ai = 0; ai < 2; ++ai)
#pragma unroll
            for (int m = 0; m < 4; ++m) {
                const int row = u.pm * BM + ai * HALF + wr * 64 + m * 16 + fr;
                float rs = 1.f;
                if (kind < 2) {
                    float ss = 0.f;
#pragma unroll
                    for (int bj = 0; bj < 2; ++bj)
#pragma unroll
                        for (int n = 0; n < 2; ++n) { const f32x4 x = acc[ai][bj][m][n]; ss += (x[0] * x[0] + x[1] * x[1]) + (x[2] * x[2] + x[3] * x[3]); }
                    ss += __shfl_xor(ss, 16); ss += __shfl_xor(ss, 32);
                    rs = rsqrtf(ss * (1.f / 64.f) + EPSN) * osc;
                }
                const unsigned ro = (unsigned)(row * DM + colbase) * 2u;
#pragma unroll
                for (int bj = 0; bj < 2; ++bj) {
                    f32x4 v0 = acc[ai][bj][m][0], v1 = acc[ai][bj][m][1];
                    if (kind < 2) { v0 = v0 * gv[bj][0] * rs; v1 = v1 * gv[bj][1] * rs; }
                    u32x4 w; w.x = cvt_pk_bf16(v0[0], v0[1]); w.y = cvt_pk_bf16(v0[2], v0[3]); w.z = cvt_pk_bf16(v1[0], v1[1]); w.w = cvt_pk_bf16(v1[2], v1[3]);
                    *at<u32x4>(base, ro + 64 * bj) = w;
                }
            }
    }
};

struct EpiResid {
    static constexpr int NPF = 0;
    static constexpr int NTRAIL = 0;
    const float* base; float* out; const float* gate;
    __device__ __forceinline__ void operator()(const f32x4 (&acc)[2][2][4][2], const Unit& u, int wr, int wc, int fr, int fq) const {
        const int col0 = u.pn * BM + wc * 32 + 8 * fq;
        const int b = (u.pm * BM) / SEQ;
        f32x4 gv[2][2];
#pragma unroll
        for (int bj = 0; bj < 2; ++bj)
#pragma unroll
            for (int n = 0; n < 2; ++n) gv[bj][n] = *(const f32x4*)(gate + (size_t)b * 6144 + col0 + bj * HALF + 4 * n);
#pragma unroll
        for (int ai = 0; ai < 2; ++ai) {
            f32x4 bv[4][2][2];
#pragma unroll
            for (int m = 0; m < 4; ++m) { const unsigned ro = (unsigned)((u.pm * BM + ai * HALF + wr * 64 + m * 16 + fr) * DM + col0) * 4u;
#pragma unroll
                for (int bj = 0; bj < 2; ++bj)
#pragma unroll
                    for (int n = 0; n < 2; ++n) bv[m][bj][n] = *at<const f32x4>(base, ro + (bj * HALF + 4 * n) * 4); }
#pragma unroll
            for (int m = 0; m < 4; ++m) { const unsigned ro = (unsigned)((u.pm * BM + ai * HALF + wr * 64 + m * 16 + fr) * DM + col0) * 4u;
#pragma unroll
                for (int bj = 0; bj < 2; ++bj)
#pragma unroll
                    for (int n = 0; n < 2; ++n) *at<f32x4>(out, ro + (bj * HALF + 4 * n) * 4) = bv[m][bj][n] + gv[bj][n] * acc[ai][bj][m][n]; }
        }
    }
};

struct EpiKV {
    static constexpr int NPF = 0;
    static constexpr int NTRAIL = 0;
    bf16_t *ack, *ksel; size_t acstride, kvstride; const float* pek;
    const float* pev; const float* kgain; const float* rope;
    LAS unsigned char* lds;
    __device__ __forceinline__ void operator()(const f32x4 (&acc)[2][2][4][2], const Unit& u, int wr, int wc, int fr, int fq) const {
        const int kind = u.pn, g = wc;
        const bool donorm = (kind == 2 || kind == 4);
        const float* gn = kgain + (kind == 2 ? 64 : 128);
        f32x4 gv[2][2];
#pragma unroll
        for (int bj = 0; bj < 2; ++bj)
#pragma unroll
            for (int n = 0; n < 2; ++n) gv[bj][n] = donorm ? *(const f32x4*)(gn + 32 * bj + 8 * fq + 4 * n) : (f32x4){1.f, 1.f, 1.f, 1.f};
#pragma unroll
        for (int ai = 0; ai < 2; ++ai)
#pragma unroll
            for (int m = 0; m < 4; ++m) {
                const int row = u.pm * BM + ai * HALF + wr * 64 + m * 16 + fr;
                f32x4 v[2][2];
#pragma unroll
                for (int bj = 0; bj < 2; ++bj)
#pragma unroll
                    for (int n = 0; n < 2; ++n) v[bj][n] = acc[ai][bj][m][n];
                if (kind < 2) {
                    const int b = row / SEQ, s = row % SEQ, nb = s >> 6, pos = s & 63;
                    const float* pe = (kind == 0 ? pek : pev) + pos * 64;
                    bf16_t* dbase = ack + (size_t)kind * acstride; const unsigned dofs = (unsigned)(((b * NCMPB + nb) * NG + g) * 4096 + pos * 64 + 8 * fq) * 2u;
#pragma unroll
                    for (int bj = 0; bj < 2; ++bj) {
                        const f32x4 p0 = *(const f32x4*)(pe + 32 * bj + 8 * fq), p1 = *(const f32x4*)(pe + 32 * bj + 8 * fq + 4);
                        const f32x4 v0 = v[bj][0] + p0, v1 = v[bj][1] + p1;
                        u32x4 w; w.x = cvt_pk_bf16(v0[0], v0[1]); w.y = cvt_pk_bf16(v0[2], v0[3]); w.z = cvt_pk_bf16(v1[0], v1[1]); w.w = cvt_pk_bf16(v1[2], v1[3]);
                        *at<u32x4>(dbase, dofs + 64 * bj) = w;
                    }
                } else {
                    if (donorm) {
                        float ss = 0.f;
#pragma unroll
                        for (int bj = 0; bj < 2; ++bj)
#pragma unroll
                            for (int n = 0; n < 2; ++n) { const f32x4 x = v[bj][n]; ss += (x[0] * x[0] + x[1] * x[1]) + (x[2] * x[2] + x[3] * x[3]); }
                        ss += __shfl_xor(ss, 16); ss += __shfl_xor(ss, 32);
                        const float rs = rsqrtf(ss * (1.f / 64.f) + EPSN);
#pragma unroll
                        for (int bj = 0; bj < 2; ++bj)
#pragma unroll
                            for (int n = 0; n < 2; ++n) v[bj][n] = v[bj][n] * gv[bj][n] * rs;
#pragma unroll
                        for (int n = 0; n < 2; ++n) {
                            const f32x4 cs = *(const f32x4*)(rope + (size_t)row * 16 + 4 * n), sn = *(const f32x4*)(rope + (size_t)row * 16 + 8 + 4 * n);
                            f32x4 mine = v[0][n], oth;
#pragma unroll
                            for (int j = 0; j < 4; ++j) oth[j] = __shfl_xor(mine[j], 16);
                            const f32x4 r0 = mine * cs - oth * sn, r1 = mine * cs + oth * sn;
                            if (fq == 0) v[0][n] = r0; else if (fq == 1) v[0][n] = r1;
                        }
                    }
                    bf16_t* dbase = ksel + (size_t)(kind - 2) * kvstride;
                    const unsigned blk = (unsigned)(((row >> 6) * NG + g) * 4096), key = (unsigned)(row & 63);
                    if (kind == 2) {
#pragma unroll
                        for (int bj = 0; bj < 2; ++bj) {
                            const f32x4 v0 = v[bj][0], v1 = v[bj][1];
                            u32x4 w; w.x = cvt_pk_bf16(v0[0], v0[1]); w.y = cvt_pk_bf16(v0[2], v0[3]); w.z = cvt_pk_bf16(v1[0], v1[1]); w.w = cvt_pk_bf16(v1[2], v1[3]);
                            *at<u32x4>(dbase, (blk + ((unsigned)(4 * bj + fq) * 64u + key) * 8u) * 2u) = w;
                        }
                    } else if (kind == 3) {
                        LAS unsigned char* stv = lds + 131072 + (wr * 4 + wc) * 1024;
                        const unsigned ks = key >> 4;
                        const int ln = fq * 16 + fr, dd_ = ln & 31, hh = ln >> 5;
#pragma unroll
                        for (int bj = 0; bj < 2; ++bj) {
                            const f32x4 v0 = v[bj][0], v1 = v[bj][1];
                            u32x4 w; w.x = cvt_pk_bf16(v0[0], v0[1]); w.y = cvt_pk_bf16(v0[2], v0[3]); w.z = cvt_pk_bf16(v1[0], v1[1]); w.w = cvt_pk_bf16(v1[2], v1[3]);
                            *(LAS u32x4*)(stv + fr * 64 + fq * 16) = w;
                            unsigned e8[8];
#pragma unroll
                            for (int j = 0; j < 8; ++j) e8[j] = *(const LAS unsigned short*)(stv + ((j & 3) + 8 * (j >> 2) + 4 * hh) * 64 + dd_ * 2);
                            u32x4 o; o.x = e8[0] | (e8[1] << 16); o.y = e8[2] | (e8[3] << 16); o.z = e8[4] | (e8[5] << 16); o.w = e8[6] | (e8[7] << 16);
                            *at<u32x4>(dbase, (blk + ((((ks * 2u + (unsigned)bj) * 2u + (unsigned)hh) * 32u + (unsigned)dd_) * 8u)) * 2u) = o;
                        }
                    } else {
                        const unsigned dofs = (unsigned)(row * 256 + g * 64 + 8 * fq) * 2u;
#pragma unroll
                        for (int bj = 0; bj < 2; ++bj) {
                            const f32x4 v0 = v[bj][0], v1 = v[bj][1];
                            u32x4 w; w.x = cvt_pk_bf16(v0[0], v0[1]); w.y = cvt_pk_bf16(v0[2], v0[3]); w.z = cvt_pk_bf16(v1[0], v1[1]); w.w = cvt_pk_bf16(v1[2], v1[3]);
                            *at<u32x4>(dbase, dofs + 64 * bj) = w;
                        }
                    }
                }
            }
    }
};

struct EpiQB {
    static constexpr int NPF = 0;
    static constexpr int NTRAIL = 0;
    bf16_t *qp, *qr; const float* qgain; const float* rope;
    __device__ __forceinline__ void operator()(const f32x4 (&acc)[2][2][4][2], const Unit& u, int wr, int wc, int fr, int fq) const {
        f32x4 gv[2][2];
#pragma unroll
        for (int bj = 0; bj < 2; ++bj)
#pragma unroll
            for (int n = 0; n < 2; ++n) gv[bj][n] = *(const f32x4*)(qgain + 32 * bj + 8 * fq + 4 * n);
        const int colbase = u.pn * 256 + wc * 64 + 8 * fq;
#pragma unroll
        for (int ai = 0; ai < 2; ++ai)
#pragma unroll
            for (int m = 0; m < 4; ++m) {
                const int row = u.pm * BM + ai * HALF + wr * 64 + m * 16 + fr;
                f32x4 v[2][2]; float ss = 0.f;
#pragma unroll
                for (int bj = 0; bj < 2; ++bj)
#pragma unroll
                    for (int n = 0; n < 2; ++n) { const f32x4 x = acc[ai][bj][m][n]; v[bj][n] = x; ss += (x[0] * x[0] + x[1] * x[1]) + (x[2] * x[2] + x[3] * x[3]); }
                ss += __shfl_xor(ss, 16); ss += __shfl_xor(ss, 32);
                const float rs = rsqrtf(ss * (1.f / 64.f) + EPSN) * C2;
#pragma unroll
                for (int bj = 0; bj < 2; ++bj)
#pragma unroll
                    for (int n = 0; n < 2; ++n) v[bj][n] = v[bj][n] * gv[bj][n] * rs;
                const unsigned ro = (unsigned)(row * DM + colbase) * 2u;
#pragma unroll
                for (int bj = 0; bj < 2; ++bj) {
                    const f32x4 v0 = v[bj][0], v1 = v[bj][1];
                    u32x4 w; w.x = cvt_pk_bf16(v0[0], v0[1]); w.y = cvt_pk_bf16(v0[2], v0[3]); w.z = cvt_pk_bf16(v1[0], v1[1]); w.w = cvt_pk_bf16(v1[2], v1[3]);
                    *at<u32x4>(qp, ro + 64 * bj) = w;
                }
#pragma unroll
                for (int n = 0; n < 2; ++n) {
                    const f32x4 cs = *(const f32x4*)(rope + (size_t)row * 16 + 4 * n), sn = *(const f32x4*)(rope + (size_t)row * 16 + 8 + 4 * n);
                    f32x4 mine = v[0][n], oth;
#pragma unroll
                    for (int j = 0; j < 4; ++j) oth[j] = __shfl_xor(mine[j], 16);
                    const f32x4 r0 = mine * cs - oth * sn, r1 = mine * cs + oth * sn;
                    if (fq == 0) v[0][n] = r0; else if (fq == 1) v[0][n] = r1;
                }
#pragma unroll
                for (int bj = 0; bj < 2; ++bj) {
                    const f32x4 v0 = v[bj][0], v1 = v[bj][1];
                    u32x4 w; w.x = cvt_pk_bf16(v0[0], v0[1]); w.y = cvt_pk_bf16(v0[2], v0[3]); w.z = cvt_pk_bf16(v1[0], v1[1]); w.w = cvt_pk_bf16(v1[2], v1[3]);
                    *at<u32x4>(qr, ro + 64 * bj) = w;
                }
            }
    }
};

__device__ __forceinline__ float clamp440(float x) { return __builtin_copysignf(__builtin_fminf(__builtin_fabsf(x), 440.f), x); }
__device__ __forceinline__ unsigned pk4_fp8_l(const f32x4 v) {
    int p = __builtin_amdgcn_cvt_pk_fp8_f32(clamp440(v[0]), clamp440(v[1]), 0, false);
    p = __builtin_amdgcn_cvt_pk_fp8_f32(clamp440(v[2]), clamp440(v[3]), p, true);
    return (unsigned)p;
}
__device__ __forceinline__ unsigned pk4_fp8(const f32x4 v) {
    const float lim = 440.f;
    int p = __builtin_amdgcn_cvt_pk_fp8_f32(__builtin_amdgcn_fmed3f(v[0], -lim, lim), __builtin_amdgcn_fmed3f(v[1], -lim, lim), 0, false);
    p = __builtin_amdgcn_cvt_pk_fp8_f32(__builtin_amdgcn_fmed3f(v[2], -lim, lim), __builtin_amdgcn_fmed3f(v[3], -lim, lim), p, true);
    return (unsigned)p;
}
constexpr float GUINV = 1.f / (USCALE * WGSCALE);
struct EpiGU {
    static constexpr int NPF = 0;
    static constexpr int NTRAIL = 8;
    bf16_t* act; bf16_t* acts; int tsh;
    __device__ __forceinline__ void operator()(const f32x4 (&acc)[2][2][4][2], const Unit& u, int wr, int wc, int fr, int fq) const {
        const int col0 = u.pn * 128 + wc * 32 + 8 * fq;
        const bool sh = (u.aux == NEXP);
        bf16_t* base = sh ? acts : act; const int tile0 = sh ? (u.pm - tsh) : u.pm;
        if (sh) {
#pragma unroll
            for (int ai = 0; ai < 2; ++ai)
#pragma unroll
                for (int m = 0; m < 4; ++m) {
                    const unsigned row = (unsigned)(tile0 * BM + ai * HALF + wr * 64 + m * 16 + fr);
                    f32x4 o[2];
#pragma unroll
                    for (int n = 0; n < 2; ++n) { const f32x4 gt = acc[ai][0][m][n], up = acc[ai][1][m][n];
#pragma unroll
                        for (int j = 0; j < 4; ++j) o[n][j] = siluf_fast(gt[j] * GUINV) * (up[j] * GUINV); }
                    u32x4 w; w.x = cvt_pk_bf16(o[0][0], o[0][1]); w.y = cvt_pk_bf16(o[0][2], o[0][3]); w.z = cvt_pk_bf16(o[1][0], o[1][1]); w.w = cvt_pk_bf16(o[1][2], o[1][3]);
                    *at<u32x4>(base, (row * DEXP + col0) * 2u) = w;
                }
        } else {
#pragma unroll
            for (int ai = 0; ai < 2; ++ai)
#pragma unroll
                for (int m = 0; m < 4; ++m) {
                    const unsigned row = (unsigned)(tile0 * BM + ai * HALF + wr * 64 + m * 16 + fr);
                    u32x2 w;
#pragma unroll
                    for (int n = 0; n < 2; ++n) { const f32x4 gt = acc[ai][0][m][n], up = acc[ai][1][m][n]; f32x4 o;
#pragma unroll
                        for (int j = 0; j < 4; ++j) o[j] = siluf_fast(gt[j] * GUINV) * (up[j] * (GUINV * ASCALE));
                        if (n == 0) w.x = pk4_fp8(o); else w.y = pk4_fp8(o); }
                    *at<u32x2>(base, row * DEXP + col0) = w;
                }
        }
    }
};

struct EpiY {
    static constexpr int NPF = 8;
    static constexpr int NTRAIL = 0;
    unsigned char* Y; MoeTab T; const float* roww;
    __device__ __forceinline__ void pre(const Unit& u, int wr, int fr, float (&pf)[8]) const {
        const int e = u.aux, lbase = (u.pm - T.tstart[e]) * BM;
#pragma unroll
        for (int ai = 0; ai < 2; ++ai)
#pragma unroll
            for (int m = 0; m < 4; ++m) pf[ai * 4 + m] = *at<const float>(roww, (unsigned)(e * CHTOK + lbase + ai * HALF + wr * 64 + m * 16 + fr) * 4u);
    }
    __device__ __forceinline__ void operator()(const f32x4 (&acc)[2][2][4][2], const Unit& u, int wr, int wc, int fr, int fq, const float (&pf)[8]) const {
        const int col0 = u.pn * BM + wc * 64 + 16 * fq;
#pragma unroll
        for (int ai = 0; ai < 2; ++ai)
#pragma unroll
            for (int m = 0; m < 4; ++m) {
                const int r = ai * HALF + wr * 64 + m * 16 + fr;
                const float w8 = pf[ai * 4 + m] * (YSCALE / (ASCALE * WDSCALE));
                u32x4 w; w.x = pk4_fp8(acc[ai][0][m][0] * w8); w.y = pk4_fp8(acc[ai][0][m][1] * w8); w.z = pk4_fp8(acc[ai][1][m][0] * w8); w.w = pk4_fp8(acc[ai][1][m][1] * w8);
                *at<u32x4>(Y, (unsigned)((u.pm * BM + r) * DM + col0)) = w;
            }
    }
};

struct EpiCombine {
    static constexpr int NPF = 0;
    static constexpr int NTRAIL = 0;
    float* h; const unsigned char* Y; const int* toke; const int* tokp; const LAS int* pstart; const float* gate; int tokbase;
    __device__ __forceinline__ void operator()(const f32x4 (&acc)[2][2][4][2], const Unit& u, int wr, int wc, int fr, int fq) const {
        const int col0 = u.pn * BM + wc * 64 + 16 * fq;
        const int b = (tokbase + u.pm * BM) / SEQ;
        const float* gp = gate + (size_t)b * 6144 + u.pn * BM + wc * 64 + 4 * fq;
        const int t0 = tokbase + u.pm * BM + wr * 64 + fr;
        i32x4 e0 = *at<const i32x4>(toke, (unsigned)t0 * 32u), e1 = *at<const i32x4>(toke, (unsigned)t0 * 32u + 16u);
        i32x4 p0 = *at<const i32x4>(tokp, (unsigned)t0 * 32u), p1 = *at<const i32x4>(tokp, (unsigned)t0 * 32u + 16u);
#pragma unroll
        for (int ai = 0; ai < 2; ++ai)
#pragma unroll
            for (int m = 0; m < 4; ++m) {
                const int t = t0 + ai * HALF + m * 16;
                int yr[8];
#pragma unroll
                for (int k = 0; k < 4; ++k) { yr[k] = pstart[e0[k]] + p0[k]; yr[4 + k] = pstart[e1[k]] + p1[k]; }
                u32x4 yw[8];
#pragma unroll
                for (int k = 0; k < 8; ++k) yw[k] = *at<const u32x4>(Y, (unsigned)(yr[k] * DM + col0));
                const unsigned ho = (unsigned)(t * DM + u.pn * BM + wc * 64 + 4 * fq) * 4u;
                f32x4 hv[4];
#pragma unroll
                for (int q = 0; q < 4; ++q) hv[q] = *at<const f32x4>(h, ho + 64u * q);
                if (ai * 4 + m < 7) { const int tn = t0 + ((ai * 4 + m + 1) >> 2) * HALF + ((ai * 4 + m + 1) & 3) * 16;
                    e0 = *at<const i32x4>(toke, (unsigned)tn * 32u); e1 = *at<const i32x4>(toke, (unsigned)tn * 32u + 16u);
                    p0 = *at<const i32x4>(tokp, (unsigned)tn * 32u); p1 = *at<const i32x4>(tokp, (unsigned)tn * 32u + 16u); }
                f32x4 s[2][2];
#pragma unroll
                for (int bj = 0; bj < 2; ++bj)
#pragma unroll
                    for (int n = 0; n < 2; ++n) s[bj][n] = (f32x4){0.f, 0.f, 0.f, 0.f};
#pragma unroll
                for (int k = 0; k < 8; ++k) {
#pragma unroll
                    for (int q = 0; q < 4; ++q) { const unsigned ww = q == 0 ? yw[k].x : q == 1 ? yw[k].y : q == 2 ? yw[k].z : yw[k].w;
                        const f32x2 lo = __builtin_amdgcn_cvt_pk_f32_fp8((int)ww, false), hi2 = __builtin_amdgcn_cvt_pk_f32_fp8((int)ww, true);
                        s[q >> 1][q & 1][0] += lo.x; s[q >> 1][q & 1][1] += lo.y; s[q >> 1][q & 1][2] += hi2.x; s[q >> 1][q & 1][3] += hi2.y; }
                }
#pragma unroll
                for (int bj = 0; bj < 2; ++bj)
#pragma unroll
                    for (int n = 0; n < 2; ++n) {
                        const f32x4 gvv = *(const f32x4*)(gp + 32 * bj + 16 * n);
                        *at<f32x4>(h, ho + (32 * bj + 16 * n) * 4) = hv[2 * bj + n] + gvv * (acc[ai][bj][m][n] + s[bj][n] * (1.f / YSCALE));
                    }
                asm volatile("" ::: "memory");
            }
    }
};

struct EpiSlab {
    static constexpr int NPF = 0;
    static constexpr int NTRAIL = 0;
    float* slab;
    __device__ __forceinline__ void operator()(const f32x4 (&acc)[2][2][4][2], const Unit& u, int wr, int wc, int fr, int fq) const {
        const int col0 = wc * 32 + 8 * fq;
#pragma unroll
        for (int ai = 0; ai < 2; ++ai)
#pragma unroll
            for (int m = 0; m < 4; ++m) {
                const unsigned ro = (unsigned)((u.aux * 2048 + u.pm * BM + ai * HALF + wr * 64 + m * 16 + fr) * 256 + col0) * 4u;
#pragma unroll
                for (int bj = 0; bj < 2; ++bj)
#pragma unroll
                    for (int n = 0; n < 2; ++n) *at<f32x4>(slab, ro + (bj * HALF + 4 * n) * 4) = acc[ai][bj][m][n];
            }
    }
};
}
namespace att {
constexpr int NSLOT = 4;
constexpr int L_K = 0, L_V = 32768, L_CK = 65536, L_WSF = 73728, L_UNI = 75776, L_LIST = 75840, L_OS = 76800;
__device__ __forceinline__ s16x4 vtr(const LAS char* p) { typedef short v4i16_t __attribute__((ext_vector_type(4))); return __builtin_bit_cast(s16x4, __builtin_amdgcn_ds_read_tr16_b64_v4i16((LAS v4i16_t*)p)); }
__device__ __forceinline__ int dppx1(int x) { return __builtin_amdgcn_update_dpp(0, x, 0xB1, 0xF, 0xF, false); }
__device__ __forceinline__ int dppx2(int x) { return __builtin_amdgcn_update_dpp(0, x, 0x4E, 0xF, 0xF, false); }
__device__ __forceinline__ float dppx1f(float x) { return __int_as_float(dppx1(__float_as_int(x))); }
__device__ __forceinline__ float dppx2f(float x) { return __int_as_float(dppx2(__float_as_int(x))); }

__device__ __forceinline__ void glds16(const void* gsrc, unsigned lds_dst) { unsigned keep;
    asm volatile("s_mov_b32 %0, m0\n\ts_mov_b32 m0, %2\n\ts_nop 0\n\tglobal_load_lds_dwordx4 %1, off\n\ts_mov_b32 m0, %0" : "=&s"(keep) : "v"(gsrc), "s"(lds_dst) : "memory"); }
__device__ __forceinline__ void glds4(const void* gsrc, unsigned lds_dst) { unsigned keep;
    asm volatile("s_mov_b32 %0, m0\n\ts_mov_b32 m0, %2\n\ts_nop 0\n\tglobal_load_lds_dword %1, off\n\ts_mov_b32 m0, %0" : "=&s"(keep) : "v"(gsrc), "s"(lds_dst) : "memory"); }
template <bool HAS_CK>
__device__ __forceinline__ void ring_issue(LAS char* lds, int slot, const bf16_t* Kg, const bf16_t* Vg, int pitch, int key0, const float* ckg, int wid, int lane) {
    const unsigned l0 = (unsigned)(uintptr_t)lds;
    { const int krow = 8 * wid + (lane >> 3);
      glds16(Kg + (size_t)(key0 + krow) * pitch + ((lane & 7) ^ ((krow >> 1) & 7)) * 8, (unsigned)__builtin_amdgcn_readfirstlane((int)(l0 + L_K + slot * 8192 + wid * 1024))); }
    { const int vrow = 8 * wid + (lane >> 3);
      glds16(Vg + (size_t)(key0 + vrow) * pitch + ((lane & 7) ^ (4 * ((vrow >> 1) & 1))) * 8, (unsigned)__builtin_amdgcn_readfirstlane((int)(l0 + L_V + slot * 8192 + wid * 1024))); }
    if (HAS_CK) glds4(ckg + key0 + lane, (unsigned)__builtin_amdgcn_readfirstlane((int)(l0 + L_CK + (slot * 8 + wid) * 256)));
}
#define RING_WAIT_BAR(N) asm volatile("s_waitcnt vmcnt(%0) lgkmcnt(0)\n\ts_barrier" :: "i"(N) : "memory")
#define SCHED_FENCE() __builtin_amdgcn_sched_barrier(0)
__device__ __forceinline__ void kfrag_load(bf16x8 (&kf)[8], const LAS char* kb, int r32, int hi) {
    const int sw = (r32 >> 1) & 7;
#pragma unroll
    for (int d0 = 0; d0 < 4; ++d0) { const int ch = ((2 * d0 + hi) ^ sw) * 16; kf[2 * d0] = *(const LAS bf16x8*)(kb + r32 * 128 + ch); kf[2 * d0 + 1] = *(const LAS bf16x8*)(kb + (r32 + 32) * 128 + ch); }
}
__device__ __forceinline__ void qk_mma(f32x16& p0, f32x16& p1, const bf16x8 (&kf)[8], const bf16x8 (&qf)[4]) {
#pragma unroll
    for (int d0 = 0; d0 < 4; ++d0) { p0 = __builtin_amdgcn_mfma_f32_32x32x16_bf16(kf[2 * d0], qf[d0], p0, 0, 0, 0); p1 = __builtin_amdgcn_mfma_f32_32x32x16_bf16(kf[2 * d0 + 1], qf[d0], p1, 0, 0, 0); }
}
__device__ __forceinline__ void qk_mma_c(f32x16& p0, f32x16& p1, const f32x16& cinit, const bf16x8 (&kf)[8], const bf16x8 (&qf)[4]) {
    p0 = __builtin_amdgcn_mfma_f32_32x32x16_bf16(kf[0], qf[0], cinit, 0, 0, 0); p1 = __builtin_amdgcn_mfma_f32_32x32x16_bf16(kf[1], qf[0], cinit, 0, 0, 0);
#pragma unroll
    for (int d0 = 1; d0 < 4; ++d0) { p0 = __builtin_amdgcn_mfma_f32_32x32x16_bf16(kf[2 * d0], qf[d0], p0, 0, 0, 0); p1 = __builtin_amdgcn_mfma_f32_32x32x16_bf16(kf[2 * d0 + 1], qf[d0], p1, 0, 0, 0); }
}
__device__ __forceinline__ void vfrag_load(s16x4 (&vlo)[8], s16x4 (&vhi)[8], const LAS char* vb, int lane, int hi) {
    const int x = ((lane >> 3) & 1) * 64;
    const LAS char* vq = vb + (4 * hi + ((lane & 15) >> 2)) * 128 + ((lane >> 4) & 1) * 32 + (lane & 3) * 8;
    const LAS char* v0 = vq + x; const LAS char* v1 = vq + (64 ^ x);
#pragma unroll
    for (int ks = 0; ks < 4; ++ks) { vlo[ks] = vtr(v0 + ks * 2048); vhi[ks] = vtr(v0 + ks * 2048 + 1024); vlo[4 + ks] = vtr(v1 + ks * 2048); vhi[4 + ks] = vtr(v1 + ks * 2048 + 1024); }
}
typedef __bf16 bf16v2 __attribute__((ext_vector_type(2)));
__device__ __forceinline__ unsigned pkbf(float lo, float hi) { const f32x2 v = {lo, hi}; return __builtin_bit_cast(unsigned, __builtin_convertvector(v, bf16v2)); }
__device__ __forceinline__ void pv_mma(f32x16 (&o)[2], const f32x16& p0, const f32x16& p1, const s16x4 (&vlo)[8], const s16x4 (&vhi)[8]) {
    u32x4 pa[4];
#pragma unroll
    for (int i = 0; i < 4; ++i) { pa[0][i] = pkbf(p0[2 * i], p0[2 * i + 1]); pa[1][i] = pkbf(p0[8 + 2 * i], p0[8 + 2 * i + 1]);
                                  pa[2][i] = pkbf(p1[2 * i], p1[2 * i + 1]); pa[3][i] = pkbf(p1[8 + 2 * i], p1[8 + 2 * i + 1]); }
    LDS_WAIT(); SCHED_FENCE();
#pragma unroll
    for (int d0 = 0; d0 < 2; ++d0)
#pragma unroll
        for (int ks = 0; ks < 4; ++ks) {
            const s16x4 lo = vlo[4 * d0 + ks], hh = vhi[4 * d0 + ks];
            const bf16x8 vf = __builtin_shufflevector(lo, hh, 0, 1, 2, 3, 4, 5, 6, 7);
            o[d0] = __builtin_amdgcn_mfma_f32_32x32x16_bf16(__builtin_bit_cast(bf16x8, pa[ks]), vf, o[d0], 0, 0, 0);
        }
}
__device__ __forceinline__ void pv_mma_m(f32x16 (&o)[2], const f32x16& p0, const f32x16& p1, const s16x4 (&vlo)[8], const s16x4 (&vhi)[8], unsigned mw) {
    u32x4 pa[4];
#pragma unroll
    for (int i = 0; i < 4; ++i) { pa[0][i] = pkbf(p0[2 * i], p0[2 * i + 1]) & mw; pa[1][i] = pkbf(p0[8 + 2 * i], p0[8 + 2 * i + 1]) & mw;
                                  pa[2][i] = pkbf(p1[2 * i], p1[2 * i + 1]) & mw; pa[3][i] = pkbf(p1[8 + 2 * i], p1[8 + 2 * i + 1]) & mw; }
    LDS_WAIT(); SCHED_FENCE();
#pragma unroll
    for (int d0 = 0; d0 < 2; ++d0)
#pragma unroll
        for (int ks = 0; ks < 4; ++ks) {
            const s16x4 lo = vlo[4 * d0 + ks], hh = vhi[4 * d0 + ks];
            const bf16x8 vf = __builtin_shufflevector(lo, hh, 0, 1, 2, 3, 4, 5, 6, 7);
            o[d0] = __builtin_amdgcn_mfma_f32_32x32x16_bf16(__builtin_bit_cast(bf16x8, pa[ks]), vf, o[d0], 0, 0, 0);
        }
}
#define TILE_QK(p0, p1, kb, vb) \
    bf16x8 kf_[8]; s16x4 vlo_[8], vhi_[8]; \
    kfrag_load(kf_, (kb), r32, hi); LDS_WAIT(); SCHED_FENCE(); \
    qk_mma(p0, p1, kf_, qf); SCHED_FENCE(); \
    vfrag_load(vlo_, vhi_, (vb), lane, hi); SCHED_FENCE(); \
    exp_sum(p0, p1);
#define TILE_PV(o, p0, p1) pv_mma(o, p0, p1, vlo_, vhi_); SCHED_FENCE();
#define TILE_QK_C(p0, p1, cinit, kb, vb) \
    bf16x8 kf_[8]; s16x4 vlo_[8], vhi_[8]; \
    kfrag_load(kf_, (kb), r32, hi); LDS_WAIT(); SCHED_FENCE(); \
    qk_mma_c(p0, p1, cinit, kf_, qf); SCHED_FENCE(); \
    vfrag_load(vlo_, vhi_, (vb), lane, hi); SCHED_FENCE(); \
    exp_sum(p0, p1);
#define QK_ONLY(p0, p1, kb) { bf16x8 kf_[8]; kfrag_load(kf_, (kb), r32, hi); LDS_WAIT(); SCHED_FENCE(); qk_mma(p0, p1, kf_, qf); SCHED_FENCE(); } exp_sum(p0, p1);
#define PV_ONLY(o, p0, p1, vb) { s16x4 vlo_[8], vhi_[8]; vfrag_load(vlo_, vhi_, (vb), lane, hi); pv_mma(o, p0, p1, vlo_, vhi_); SCHED_FENCE(); }
#define HALF_BAR() asm volatile("s_waitcnt lgkmcnt(0)\n\ts_barrier" ::: "memory")
__device__ __forceinline__ void exp_sum(f32x16& p0, f32x16& p1) {
#pragma unroll
    for (int r = 0; r < 16; ++r) { p0[r] = __builtin_amdgcn_exp2f(p0[r]); p1[r] = __builtin_amdgcn_exp2f(p1[r]); }
}
#define OPQ(x) asm("" : "+v"(x))
__device__ __forceinline__ float psum(const f32x16& p0, const f32x16& p1) {
    float s0 = p0[0], s1 = p1[0], s2 = p0[8], s3 = p1[8];
#pragma unroll
    for (int r = 1; r < 8; ++r) { s0 += p0[r]; OPQ(s0); s1 += p1[r]; OPQ(s1); s2 += p0[r + 8]; OPQ(s2); s3 += p1[r + 8]; OPQ(s3); }
    s0 += s2; OPQ(s0); s1 += s3; OPQ(s1);
    return s0 + s1;
}
__device__ __forceinline__ void p_pack(u32x4 (&pa)[4], const f32x16& p0, const f32x16& p1) {
#pragma unroll
    for (int i = 0; i < 4; ++i) { pa[0][i] = pkbf(p0[2 * i], p0[2 * i + 1]); pa[1][i] = pkbf(p0[8 + 2 * i], p0[8 + 2 * i + 1]); pa[2][i] = pkbf(p1[2 * i], p1[2 * i + 1]); pa[3][i] = pkbf(p1[8 + 2 * i], p1[8 + 2 * i + 1]); }
}
__device__ __forceinline__ void pv_mma_p(f32x16 (&o)[2], const u32x4 (&pa)[4], const s16x4 (&vlo)[8], const s16x4 (&vhi)[8]) {
#pragma unroll
    for (int ks = 0; ks < 4; ++ks)
#pragma unroll
        for (int d0 = 0; d0 < 2; ++d0) {
            const bf16x8 vf = __builtin_shufflevector(vlo[4 * d0 + ks], vhi[4 * d0 + ks], 0, 1, 2, 3, 4, 5, 6, 7);
            o[d0] = __builtin_amdgcn_mfma_f32_32x32x16_bf16(__builtin_bit_cast(bf16x8, pa[ks]), vf, o[d0], 0, 0, 0);
        }
}
#define SG_PAIR(nv) do { _Pragma("unroll") for (int g_ = 0; g_ < 8; ++g_) { __builtin_amdgcn_sched_group_barrier(0x008, 1, 0); __builtin_amdgcn_sched_group_barrier(0x402, (nv), 0); } } while (0)
__device__ __forceinline__ void rows_from_cols(float s, LAS float* wsf, int r32, int hi, float (&out)[16]) {
    LDS_WAIT();
    if (hi == 0) wsf[r32] = s;
    LDS_WAIT();
#pragma unroll
    for (int m = 0; m < 4; ++m) { const f32x4 t = *(const LAS f32x4*)(wsf + 8 * m + 4 * hi); out[4 * m] = t[0]; out[4 * m + 1] = t[1]; out[4 * m + 2] = t[2]; out[4 * m + 3] = t[3]; }
    LDS_WAIT();
}

__device__ __forceinline__ void fox_unit(LAS char* lds, int b, int h, int qb, const bf16_t* Q, const bf16_t* K, const bf16_t* V, bf16_t* O, const float* CUM, float M2, int wv_) {
    int tid_ = (wv_ << 6) | lane_local(); asm volatile("" : "+v"(tid_));
    const int tid = tid_, lane = tid & 63, r32 = lane & 31, hi = lane >> 5, wid = __builtin_amdgcn_readfirstlane(tid >> 6);
    const int q0 = qb * 256, qpos = q0 + 32 * wid + r32;
    const size_t rowbase = (size_t)b * SEQ;
    const bf16_t* Kg = K + rowbase * DM + h * HD; const bf16_t* Vg = V + rowbase * DM + h * HD;
    const float* ckg = CUM + (size_t)(b * NH + h) * SEQ;
    const int NT = (q0 + 256) / 64;
    ring_issue<true>(lds, 0, Kg, Vg, DM, 64 * (NT - 2), ckg, wid, lane); ring_issue<true>(lds, 1, Kg, Vg, DM, 64 * (NT - 1), ckg, wid, lane);
    ring_issue<true>(lds, 2, Kg, Vg, DM, 64 * (NT - 4), ckg, wid, lane); ring_issue<true>(lds, 3, Kg, Vg, DM, 64 * (NT - 3), ckg, wid, lane);
    bf16x8 qf[4];
    { const bf16_t* qp = Q + (rowbase + qpos) * DM + h * HD;
#pragma unroll
      for (int d0 = 0; d0 < 4; ++d0) qf[d0] = *(const bf16x8*)(qp + d0 * 16 + hi * 8); }
    const float cq = ckg[qpos] - M2;
    f32x16 o[2]; o[0] = (f32x16){}; o[1] = (f32x16){}; float lsum = 0.f;
    const int wave_last = (q0 + 32 * wid + 31) >> 6;
    int t0 = 0;
    { const float c0 = ckg[q0];
      int t = NT - 5;
#pragma unroll 1
      for (int base = NT - 5; base >= 0; base -= 64) {
          const int tt = base - lane; const float ce = ckg[64 * (tt >= 0 ? tt : 0) + 63]; const float lim = c0 + (46.f + 2.f * M2); const bool skip = (tt >= 0) && (ce > lim);
          const unsigned long long bm = __ballot(skip);
          if (bm) { t = base - (int)__builtin_ctzll(bm); break; }
          t = base - 64;
      }
      t0 = __builtin_amdgcn_readfirstlane(t < 0 ? 0 : t + 1); }
#define FOX_TILE(t_, slot_) do { if ((t_) <= wave_last) { \
            f32x16 p0, p1; \
            const LAS float* ck = (const LAS float*)(lds + L_CK + ((slot_) * 8 + wid) * 256); \
            _Pragma("unroll") for (int m = 0; m < 4; ++m) { const f32x4 a = *(const LAS f32x4*)(ck + 8 * m + 4 * hi), c = *(const LAS f32x4*)(ck + 32 + 8 * m + 4 * hi); \
                _Pragma("unroll") for (int j = 0; j < 4; ++j) { p0[4 * m + j] = cq - a[j]; p1[4 * m + j] = cq - c[j]; } } \
            TILE_QK(p0, p1, lds + L_K + (slot_) * 8192, lds + L_V + (slot_) * 8192) \
            if (64 * (t_) + 63 > q0 + 32 * wid) { const int kb = 64 * (t_) + 4 * hi; \
                _Pragma("unroll") for (int r = 0; r < 16; ++r) { const int kv = kb + (r & 3) + 8 * (r >> 2); if (kv > qpos) p0[r] = 0.f; if (kv + 32 > qpos) p1[r] = 0.f; } } \
            lsum += psum(p0, p1); \
            TILE_PV(o, p0, p1) } } while (0)
#define FOX_INIT(p0, p1, slot_) do { const LAS float* ck = (const LAS float*)(lds + L_CK + ((slot_) * 8 + wid) * 256); \
            _Pragma("unroll") for (int m = 0; m < 4; ++m) { const f32x4 a = *(const LAS f32x4*)(ck + 8 * m + 4 * hi), c = *(const LAS f32x4*)(ck + 32 + 8 * m + 4 * hi); \
                _Pragma("unroll") for (int j = 0; j < 4; ++j) { p0[4 * m + j] = cq - a[j]; p1[4 * m + j] = cq - c[j]; } } } while (0)
#define FOX_PAIR(sa, sb) do { \
            f32x16 a0, a1, b0, b1; u32x4 pa[4], pb[4]; \
            { bf16x8 kfa[8]; FOX_INIT(a0, a1, sa); kfrag_load(kfa, lds + L_K + (sa) * 8192, r32, hi); LDS_WAIT(); SCHED_FENCE(); \
              qk_mma(a0, a1, kfa, qf); SCHED_FENCE(); } \
            { bf16x8 kfb[8]; s16x4 val[8], vah[8]; \
              FOX_INIT(b0, b1, sb); kfrag_load(kfb, lds + L_K + (sb) * 8192, r32, hi); LDS_WAIT(); SCHED_FENCE(); \
              vfrag_load(val, vah, lds + L_V + (sa) * 8192, lane, hi); SCHED_FENCE(); \
              qk_mma(b0, b1, kfb, qf); exp_sum(a0, a1); lsum += psum(a0, a1); p_pack(pa, a0, a1); SCHED_FENCE(); \
              LDS_WAIT(); SCHED_FENCE(); \
              pv_mma_p(o, pa, val, vah); exp_sum(b0, b1); lsum += psum(b0, b1); p_pack(pb, b0, b1); SCHED_FENCE(); } \
            { s16x4 vbl[8], vbh[8]; vfrag_load(vbl, vbh, lds + L_V + (sb) * 8192, lane, hi); LDS_WAIT(); SCHED_FENCE(); \
              pv_mma_p(o, pb, vbl, vbh); SCHED_FENCE(); } } while (0)
    int sp = 0;
#pragma unroll 1
    for (int ta = NT - 2; ta + 1 >= t0; ta -= 2) {
        RING_WAIT_BAR(0);
        if (ta != NT - 2) {
            const int na = ta - 2;
            if (na + 1 >= t0) { if (na >= t0) ring_issue<true>(lds, 2 * (sp ^ 1), Kg, Vg, DM, 64 * na, ckg, wid, lane);
                                ring_issue<true>(lds, 2 * (sp ^ 1) + 1, Kg, Vg, DM, 64 * (na + 1), ckg, wid, lane); }
        }
        if (ta >= t0 && ta + 1 < wave_last) { FOX_PAIR(2 * sp, 2 * sp + 1); }
        else { if (ta >= t0) FOX_TILE(ta, 2 * sp);
               FOX_TILE(ta + 1, 2 * sp + 1); }
        sp ^= 1;
    }
#undef FOX_TILE
#undef FOX_PAIR
#undef FOX_INIT
    RING_WAIT_BAR(0);
    lsum += __shfl_xor(lsum, 32);
    float sc[16];
    rows_from_cols(1.f / lsum, (LAS float*)(lds + L_WSF) + wid * 64, r32, hi, sc);
    { LAS bf16_t* stg = (LAS bf16_t*)(lds + wid * 4096);
#pragma unroll
      for (int r = 0; r < 16; ++r) { const int q = crow(r, hi); stg[q * 64 + r32] = (bf16_t)f2bf(o[0][r] * sc[r]); stg[q * 64 + 32 + r32] = (bf16_t)f2bf(o[1][r] * sc[r]); }
      LDS_WAIT();
      bf16_t* Ow = O + (rowbase + q0 + 32 * wid) * DM + h * HD;
#pragma unroll
      for (int i = 0; i < 4; ++i) { const int rw = (lane >> 3) + 8 * i, ch = lane & 7; const u32x4 v = *(const LAS u32x4*)(stg + rw * 64 + ch * 8); *(u32x4*)(Ow + (size_t)rw * DM + ch * 8) = v; } }
    __syncthreads();
}

struct NsaArgs { const bf16_t *QP, *QR, *KCMP, *VCMP, *KSEL, *VSEL, *KWIN, *VWIN; const float* GATES; bf16_t* O; float Mcmp, Msel, Mwin; };

__device__ __forceinline__ int next_bit4(unsigned u0, unsigned u1, unsigned u2, unsigned u3, int from) {
    if (from >= 128) return 128;
    const int w = from >> 5; const unsigned mlow = ~0u << (from & 31);
    unsigned x;
    x = (w == 0) ? (u0 & mlow) : 0u;                         if (x) return __builtin_ctz(x);
    x = (w == 1) ? (u1 & mlow) : (w < 1 ? u1 : 0u);          if (x) return 32 + __builtin_ctz(x);
    x = (w == 2) ? (u2 & mlow) : (w < 2 ? u2 : 0u);          if (x) return 64 + __builtin_ctz(x);
    x = (w == 3) ? (u3 & mlow) : (w < 3 ? u3 : 0u);          if (x) return 96 + __builtin_ctz(x);
    return 128;
}

__device__ __forceinline__ void nsa_unit(LAS char* lds, int b, int g, int c, const NsaArgs& A, int wv_) {
    int tid_ = (wv_ << 6) | lane_local(); asm volatile("" : "+v"(tid_));
    const int tid = tid_, lane = tid & 63, r32 = lane & 31, hi = lane >> 5, wid = __builtin_amdgcn_readfirstlane(tid >> 6);
    const int q0 = 64 * c, ti = 8 * wid + (r32 >> 2);
    const int head = 4 * g + (r32 & 3);
    const size_t row = (size_t)b * SEQ + q0 + ti;
    LAS float* wsf = (LAS float*)(lds + L_WSF) + wid * 64;

    LAS float* osl = (LAS float*)(lds + L_OS) + wid * 2048 + lane;

    unsigned mw0 = 0u, mw1 = 0u, mw2 = 0u, mw3 = 0u;
    const float gate_c = A.GATES[row * 48 + head * 3 + 0], gate_s = A.GATES[row * 48 + head * 3 + 1], gate_w = A.GATES[row * 48 + head * 3 + 2];
    bf16x8 qf[4];
    { const bf16_t* qp = A.QR + row * DM + head * HD;
#pragma unroll
      for (int d0 = 0; d0 < 4; ++d0) qf[d0] = *(const bf16x8*)(qp + d0 * 16 + hi * 8); }
    {
        bf16x8 qfp[4];
        { const bf16_t* qp = A.QP + row * DM + head * HD;
#pragma unroll
          for (int d0 = 0; d0 < 4; ++d0) qfp[d0] = *(const bf16x8*)(qp + d0 * 16 + hi * 8); }
        const bf16_t* Kg = A.KCMP + (size_t)b * NCMPB * 256 + g * HD; const bf16_t* Vg = A.VCMP + (size_t)b * NCMPB * 256 + g * HD;
        const int nvis = (q0 + ti + 1) >> 6;
        const int ntl = (c + 1 > 64) ? 2 : 1;
        { const bf16_t* Kw = A.KWIN + (size_t)b * SEQ * 256 + g * HD; const bf16_t* Vw = A.VWIN + (size_t)b * SEQ * 256 + g * HD; const int tlo = c >= 8 ? c - 8 : 0;
          ring_issue<false>(lds, 2, Kw, Vw, 256, 64 * tlo, nullptr, wid, lane);
          if (tlo + 1 <= c) ring_issue<false>(lds, 3, Kw, Vw, 256, 64 * (tlo + 1), nullptr, wid, lane); }
        ring_issue<false>(lds, 0, Kg, Vg, 256, 0, nullptr, wid, lane);
        if (ntl == 2) ring_issue<false>(lds, 1, Kg, Vg, 256, 64, nullptr, wid, lane);
        RING_WAIT_BAR(0);
        float lsum = 0.f;
#pragma unroll 1
        for (int t = 0; t < ntl; ++t) {
            f32x16 p0, p1;
#pragma unroll
            for (int r = 0; r < 16; ++r) { p0[r] = -A.Mcmp; p1[r] = -A.Mcmp; }
            { bf16x8 kf_[8]; kfrag_load(kf_, lds + L_K + t * 8192, r32, hi); LDS_WAIT(); SCHED_FENCE(); qk_mma(p0, p1, kf_, qfp); SCHED_FENCE(); }
            exp_sum(p0, p1);
#pragma unroll
            for (int r = 0; r < 16; ++r) { const int n = 64 * t + crow(r, hi); if (n >= nvis) p0[r] = 0.f; if (n + 32 >= nvis) p1[r] = 0.f; }
            lsum += psum(p0, p1);
        }
        lsum += __shfl_xor(lsum, 32);
        const float inv = lsum > 0.f ? 1.f / lsum : 0.f;
        const int k4 = lane & 3;
        unsigned keys[16];
#pragma unroll
        for (int i = 0; i < 16; ++i) keys[i] = 0u;
        f32x16 o[2]; o[0] = (f32x16){}; o[1] = (f32x16){};
#pragma unroll
        for (int t = 0; t < 2; ++t) {
            if (t < ntl) {
                f32x16 p0, p1;
#pragma unroll
                for (int r = 0; r < 16; ++r) { p0[r] = -A.Mcmp; p1[r] = -A.Mcmp; }
                bf16x8 kf_[8]; s16x4 vlo_[8], vhi_[8];
                kfrag_load(kf_, lds + L_K + t * 8192, r32, hi); LDS_WAIT(); SCHED_FENCE();
                qk_mma(p0, p1, kf_, qfp); SCHED_FENCE();
                vfrag_load(vlo_, vhi_, lds + L_V + t * 8192, lane, hi); SCHED_FENCE();
                exp_sum(p0, p1);
#pragma unroll
                for (int r = 0; r < 16; ++r) { const int n = 64 * t + crow(r, hi); if (n >= nvis) p0[r] = 0.f; if (n + 32 >= nvis) p1[r] = 0.f; }
                TILE_PV(o, p0, p1)
#pragma unroll
                for (int jj = 0; jj < 2; ++jj)
#pragma unroll
                    for (int m4 = 0; m4 < 4; ++m4) {
                        const float v0 = (jj ? p1[4 * m4] : p0[4 * m4]) * inv, v1 = (jj ? p1[4 * m4 + 1] : p0[4 * m4 + 1]) * inv, v2 = (jj ? p1[4 * m4 + 2] : p0[4 * m4 + 2]) * inv, v3 = (jj ? p1[4 * m4 + 3] : p0[4 * m4 + 3]) * inv;
                        const float s01 = (k4 & 1) ? v0 : v1, k01 = (k4 & 1) ? v1 : v0; const float a01 = k01 + dppx1f(s01);
                        const float s23 = (k4 & 1) ? v2 : v3, k23 = (k4 & 1) ? v3 : v2; const float a23 = k23 + dppx1f(s23);
                        const float s2 = (k4 & 2) ? a01 : a23, k2 = (k4 & 2) ? a23 : a01; const float imp = k2 + dppx2f(s2);
                        const int j = 2 * t + jj;
                        const int n = 32 * j + 8 * m4 + 4 * hi + k4;
                        const bool valid = (n >= 1) && (n <= c - 2);
                        keys[4 * j + m4] = valid ? ((__float_as_uint(imp) & ~127u) | (unsigned)(127 - n) | 0x80000000u) : 0u;
                    }
            }
        }
        { float sc[16]; rows_from_cols(inv * gate_c, wsf, r32, hi, sc);
#pragma unroll
          for (int r = 0; r < 16; ++r) { osl[r * 64] = o[0][r] * sc[r]; osl[(16 + r) * 64] = o[1][r] * sc[r]; } }
        if (c + 1 <= 16) {
            mw0 = (1u << (c + 1)) - 1u;
        } else {
#pragma unroll 1
            for (int round = 0; round < 13; ++round) {
                unsigned mx = keys[0];
#pragma unroll
                for (int i = 1; i < 16; ++i) mx = mx > keys[i] ? mx : keys[i];
                { const unsigned t1 = (unsigned)dppx1((int)mx); mx = mx > t1 ? mx : t1; }
                { const unsigned t2 = (unsigned)dppx2((int)mx); mx = mx > t2 ? mx : t2; }
                { const auto rr = __builtin_amdgcn_permlane32_swap(mx, mx, false, false); const unsigned t3 = rr[0] > rr[1] ? rr[0] : rr[1]; mx = mx > t3 ? mx : t3; }
#pragma unroll
                for (int i = 0; i < 16; ++i) keys[i] = (keys[i] == mx) ? 0u : keys[i];
            }
#pragma unroll
            for (int j = 0; j < 4; ++j) {
                unsigned wbits = 0u;
#pragma unroll
                for (int m4 = 0; m4 < 4; ++m4) {
                    const int n = 32 * j + 8 * m4 + 4 * hi + k4;
                    const bool valid = (n >= 1) && (n <= c - 2);
                    if (valid && keys[4 * j + m4] == 0u) wbits |= 1u << (8 * m4 + 4 * hi + k4);
                }
                wbits |= (unsigned)dppx1((int)wbits); wbits |= (unsigned)dppx2((int)wbits); wbits |= (unsigned)__shfl_xor((int)wbits, 32);
                if (j == 0) mw0 = wbits; else if (j == 1) mw1 = wbits; else if (j == 2) mw2 = wbits; else mw3 = wbits;
            }
            mw0 |= 1u;
            { const int n = c - 1; const unsigned bt = 1u << (n & 31); if ((n >> 5) == 0) mw0 |= bt; else if ((n >> 5) == 1) mw1 |= bt; else if ((n >> 5) == 2) mw2 |= bt; else mw3 |= bt; }
            { const int n = c;     const unsigned bt = 1u << (n & 31); if ((n >> 5) == 0) mw0 |= bt; else if ((n >> 5) == 1) mw1 |= bt; else if ((n >> 5) == 2) mw2 |= bt; else mw3 |= bt; }
        }
    }
    __syncthreads();
    {
        const bf16_t* Kg = A.KWIN + (size_t)b * SEQ * 256 + g * HD; const bf16_t* Vg = A.VWIN + (size_t)b * SEQ * 256 + g * HD;
        const int tlo = c >= 8 ? c - 8 : 0;
        f32x16 o[2]; o[0] = (f32x16){}; o[1] = (f32x16){}; float lsum = 0.f;
        f32x16 negm;
        { float mv_ = -A.Mwin; asm volatile("" : "+v"(mv_));
#pragma unroll
          for (int r = 0; r < 16; ++r) negm[r] = mv_; }
#define WIN_TILE(t_, slot_) do { f32x16 p0, p1; \
            TILE_QK_C(p0, p1, negm, lds + L_K + (slot_) * 8192, lds + L_V + (slot_) * 8192) \
            if ((t_) == c) { _Pragma("unroll") for (int r = 0; r < 16; ++r) { const int kl = crow(r, hi); if (kl > ti) p0[r] = 0.f; if (kl + 32 > ti) p1[r] = 0.f; } } \
            else if ((t_) == c - 8) { _Pragma("unroll") for (int r = 0; r < 16; ++r) { const int kl = crow(r, hi); if (kl <= ti) p0[r] = 0.f; if (kl + 32 <= ti) p1[r] = 0.f; } } \
            lsum += psum(p0, p1); \
            TILE_PV(o, p0, p1) } while (0)
        int sp = 1;
#pragma unroll 1
        for (int t = tlo; t <= c; t += 2) {
            RING_WAIT_BAR(0);
            if (t + 2 <= c) ring_issue<false>(lds, 2 * (sp ^ 1), Kg, Vg, 256, 64 * (t + 2), nullptr, wid, lane);
            if (t + 3 <= c) ring_issue<false>(lds, 2 * (sp ^ 1) + 1, Kg, Vg, 256, 64 * (t + 3), nullptr, wid, lane);
            WIN_TILE(t, 2 * sp);
            if (t + 1 <= c) WIN_TILE(t + 1, 2 * sp + 1);
            sp ^= 1;
        }
        RING_WAIT_BAR(0);
#undef WIN_TILE
        lsum += __shfl_xor(lsum, 32);
        float sc[16]; rows_from_cols(gate_w / lsum, wsf, r32, hi, sc);
#pragma unroll
        for (int r = 0; r < 16; ++r) { osl[r * 64] += o[0][r] * sc[r]; osl[(16 + r) * 64] += o[1][r] * sc[r]; }
    }
    {
        f32x16 o[2]; o[0] = (f32x16){}; o[1] = (f32x16){}; float lsum = 0.f;
        f32x16 negm;
        { float mv_ = -A.Msel; asm volatile("" : "+v"(mv_));
#pragma unroll
          for (int r = 0; r < 16; ++r) negm[r] = mv_; }
        const bf16_t* Kb = A.KSEL + (size_t)(b * NCMPB) * NG * 4096 + g * 4096; const bf16_t* Vb = A.VSEL + (size_t)(b * NCMPB) * NG * 4096 + g * 4096;
        unsigned U0 = mw0, U1 = mw1, U2 = mw2, U3 = mw3;
#pragma unroll
        for (int s = 4; s <= 16; s <<= 1) { U0 |= (unsigned)__shfl_xor((int)U0, s); U1 |= (unsigned)__shfl_xor((int)U1, s); U2 |= (unsigned)__shfl_xor((int)U2, s); U3 |= (unsigned)__shfl_xor((int)U3, s); }
        U0 = __builtin_amdgcn_readfirstlane(U0); U1 = __builtin_amdgcn_readfirstlane(U1); U2 = __builtin_amdgcn_readfirstlane(U2); U3 = __builtin_amdgcn_readfirstlane(U3);
        bf16x8 kf[8], vf[8];
#define SEL_LOADK(n_) do { const bf16_t* kp = Kb + (size_t)(n_) * (NG * 4096) + (hi * 64 + r32) * 8; \
            _Pragma("unroll") for (int d0 = 0; d0 < 4; ++d0) { kf[2 * d0] = *(const bf16x8*)(kp + d0 * 1024); kf[2 * d0 + 1] = *(const bf16x8*)(kp + d0 * 1024 + 256); } } while (0)
#define SEL_LOADV(n_) do { const bf16_t* vp = Vb + (size_t)(n_) * (NG * 4096) + (hi * 32 + r32) * 8; \
            _Pragma("unroll") for (int ks = 0; ks < 4; ++ks) _Pragma("unroll") for (int d0 = 0; d0 < 2; ++d0) vf[2 * ks + d0] = *(const bf16x8*)(vp + (ks * 2 + d0) * 512); } while (0)
        LAS unsigned char* blist = (LAS unsigned char*)(lds + L_CK + wid * 256);
        { const unsigned b0 = ((lane < 32 ? U0 : U1) >> (lane & 31)) & 1u, b1 = ((lane < 32 ? U2 : U3) >> (lane & 31)) & 1u;
          const int c01 = __builtin_popcount(U0) + __builtin_popcount(U1), c23 = __builtin_popcount(U2) + __builtin_popcount(U3);
          const int p0_ = (int)__builtin_amdgcn_mbcnt_hi(U1, __builtin_amdgcn_mbcnt_lo(U0, 0u)), p1_ = c01 + (int)__builtin_amdgcn_mbcnt_hi(U3, __builtin_amdgcn_mbcnt_lo(U2, 0u));
          if (b0) blist[p0_] = (unsigned char)lane;
          if (b1) blist[p1_] = (unsigned char)(64 + lane);
          if (lane < 4) blist[c01 + c23 + lane] = 255; }
        int n = __builtin_amdgcn_readfirstlane((int)blist[0]), n2 = __builtin_amdgcn_readfirstlane((int)blist[1]);
        int li = 2; int nxv = (int)blist[2];
        SEL_LOADK(n); SEL_LOADV(n);
#pragma unroll 1
        while (n < 128) {
            const unsigned wn = (n >> 5) == 0 ? mw0 : (n >> 5) == 1 ? mw1 : (n >> 5) == 2 ? mw2 : mw3;
            const bool mine = (wn >> (n & 31)) & 1u;
            f32x16 p0, p1;
            qk_mma_c(p0, p1, negm, kf, qf); SCHED_FENCE();
            if (n2 < 128) SEL_LOADK(n2);
            SCHED_FENCE();
            exp_sum(p0, p1);
            if (n == c) {
#pragma unroll
                for (int r = 0; r < 16; ++r) { const int kl = crow(r, hi); if (kl > ti) p0[r] = 0.f; if (kl + 32 > ti) p1[r] = 0.f; }
            }
            const unsigned keepw = mine ? 0xffffffffu : 0u; const float keep = mine ? 1.f : 0.f;
            lsum += keep * psum(p0, p1);
            u32x4 pa[4];
#pragma unroll
            for (int i = 0; i < 4; ++i) { pa[0][i] = pkbf(p0[2 * i], p0[2 * i + 1]) & keepw; pa[1][i] = pkbf(p0[8 + 2 * i], p0[8 + 2 * i + 1]) & keepw;
                                          pa[2][i] = pkbf(p1[2 * i], p1[2 * i + 1]) & keepw; pa[3][i] = pkbf(p1[8 + 2 * i], p1[8 + 2 * i + 1]) & keepw; }
#pragma unroll
            for (int ks = 0; ks < 4; ++ks) { o[0] = __builtin_amdgcn_mfma_f32_32x32x16_bf16(__builtin_bit_cast(bf16x8, pa[ks]), vf[2 * ks], o[0], 0, 0, 0);
                                             o[1] = __builtin_amdgcn_mfma_f32_32x32x16_bf16(__builtin_bit_cast(bf16x8, pa[ks]), vf[2 * ks + 1], o[1], 0, 0, 0); }
            SCHED_FENCE();
            if (n2 < 128) SEL_LOADV(n2);
            SCHED_FENCE();
            n = n2; n2 = __builtin_amdgcn_readfirstlane(nxv); ++li; nxv = (int)blist[li];
        }
#undef SEL_LOADK
#undef SEL_LOADV
        lsum += __shfl_xor(lsum, 32);
        float sc[16]; rows_from_cols(gate_s / lsum, wsf, r32, hi, sc);
        bf16_t* Ob = A.O + ((size_t)b * SEQ + q0 + 8 * wid) * DM + 4 * g * HD;
        { LAS bf16_t* stg = (LAS bf16_t*)(lds + wid * 4096);
#pragma unroll
          for (int r = 0; r < 16; ++r) { const int q = crow(r, hi); stg[q * 64 + r32] = (bf16_t)f2bf(osl[r * 64] + o[0][r] * sc[r]); stg[q * 64 + 32 + r32] = (bf16_t)f2bf(osl[(16 + r) * 64] + o[1][r] * sc[r]); }
          LDS_WAIT();
#pragma unroll
          for (int i = 0; i < 4; ++i) { const int rw = (lane >> 3) + 8 * i, ch = lane & 7; const u32x4 v = *(const LAS u32x4*)(stg + rw * 64 + ch * 8);
              *(u32x4*)(Ob + (size_t)(rw >> 2) * DM + (rw & 3) * HD + ch * 8) = v; } }
    }
    __syncthreads();
}
}
struct Args { const float* in[N_IN]; float* out; unsigned char* ws; int ph_lo, ph_hi; };
#define AS4 __attribute__((address_space(4)))
typedef const float* const AS4* KIn;
struct Ctx {
    const int* pos; float* out; unsigned char* ws;
    LAS unsigned char* lds; unsigned* ctl; int tid, lane, wave, G, bid;
};

enum { MAP_ID = 0, MAP_HPERM = 1, MAP_IL8 = 2 };
template <int MAP> __device__ __forceinline__ int rowmap(int s) {
    if (MAP == MAP_HPERM) return (s & ~255) + 128 * ((s >> 5) & 1) + 32 * ((s >> 6) & 3) + (s & 31);
    if (MAP == MAP_IL8) return (s & ~255) + 128 * ((s >> 5) & 1) + 32 * ((s >> 6) & 3) + 8 * ((s >> 2) & 3) + 4 * ((s >> 4) & 1) + (s & 3);
    return s;
}
template <int MAP>
__device__ __forceinline__ void xitem64(const float* W, int ld, int sc0, int k0, bf16_t* WT, int Kd, int rowoff, int mapbase, LAS float* scr, int lane, bool probe_rep = false) {
    f32x4 v[16];
#pragma unroll
    for (int i = 0; i < 16; ++i) { const int kk = 4 * i + (lane >> 4);
        v[i] = *(const f32x4*)(W + (size_t)(k0 + kk) * ld + sc0 + 4 * (lane & 15)); }
#pragma unroll
    for (int i = 0; i < 16; ++i) { const int kk = 4 * i + (lane >> 4); *(LAS f32x4*)(scr + kk * 64 + 4 * ((lane & 15) ^ ((kk >> 3) & 7))) = v[i]; }
    LDS_WAIT(); asm volatile("" ::: "memory");
    const int c = lane & 7;
#pragma unroll
    for (int j = 0; j < 8; ++j) { const int n = (lane >> 3) + 8 * j; const LAS float* sp = scr + (8 * c) * 64 + 4 * ((n >> 2) ^ c) + (n & 3);
        u32x4 o; o.x = cvt_pk_bf16(sp[0 * 64], sp[1 * 64]); o.y = cvt_pk_bf16(sp[2 * 64], sp[3 * 64]); o.z = cvt_pk_bf16(sp[4 * 64], sp[5 * 64]); o.w = cvt_pk_bf16(sp[6 * 64], sp[7 * 64]);
        *(u32x4*)(WT + (size_t)(rowoff + rowmap<MAP>(mapbase + n)) * Kd + k0 + 8 * c) = o; }
    LDS_WAIT(); asm volatile("" ::: "memory");
}
template <int MAP>
__device__ __forceinline__ void conv_dense(Ctx& C, const float* src, int ld, int K, int N, bf16_t* dst, int gw, int ngw) {
    LAS float* scr = (LAS float*)(C.lds + C.wave * 16384);
    const int nkb = K / 64, nnb = N / 64;
    for (int it = gw; it < nkb * nnb; it += ngw) { const int kb = it / nnb, nb = it % nnb; xitem64<MAP>(src, ld, 64 * nb, 64 * kb, dst, K, 0, 64 * nb, scr, C.lane); }
}
template <int KT>
__device__ __forceinline__ void xsub64(const float* W, int ld, int sc0, int k0, LAS bf16_t* tile, int nt0, int k0t, int lane) {
    f32x4 v[16];
#pragma unroll
    for (int i = 0; i < 16; ++i) { const int kk = 4 * i + (lane >> 4); v[i] = *(const f32x4*)(W + (size_t)(k0 + kk) * ld + sc0 + 4 * (lane & 15)); }
#pragma unroll
    for (int i = 0; i < 16; ++i) { const int kt = k0t + 4 * i + (lane >> 4);
        const unsigned w01 = cvt_pk_bf16(v[i][0], v[i][1]), w23 = cvt_pk_bf16(v[i][2], v[i][3]);
#pragma unroll
        for (int j = 0; j < 4; ++j) { const int n = nt0 + 4 * (lane & 15) + j; const unsigned ww = (j < 2) ? w01 : w23;
            tile[n * KT + 8 * ((kt >> 3) ^ ((n >> 2) & 7)) + (kt & 7)] = (bf16_t)((j & 1) ? (ww >> 16) : (ww & 0xffffu)); } }
}
__device__ __forceinline__ void conv_experts(Ctx& C, const float* wg, const float* wu, const float* wd, int nexp, bf16_t* dgu, bf16_t* dd, int gw, int ngw, bool down_only = false) {
    (void)gw; (void)ngw;
    LAS bf16_t* tile = (LAS bf16_t*)C.lds;
    const int per_e = 8 + 4;
    const int w = C.wave, lane = C.lane;
    __syncthreads();
    for (int bi = C.bid; bi < nexp * per_e; bi += C.G) {
        const int e = bi / per_e, r = bi % per_e;
        if (r < 8 && down_only) continue;
        if (r < 8) {
            const int bj = r >> 2, kq = r & 3;
            const float* src = (bj ? wu : wg) + (size_t)e * DM * DEXP;
#pragma unroll 1
            for (int s2 = 0; s2 < 2; ++s2) { const int st = w + 8 * s2, nb = st >> 2, kb = st & 3;
                xsub64<256>(src, DEXP, 64 * nb, 256 * kq + 64 * kb, tile, 64 * nb, 64 * kb, lane); }
            __syncthreads();
            bf16_t* dst = dgu + (size_t)e * 512 * DM + 256 * kq;
#pragma unroll 8
            for (int i = 0; i < 16; ++i) { const int n = 32 * w + 2 * i + (lane >> 5), c8 = lane & 31;
                const u32x4 v = *(const LAS u32x4*)(tile + n * 256 + 8 * (c8 ^ ((n >> 2) & 7)));
                *(u32x4*)(dst + (size_t)(256 * (n >> 7) + 128 * bj + (n & 127)) * DM + 8 * c8) = v; }
            __syncthreads();
        } else {
            const int cg = r - 8;
            const float* src = wd + (size_t)e * DEXP * DM;
#pragma unroll 1
            for (int s2 = 0; s2 < 2; ++s2) { const int st = w + 8 * s2, nb = st >> 2, kb = st & 3;
                xsub64<256>(src, DM, 256 * cg + 64 * nb, 64 * kb, tile, 64 * nb, 64 * kb, lane); }
            __syncthreads();
            bf16_t* dst = dd + (size_t)e * DM * DEXP;
#pragma unroll 8
            for (int i = 0; i < 16; ++i) { const int n = 32 * w + 2 * i + (lane >> 5), c8 = lane & 31;
                const u32x4 v = *(const LAS u32x4*)(tile + n * 256 + 8 * (c8 ^ ((n >> 2) & 7)));
                *(u32x4*)(dst + (size_t)rowmap<MAP_IL8>(256 * cg + n) * DEXP + 8 * c8) = v; }
            __syncthreads();
        }
    }
}

struct CvAddr { const float* s; u32x4* d[4]; int ld; };
__device__ __forceinline__ void cv_addr(CvAddr& a, int t, int ngu, const float* wg, const float* wu, const float* wd, bf16_t* dgu, bf16_t* dd, int lane) {
    if (t < ngu) { const int e = t >> 8, bj = (t >> 7) & 1, k8 = t & 127;
        a.s = (bj ? wu : wg) + (size_t)e * DM * DEXP + (size_t)(8 * k8) * DEXP + lane; a.ld = DEXP;
        u32x4* db = (u32x4*)((unsigned char*)dgu + (size_t)e * 512 * DM + 8 * (k8 & 1)) + ((k8 >> 1) * 512 + 128 * bj + lane);
#pragma unroll
        for (int i = 0; i < 4; ++i) a.d[i] = db + 256 * (i >> 1) + 64 * (i & 1); }
    else { const int r = t - ngu, e = r >> 7, k8 = (r >> 2) & 31, cg = r & 3;
        a.s = wd + (size_t)e * DEXP * DM + (size_t)(8 * k8) * DM + 256 * cg + lane; a.ld = DM;
        u32x4* db = (u32x4*)((unsigned char*)dd + (size_t)e * DM * DEXP + 8 * (k8 & 1)) + (k8 >> 1) * 1024;
#pragma unroll
        for (int i = 0; i < 4; ++i) a.d[i] = db + rowmap<MAP_IL8>(256 * cg + 64 * i + lane); }
}
__device__ __forceinline__ void conv_experts_ch(Ctx& C, const float* wg, const float* wu, const float* wd, int nexp, bf16_t* dgu, bf16_t* dd, bool with_down) {
    int lane_ = lane_local();
    const int gw = C.bid * NWAVES + C.wave, ngw = C.G * NWAVES, lane = lane_;
    static_assert(WGSCALE == WDSCALE, "one packing path for both task kinds");
    const int ngu = nexp * 256, ntask = ngu + (with_down ? nexp * 128 : 0);
#pragma unroll 1
    for (int t0 = gw; t0 < ntask; t0 += 2 * ngw) {
        const int t1 = t0 + ngw; const bool has1 = t1 < ntask;
        CvAddr a0, a1; cv_addr(a0, t0, ngu, wg, wu, wd, dgu, dd, lane); cv_addr(a1, has1 ? t1 : t0, ngu, wg, wu, wd, dgu, dd, lane);
        float v0[8][4], v1[8][4];
#pragma unroll
        for (int j = 0; j < 8; ++j)
#pragma unroll
            for (int i = 0; i < 4; ++i) v0[j][i] = a0.s[(size_t)j * a0.ld + 64 * i];
        if (has1) {
#pragma unroll
            for (int j = 0; j < 8; ++j)
#pragma unroll
                for (int i = 0; i < 4; ++i) v1[j][i] = a1.s[(size_t)j * a1.ld + 64 * i];
        } else {
#pragma unroll
            for (int j = 0; j < 8; ++j)
#pragma unroll
                for (int i = 0; i < 4; ++i) v1[j][i] = 0.f;
        }
#pragma unroll
        for (int i = 0; i < 4; ++i) { u32x2 o; o.x = pg8::pk4_fp8((f32x4){v0[0][i], v0[1][i], v0[2][i], v0[3][i]} * WGSCALE); o.y = pg8::pk4_fp8((f32x4){v0[4][i], v0[5][i], v0[6][i], v0[7][i]} * WGSCALE); *(u32x2*)a0.d[i] = o; }
        if (has1) {
#pragma unroll
            for (int i = 0; i < 4; ++i) { u32x2 o; o.x = pg8::pk4_fp8((f32x4){v1[0][i], v1[1][i], v1[2][i], v1[3][i]} * WGSCALE); o.y = pg8::pk4_fp8((f32x4){v1[4][i], v1[5][i], v1[6][i], v1[7][i]} * WGSCALE); *(u32x2*)a1.d[i] = o; }
        }
    }
}

__device__ __forceinline__ void ada_units(Ctx& C, KIn kin) {
    LAS float* cond = (LAS float*)C.lds;
    LAS float* part = cond + 4096;
    for (int i = C.tid; i < 4096; i += NTHREADS) cond[i] = siluf_(kin[I_C][i]);
    __syncthreads();
    float* ADA = (float*)(C.ws + WS_ADA); float* ADAKV = (float*)(C.ws + WS_ADAKV);
    for (int u = C.bid; u < 224; u += C.G) {
        const int col0 = 64 * u; const float* W; const float* bias; float* outp; int ld, ostride;
        if (col0 < 12288) { const int l = col0 / 6144, c = col0 % 6144; W = kin[I_WADA] + (size_t)l * DM * 6144 + c; ld = 6144; bias = kin[I_BADA] + l * 6144 + c; outp = ADA + (size_t)l * 4 * 6144 + c; ostride = 6144; }
        else { const int c = col0 - 12288; W = kin[I_WADAKV] + c; ld = 2048; bias = kin[I_BADAKV] + c; outp = ADAKV + c; ostride = 2048; }
        const int kq = C.tid >> 6, cl = C.tid & 63;
        float a0 = 0.f, a1 = 0.f, a2 = 0.f, a3 = 0.f;
#pragma unroll 16
        for (int k = 128 * kq; k < 128 * kq + 128; ++k) { const float w = W[(size_t)k * ld + cl]; a0 += cond[k] * w; a1 += cond[1024 + k] * w; a2 += cond[2048 + k] * w; a3 += cond[3072 + k] * w; }
        part[(kq * 4 + 0) * 64 + cl] = a0; part[(kq * 4 + 1) * 64 + cl] = a1; part[(kq * 4 + 2) * 64 + cl] = a2; part[(kq * 4 + 3) * 64 + cl] = a3;
        __syncthreads();
        if (C.tid < 256) { const int b = C.tid >> 6; float s = bias[cl];
#pragma unroll
            for (int q = 0; q < 8; ++q) s += part[(q * 4 + b) * 64 + cl];
            outp[(size_t)b * ostride + cl] = s; }
        __syncthreads();
    }
}
__device__ __forceinline__ void misc_tables(Ctx& C, KIn kin) {
    float* ROPE = (float*)(C.ws + WS_ROPE);
    for (int i = C.bid * NTHREADS + C.tid; i < NTOK * 8; i += C.G * NTHREADS) { const int t = i >> 3, f = i & 7;
        const float invf = exp2f(-(float)f * (18.931568569324174f / 8.0f));
        const float ang = (float)C.pos[t] * invf; ROPE[(size_t)t * 16 + f] = cosf(ang); ROPE[(size_t)t * 16 + 8 + f] = sinf(ang); }
    if (C.bid == 0 && C.wave == 0) {
        float* MF = (float*)(C.ws + WS_MF);
        const int d = C.lane;
        float qa = fabsf(kin[I_QNA][d]), ka = fabsf(kin[I_KNA][d]), qb = fabsf(kin[I_QNB][d]), k0 = fabsf(kin[I_KNB][d]), k1 = fabsf(kin[I_KNB][64 + d]), k2 = fabsf(kin[I_KNB][128 + d]);
#pragma unroll
        for (int o = 1; o < 64; o <<= 1) { qa = fmaxf(qa, __shfl_xor(qa, o)); ka = fmaxf(ka, __shfl_xor(ka, o)); qb = fmaxf(qb, __shfl_xor(qb, o)); k0 = fmaxf(k0, __shfl_xor(k0, o)); k1 = fmaxf(k1, __shfl_xor(k1, o)); k2 = fmaxf(k2, __shfl_xor(k2, o)); }
        const float f = 8.f * LOG2E * 1.002f;
        if (d == 0) { MF[0] = f * qa * ka; MF[1] = f * qb * k0; MF[2] = f * qb * k1; MF[3] = f * qb * k2; }
    }
}

__device__ __forceinline__ void split8(const f32x4 a, const f32x4 b, u32x4& hi, u32x4& lo) {
    hi.x = cvt_pk_bf16(a[0], a[1]); hi.y = cvt_pk_bf16(a[2], a[3]); hi.z = cvt_pk_bf16(b[0], b[1]); hi.w = cvt_pk_bf16(b[2], b[3]);
    lo.x = cvt_pk_bf16(a[0] - __builtin_bit_cast(float, hi.x << 16), a[1] - __builtin_bit_cast(float, hi.x & 0xffff0000u));
    lo.y = cvt_pk_bf16(a[2] - __builtin_bit_cast(float, hi.y << 16), a[3] - __builtin_bit_cast(float, hi.y & 0xffff0000u));
    lo.z = cvt_pk_bf16(b[0] - __builtin_bit_cast(float, hi.z << 16), b[1] - __builtin_bit_cast(float, hi.z & 0xffff0000u));
    lo.w = cvt_pk_bf16(b[2] - __builtin_bit_cast(float, hi.w << 16), b[3] - __builtin_bit_cast(float, hi.w & 0xffff0000u));
}
struct NormVar { const float* gain; const float* shift; const float* scale; bf16_t* out; };
template <int NV, int NW  , class EpiS>
__device__ __forceinline__ void norm_tile(Ctx& C, int tok0, const float* h, const NormVar (&V)[NV], int skv, const float* W, int ldw, int c0, int ncols, const EpiS& ES) {
    LAS float* GV = (LAS float*)C.lds;
    LAS float* SV = GV + 1024;
    LAS float* RS = SV + 1024;
    LAS float* WL = RS + 128;
    int lane_ = C.lane; asm volatile("" : "+v"(lane_));
    const int lane = lane_, wid = C.wave;
    {
        f32x4 G[NV][4], S[NV][4];
#pragma unroll
        for (int v = 0; v < NV; ++v)
#pragma unroll
            for (int j = 0; j < 4; ++j) { const int k = (64 * j + lane) * 4; const f32x4 gn = *(const f32x4*)(V[v].gain + k), sc = *(const f32x4*)(V[v].scale + k); G[v][j] = gn * (sc + 1.f); S[v][j] = *(const f32x4*)(V[v].shift + k);
                if (v == skv && wid == 0) { *(LAS f32x4*)(GV + k) = G[v][j]; *(LAS f32x4*)(SV + k) = S[v][j]; } }
#pragma unroll 4
        for (int i = 0; i < 16; ++i) {
            const int row = tok0 + 16 * wid + i;
            const f32x4* xr = (const f32x4*)(h + (size_t)row * DM) + lane;
            f32x4 x[4]; float ss = 0.f;
#pragma unroll
            for (int j = 0; j < 4; ++j) { x[j] = xr[64 * j]; ss += (x[j][0] * x[j][0] + x[j][1] * x[j][1]) + (x[j][2] * x[j][2] + x[j][3] * x[j][3]); }
            const float rstd = rsqrtf(wave_sum(ss) * (1.f / DM) + EPSN);
            if (lane == 0) RS[16 * wid + i] = rstd;
#pragma unroll
            for (int v = 0; v < NV; ++v) { u32x2* o8 = (u32x2*)(V[v].out + (size_t)row * DM) + lane;
#pragma unroll
                for (int j = 0; j < 4; ++j) { const f32x4 uu = x[j] * rstd * G[v][j] + S[v][j];
                    if constexpr (NV == 1 && NW == 64) ((unsigned*)((unsigned char*)V[v].out + (size_t)row * DM))[64 * j + lane] = pg8::pk4_fp8(uu * USCALE);
                    else { u32x2 w; w.x = cvt_pk_bf16(uu[0], uu[1]); w.y = cvt_pk_bf16(uu[2], uu[3]); o8[64 * j] = w; } } }
        }
    }
    __syncthreads();
    f32x16 acc0 = (f32x16){}, acc1 = (f32x16){};
    const int tl = 32 * wid + (lane & 31), half = lane >> 5;
    const float rstd = (wid < 4) ? RS[tl] : 0.f;
    const float* hrow = h + (size_t)(tok0 + (wid < 4 ? tl : 0)) * DM;
    LAS unsigned char* WHI = (LAS unsigned char*)WL; LAS unsigned char* WLO = WHI + 32 * NW * 16;
#pragma unroll 1
    for (int kc = 0; kc < 4; ++kc) {
        {
            constexpr int NP = 32 * NW / NTHREADS;
            float wv[NP][8];
#pragma unroll
            for (int q = 0; q < NP; ++q) { const int p = C.tid + q * NTHREADS, n = p % NW, kg = p / NW;
#pragma unroll
                for (int i = 0; i < 8; ++i) wv[q][i] = (n < ncols) ? W[(size_t)(kc * 256 + 8 * kg + i) * ldw + c0 + n] : 0.f; }
#pragma unroll
            for (int q = 0; q < NP; ++q) { const int p = C.tid + q * NTHREADS;
                u32x4 hw, lw; split8((f32x4){wv[q][0], wv[q][1], wv[q][2], wv[q][3]}, (f32x4){wv[q][4], wv[q][5], wv[q][6], wv[q][7]}, hw, lw);
                *(LAS u32x4*)(WHI + p * 16) = hw; *(LAS u32x4*)(WLO + p * 16) = lw; }
        }
        __syncthreads();
        if (wid < 4) {
#pragma unroll 1
            for (int ks4 = 0; ks4 < 16; ks4 += 4) {
                f32x4 hv[4][2];
#pragma unroll
                for (int jj = 0; jj < 4; ++jj) { const float* hp = hrow + kc * 256 + 16 * (ks4 + jj) + 8 * half; hv[jj][0] = *(const f32x4*)hp; hv[jj][1] = *(const f32x4*)(hp + 4); }
#pragma unroll
                for (int jj = 0; jj < 4; ++jj) {
                    const int ks = ks4 + jj, k = kc * 256 + 16 * ks + 8 * half;
                    const f32x4 u0 = hv[jj][0] * rstd * *(const LAS f32x4*)(GV + k) + *(const LAS f32x4*)(SV + k), u1 = hv[jj][1] * rstd * *(const LAS f32x4*)(GV + k + 4) + *(const LAS f32x4*)(SV + k + 4);
                    u32x4 hw, lw; split8(u0, u1, hw, lw);
                    const bf16x8 bhi = __builtin_bit_cast(bf16x8, hw), blo = __builtin_bit_cast(bf16x8, lw);
                    const int fo = ((2 * ks + half) * NW + (lane & 31)) * 16;
                    const bf16x8 ah0 = *(const LAS bf16x8*)(WHI + fo), al0 = *(const LAS bf16x8*)(WLO + fo);
                    acc0 = __builtin_amdgcn_mfma_f32_32x32x16_bf16(ah0, bhi, acc0, 0, 0, 0); acc0 = __builtin_amdgcn_mfma_f32_32x32x16_bf16(ah0, blo, acc0, 0, 0, 0); acc0 = __builtin_amdgcn_mfma_f32_32x32x16_bf16(al0, bhi, acc0, 0, 0, 0);
                    if (NW == 64) { const bf16x8 ah1 = *(const LAS bf16x8*)(WHI + fo + 512), al1 = *(const LAS bf16x8*)(WLO + fo + 512);
                        acc1 = __builtin_amdgcn_mfma_f32_32x32x16_bf16(ah1, bhi, acc1, 0, 0, 0); acc1 = __builtin_amdgcn_mfma_f32_32x32x16_bf16(ah1, blo, acc1, 0, 0, 0); acc1 = __builtin_amdgcn_mfma_f32_32x32x16_bf16(al1, bhi, acc1, 0, 0, 0); }
                }
            }
        }
        __syncthreads();
    }
    ES(C, tok0, acc0, acc1);
}

struct EpiForget { float* logf; const float* bf;
    __device__ __forceinline__ void operator()(Ctx& C, int tok0, const f32x16& a0, const f32x16&) const {
        if (C.wave >= 4) return;
        const int t = tok0 + 32 * C.wave + (C.lane & 31), hi = C.lane >> 5;
#pragma unroll
        for (int r = 0; r < 16; ++r) { const int n = crow(r, hi); if (n < 16) { const float x = a0[r] + bf[n]; logf[(size_t)n * NTOK + t] = fminf(x, 0.f) - log1pf(__expf(-fabsf(x))); } }
    } };
struct EpiGates { float* gates; const float* bg;
    __device__ __forceinline__ void operator()(Ctx& C, int tok0, const f32x16& a0, const f32x16& a1) const {
        if (C.wave >= 4) return;
        const int t = tok0 + 32 * C.wave + (C.lane & 31), hi = C.lane >> 5;
#pragma unroll
        for (int r = 0; r < 16; ++r) { const int n = crow(r, hi); gates[(size_t)t * 48 + n] = sigmoidf_(a0[r] + bg[n]); if (n + 32 < 48) gates[(size_t)t * 48 + n + 32] = sigmoidf_(a1[r] + bg[n + 32]); }
    } };
struct EpiRoute { const float* brout; unsigned* cnt; int* toke; int* tokp; int* rowtok; float* roww;
    __device__ __forceinline__ void operator()(Ctx& C, int tok0, const f32x16& a0, const f32x16& a1) const {
        LAS int* hist = (LAS int*)(C.lds + 100000); LAS int* base = hist + 64;
        const int lane = C.lane, hi = lane >> 5, t = tok0 + 32 * C.wave + (lane & 31);
        const int ch = tok0 / CHTOK;
        if (C.tid < 64) hist[C.tid] = 0;
        int te[8]; float tw[8]; int rk[8];
        if (C.wave < 4) {
            float sc[32]; unsigned key[32];
#pragma unroll
            for (int r = 0; r < 16; ++r) { const int e = crow(r, hi);
                sc[r] = sigmoidf_(a0[r]); sc[16 + r] = sigmoidf_(a1[r]);
                const float v0 = sc[r] + brout[e], v1 = sc[16 + r] + brout[e + 32];
                const unsigned u0 = __float_as_uint(v0), u1 = __float_as_uint(v1);
                key[r] = (u0 & 0x80000000u) ? ~u0 : (u0 | 0x80000000u); key[16 + r] = (u1 & 0x80000000u) ? ~u1 : (u1 | 0x80000000u); }
            float ssum = 0.f;
#pragma unroll
            for (int k = 0; k < 8; ++k) {
                unsigned mx = 0u;
#pragma unroll
                for (int i = 0; i < 32; ++i) mx = mx > key[i] ? mx : key[i];
                { const unsigned o = (unsigned)__shfl_xor((int)mx, 32); mx = mx > o ? mx : o; }
                int idx = 64;
#pragma unroll
                for (int i = 0; i < 32; ++i) { const int e = crow(i & 15, hi) + 32 * (i >> 4); idx = (key[i] == mx && e < idx) ? e : idx; }
                { const int o = __shfl_xor(idx, 32); idx = o < idx ? o : idx; }
                float sk = -1.f;
#pragma unroll
                for (int i = 0; i < 32; ++i) { const int e = crow(i & 15, hi) + 32 * (i >> 4); const bool hit = (e == idx); sk = hit ? sc[i] : sk; key[i] = hit ? 0u : key[i]; }
                { const float o = __shfl_xor(sk, 32); sk = fmaxf(sk, o); }
                te[k] = idx; tw[k] = sk; ssum += sk;
            }
            const float inv = 2.5f / ssum;
#pragma unroll
            for (int k = 0; k < 8; ++k) tw[k] *= inv;
        }
        __syncthreads();
        if (C.wave < 4 && hi == 0) {
#pragma unroll
            for (int k = 0; k < 8; ++k) rk[k] = atomicAdd((int*)(hist + te[k]), 1);
        }
        __syncthreads();
        if (C.tid < 64) base[C.tid] = (int)atomicAdd(cnt + ch * 64 + C.tid, (unsigned)hist[C.tid]);
        __syncthreads();
        if (C.wave < 4 && hi == 0) {
            i32x4 e0, e1, p0, p1;
#pragma unroll
            for (int k = 0; k < 8; ++k) { const int e = te[k], p = base[e] + rk[k];
                if (k < 4) { e0[k] = e; p0[k] = p; } else { e1[k - 4] = e; p1[k - 4] = p; }
                rowtok[((size_t)ch * 64 + e) * CHTOK + p] = t; roww[((size_t)ch * 64 + e) * CHTOK + p] = tw[k]; }
            *(i32x4*)(toke + (size_t)t * 8) = e0; *(i32x4*)(toke + (size_t)t * 8 + 4) = e1; *(i32x4*)(tokp + (size_t)t * 8) = p0; *(i32x4*)(tokp + (size_t)t * 8 + 4) = p1;
        }
        __syncthreads();
    } };

__device__ __forceinline__ pg8::MoeTab moe_tables(Ctx& C, const unsigned* cnt_g, const LAS int** pstart_out, bool with_shared = false) {
    LAS int* cnt = (LAS int*)(C.lds + MISC_OFF + 1024); LAS int* tstart = cnt + 68; LAS int* pstart = tstart + 68; LAS unsigned char* tile_e = (LAS unsigned char*)(pstart + 68);
    const int ne = with_shared ? NEXP + 1 : NEXP;
    __syncthreads();
    if (C.tid < 64) cnt[C.tid] = (int)__hip_atomic_load(cnt_g + C.tid, __ATOMIC_RELAXED, __HIP_MEMORY_SCOPE_AGENT);
    if (C.tid == 64) cnt[64] = with_shared ? CHTOK : 0;
    __syncthreads();
    if (C.tid < 64) {
        const int e = C.tid; const int nt = (cnt[e] + 255) >> 8;
        int inc = nt;
#pragma unroll
        for (int o = 1; o < 64; o <<= 1) { const int v = __shfl_up(inc, o); if (C.lane >= o) inc += v; }
        if (e == 63) tstart[67] = inc;
        asm volatile("s_waitcnt lgkmcnt(0)" ::: "memory");
        if (e < 64) { tstart[e] = inc - nt; pstart[e] = (inc - nt) * 256; if (e == 63 && ne == 64) { tstart[64] = inc; pstart[64] = inc * 256; } }
    }
    __syncthreads();
    if (ne > 64 && C.tid == 0) { const int base = tstart[67], n64 = (cnt[64] + 255) >> 8; tstart[64] = base; pstart[64] = base * 256; tstart[65] = base + n64; pstart[65] = (base + n64) * 256; }
    __syncthreads();
    if (C.tid < ne) { for (int m = tstart[C.tid]; m < tstart[C.tid + 1]; ++m) tile_e[m] = (unsigned char)C.tid; }
    __syncthreads();
    pg8::MoeTab T; T.tstart = tstart; T.cnt = cnt; T.tile_e = tile_e; T.ntiles = tstart[ne];
    *pstart_out = pstart;
    return T;
}

__device__ __forceinline__ void cumsum_unit(Ctx& C, int bh) {
    const float* LOGF = (const float*)(C.ws + WS_LOGF); float* CUM = (float*)(C.ws + WS_CUM);
    LAS float* wt = (LAS float*)(C.lds + MISC_OFF + 3072);
    const int b = bh >> 4, hh = bh & 15;
    float v[16]; float run = 0.f;
#pragma unroll
    for (int i = 0; i < 16; ++i) { run += LOGF[(size_t)hh * NTOK + (size_t)b * SEQ + 16 * C.tid + i]; v[i] = run; }
    float inc = run;
#pragma unroll
    for (int o = 1; o < 64; o <<= 1) { const float n = __shfl_up(inc, o); if (C.lane >= o) inc += n; }
    if (C.lane == 63) wt[C.wave] = inc;
    __syncthreads();
    float pre = inc - run;
    for (int w = 0; w < C.wave; ++w) pre += wt[w];
#pragma unroll
    for (int i = 0; i < 16; ++i) CUM[(size_t)bh * SEQ + 16 * C.tid + i] = (pre + v[i]) * LOG2E;
    __syncthreads();
}

__device__ __forceinline__ void compress2(Ctx& C, KIn kin) {
    LAS float* w2l = (LAS float*)C.lds;
    LAS float* hl = (LAS float*)(C.lds + 65536) + C.wave * 256;
    const float* SLAB = (const float*)(C.ws + WS_SLAB);
    const int gw = C.bid * NWAVES + C.wave, ngw = C.G * NWAVES;
#pragma unroll 1
    for (int kind = 0; kind < 2; ++kind) {
        const float* w2 = kin[kind == 0 ? I_WCK2 : I_WCV2];
        __syncthreads();
        { f32x4 wv[8];
#pragma unroll
          for (int q = 0; q < 8; ++q) wv[q] = *(const f32x4*)(w2 + 4 * (C.tid + q * NTHREADS));
#pragma unroll
          for (int q = 0; q < 8; ++q) *(LAS f32x4*)(w2l + 4 * (C.tid + q * NTHREADS)) = wv[q]; }
        __syncthreads();
        bf16_t* dst = (bf16_t*)(C.ws + (kind == 0 ? WS_KCMP : WS_VCMP));
        for (int row = gw; row < 2048; row += ngw) {
            const float* sl = SLAB + (size_t)kind * 8 * 2048 * 256 + (size_t)row * 256;
            float sv[4][8];
#pragma unroll
            for (int i = 0; i < 4; ++i)
#pragma unroll
                for (int ks = 0; ks < 8; ++ks) sv[i][ks] = sl[(size_t)ks * 2048 * 256 + C.lane + 64 * i];
#pragma unroll
            for (int i = 0; i < 4; ++i) { float s = 0.f;
#pragma unroll
                for (int ks = 0; ks < 8; ++ks) s += sv[i][ks];
                hl[C.lane + 64 * i] = siluf_(s); }
            LDS_WAIT();
            float a0 = 0.f, a1 = 0.f, a2 = 0.f, a3 = 0.f;
#pragma unroll 8
            for (int j = 0; j < 256; j += 4) { const f32x4 hv = *(const LAS f32x4*)(hl + j);
                a0 += hv[0] * w2l[j * 64 + C.lane]; a1 += hv[1] * w2l[(j + 1) * 64 + C.lane]; a2 += hv[2] * w2l[(j + 2) * 64 + C.lane]; a3 += hv[3] * w2l[(j + 3) * 64 + C.lane]; }
            const float acc = (a0 + a1) + (a2 + a3);
            float o = acc;
            if (kind == 0) { const float ss = wave_sum(acc * acc); o = acc * rsqrtf(ss * (1.f / 64.f) + EPSN) * kin[I_KNB][C.lane]; }
            dst[(size_t)row * 64 + C.lane] = (bf16_t)f2bf(o);
            LDS_WAIT();
        }
    }
    __syncthreads();
}
#define XB_TMO      128
#define XB_XCNT(j)  (256  + 64 * (j))
#define XB_XSUB(j)  (1280 + 64 * (j))
#define XB_XGEN(j)  (2304 + 64 * (j))
#define XB_TOP      3328
#define XB_TOPGEN   3392
#define XCD_BAR_WORDS 3456
#define XB_SPIN_CAP (1u << 22)
__device__ __forceinline__ unsigned xb_ld(unsigned* p)              { return __hip_atomic_load(p, __ATOMIC_RELAXED, __HIP_MEMORY_SCOPE_AGENT); }
__device__ __forceinline__ unsigned xb_add(unsigned* p, unsigned v) { return __hip_atomic_fetch_add(p, v, __ATOMIC_RELAXED, __HIP_MEMORY_SCOPE_AGENT); }
__device__ __forceinline__ unsigned xb_xcc_id() { return (unsigned)__builtin_amdgcn_s_getreg((3 << 11) | 20) & 0xFu; }
#define XB_SPIN(cond, bar) do { unsigned _sp = 0; while (cond) { __builtin_amdgcn_s_sleep(1); \
    if ((++_sp & 255u) == 0u) { if (xb_ld(&(bar)[XB_TMO])) break; if (_sp > XB_SPIN_CAP) { atomicAdd(&(bar)[XB_TMO], 1u); break; } } } } while (0)
struct XcdBarrier { unsigned* bar; unsigned x; volatile LAS unsigned* st; };
__device__ __forceinline__ XcdBarrier xcd_barrier_post(unsigned* bar, volatile LAS unsigned* st) {
    XcdBarrier b; b.bar = bar; b.x = xb_xcc_id(); b.st = st;
    if (threadIdx.x == 0) (void)xb_add(&bar[XB_XCNT(b.x)], 1u);
    return b;
}
__device__ __forceinline__ void xcd_barrier_complete(unsigned* bar, unsigned x, unsigned& nloc, unsigned& nx) {
    const unsigned G = gridDim.x * gridDim.y * gridDim.z;
    unsigned sum, cnt, mine, sp = 0u;
    for (;;) {
        sum = 0u; cnt = 0u; mine = 0u;
#pragma unroll
        for (unsigned j = 0; j < 16; ++j) { const unsigned c = xb_ld(&bar[XB_XCNT(j)]); sum += c; cnt += (c > 0u) ? 1u : 0u; mine = (j == x) ? c : mine; }
        if (sum == G) break;
        __builtin_amdgcn_s_sleep(1);
        if ((++sp & 255u) == 0u) { if (xb_ld(&bar[XB_TMO])) break; if (sp > XB_SPIN_CAP) { atomicAdd(&bar[XB_TMO], 1u); break; } }
    }
    nloc = mine > 0u ? mine : 1u; nx = cnt > 0u ? cnt : 1u;
}
__device__ __forceinline__ void xcd_barrier(const XcdBarrier& b, bool t0) {
    asm volatile("s_waitcnt vmcnt(0)" ::: "memory");
    __syncthreads();
    if (t0) {
        unsigned* bar = b.bar;
        __builtin_amdgcn_s_waitcnt(0);
        unsigned nloc = b.st[0], nx = b.st[1];
        if (nloc == 0u) { xcd_barrier_complete(bar, b.x, nloc, nx); b.st[0] = nloc; b.st[1] = nx; }
        const unsigned old = xb_add(&bar[XB_XSUB(b.x)], 1u);
        const unsigned gen = old / nloc;
        if (old + 1u == (gen + 1u) * nloc) {
            __builtin_amdgcn_fence(__ATOMIC_RELEASE, "agent");
            asm volatile("s_waitcnt vmcnt(0)" ::: "memory");
            const unsigned og = xb_add(&bar[XB_TOP], 1u);
            const unsigned tg = og / nx;
            if (og + 1u == (tg + 1u) * nx) xb_add(&bar[XB_TOPGEN], 1u);
            else XB_SPIN(xb_ld(&bar[XB_TOPGEN]) == tg, bar);
            __builtin_amdgcn_fence(__ATOMIC_ACQUIRE, "agent");
            xb_add(&bar[XB_XGEN(b.x)], 1u);
            asm volatile("s_waitcnt vmcnt(0)" ::: "memory");
        } else {
            XB_SPIN(xb_ld(&bar[XB_XGEN(b.x)]) == gen, bar);
            __builtin_amdgcn_fence(__ATOMIC_ACQUIRE, "agent");
            asm volatile("s_waitcnt vmcnt(0)" ::: "memory");
        }
    }
    __syncthreads();
}

#ifndef MK_ONE_LAUNCH
#define MK_ONE_LAUNCH 1
#endif
constexpr int N_PHASES = 25;

__global__ void __launch_bounds__(NTHREADS, 2) fwd_kernel(Args args) {
    extern __shared__ __attribute__((aligned(16))) unsigned char lds_raw[];
    { volatile LAS unsigned* MISC0 = (volatile LAS unsigned*)((LAS unsigned char*)lds_raw + MISC_OFF); if (threadIdx.x < 16) MISC0[threadIdx.x] = 0u; }
    __syncthreads();
#if MK_ONE_LAUNCH
    const int wv0_ = __builtin_amdgcn_readfirstlane((int)threadIdx.x >> 6);
    (void)xcd_barrier_post((unsigned*)(args.ws + WS_CTL) + CW_BAR, (volatile LAS unsigned*)((LAS unsigned char*)lds_raw + MISC_OFF) + 8);
#define GRID_BAR() do { unsigned zb_; asm volatile("s_mov_b32 %0, 0" : "=s"(zb_)); const AS4 char* kbb_ = (const AS4 char*)__builtin_amdgcn_kernarg_segment_ptr() + zb_; \
        XcdBarrier b_; b_.bar = (unsigned*)(*(unsigned char* const AS4*)(kbb_ + 8 * N_IN + 8) + WS_CTL) + CW_BAR; b_.x = xb_xcc_id(); b_.st = (volatile LAS unsigned*)((LAS unsigned char*)lds_raw + MISC_OFF) + 8; \
        xcd_barrier(b_, wv0_ == 0 && lane_local() == 0); } while (0)
#else
#define GRID_BAR() do {} while (0)
#endif
#if MK_ONE_LAUNCH
    constexpr int lo = 0, hi = N_PHASES;
#else
    const int lo = args.ph_lo, hi = args.ph_hi;
#endif
#ifndef PHMASK
#define PHMASK 0x1ffffffu
#endif
#define INR(k) (lo <= (k) && (k) < hi)
#define PHB(b) ((PHMASK >> (b)) & 1u)
#define IN(k) (PHB(k) && INR(k))
#define SEAM(k) do { if (INR(k) && INR((k) + 1)) GRID_BAR(); } while (0)
#ifndef REPMASK
#define REPMASK 0u
#endif
#define NREP(b) (((REPMASK >> (b)) & 1u) ? 2 : 1)
#define PH_BEGIN \
    unsigned zo_; asm volatile("s_mov_b32 %0, 0" : "=s"(zo_)); \
    const AS4 char* kb_ = (const AS4 char*)__builtin_amdgcn_kernarg_segment_ptr() + zo_; \
    KIn kin = (KIn)kb_; \
    Ctx C; C.out = *(float* const AS4*)(kb_ + 8 * N_IN); C.ws = *(unsigned char* const AS4*)(kb_ + 8 * N_IN + 8); C.pos = (const int*)kin[I_POS]; \
    C.lds = (LAS unsigned char*)lds_raw; C.ctl = (unsigned*)(C.ws + WS_CTL); \
    { int t_ = (wv0_ << 6) | lane_local(); asm volatile("" : "+v"(t_)); C.tid = t_; } C.lane = C.tid & 63; C.wave = __builtin_amdgcn_readfirstlane(C.tid >> 6); C.G = gridDim.x; C.bid = blockIdx.x; \
    const int vcu = (C.G % 8 == 0) ? (C.bid % 8) * (C.G / 8) + C.bid / 8 : C.bid; (void)vcu; \
    const float* ADA0 = (const float*)(C.ws + WS_ADA); (void)ADA0; const float* ADAKV = (const float*)(C.ws + WS_ADAKV); (void)ADAKV; const float* MF = (const float*)(C.ws + WS_MF); (void)MF; \
    bf16_t* U = (bf16_t*)(C.ws + WS_U); (void)U;

    for (int rp_ = 0; rp_ < NREP(0); ++rp_) if (IN(0)) { PH_BEGIN
        ada_units(C, kin);
        misc_tables(C, kin);
        const int gw = C.bid * NWAVES + C.wave, ngw = C.G * NWAVES;
        {
            LAS float* scr = (LAS float*)(C.lds + C.wave * 16384);
            constexpr int N0 = 16 * 48, N1 = N0 + 256, N2 = N1 + 16 * 24, N3 = N2 + 256, N4 = N3 + 256, N5 = N4 + 64 * 4, N6 = N5 + 64 * 4;
            for (int it = gw; it < N6; it += ngw) {
                if (it < N0)      { const int r = it,      kb = r / 48, nb = r % 48; xitem64<MAP_HPERM>(kin[I_WINA], 3088, 64 * nb, 64 * kb, (bf16_t*)(C.ws + WS_WQKV), DM, 0, 64 * nb, scr, C.lane); }
                else if (it < N1) { const int r = it - N0, kb = r / 16, nb = r % 16; xitem64<MAP_ID>(kin[I_WOA], DM, 64 * nb, 64 * kb, (bf16_t*)(C.ws + WS_WOA), DM, 0, 64 * nb, scr, C.lane); }
                else if (it < N2) { const int r = it - N1, kb = r / 24, nb = r % 24; xitem64<MAP_HPERM>(kin[I_WKVB], 1536, 64 * nb, 64 * kb, (bf16_t*)(C.ws + WS_WKV), DM, 0, 64 * nb, scr, C.lane); }
                else if (it < N3) { const int r = it - N2, kb = r / 16, nb = r % 16; xitem64<MAP_HPERM>(kin[I_WINB], 1072, 64 * nb, 64 * kb, (bf16_t*)(C.ws + WS_WQB), DM, 0, 64 * nb, scr, C.lane); }
                else if (it < N4) { const int r = it - N3, kb = r / 16, nb = r % 16; xitem64<MAP_ID>(kin[I_WOB], DM, 64 * nb, 64 * kb, (bf16_t*)(C.ws + WS_WOB), DM, 0, 64 * nb, scr, C.lane); }
                else if (it < N5) { const int r = it - N4, kb = r / 4,  nb = r % 4;  xitem64<MAP_ID>(kin[I_WCK1], 256, 64 * nb, 64 * kb, (bf16_t*)(C.ws + WS_WC1K), 4096, 0, 64 * nb, scr, C.lane); }
                else              { const int r = it - N5, kb = r / 4,  nb = r % 4;  xitem64<MAP_ID>(kin[I_WCV1], 256, 64 * nb, 64 * kb, (bf16_t*)(C.ws + WS_WC1V), 4096, 0, 64 * nb, scr, C.lane); }
            }
        }
        conv_experts_ch(C, kin[I_WSG], kin[I_WSU], kin[I_WSD], 2, (bf16_t*)(C.ws + WS_WSGU), (bf16_t*)(C.ws + WS_WSD), false);
        conv_experts(C, kin[I_WSG], kin[I_WSU], kin[I_WSD], 2, (bf16_t*)(C.ws + WS_WSGU), (bf16_t*)(C.ws + WS_WSD), gw, ngw, true);
        __syncthreads();
    }
#pragma unroll 1
    for (int layer = 0; layer < 2; ++layer) {
#define CONV_LAYER_EXPERTS() conv_experts_ch(C, kin[I_WEG] + (size_t)layer * NEXP * DM * DEXP, kin[I_WEU] + (size_t)layer * NEXP * DM * DEXP, kin[I_WED] + (size_t)layer * NEXP * DEXP * DM, NEXP, (bf16_t*)(C.ws + WS_WEGU), (bf16_t*)(C.ws + WS_WED), true)
        if (layer == 0) {
            SEAM(0);
            for (int rp_ = 0; rp_ < NREP(1); ++rp_) if (IN(1)) { PH_BEGIN const float* ADA = ADA0 + (size_t)layer * 4 * 6144; (void)ADA;
                for (int tile = C.bid; tile < NTOK / 128; tile += C.G) {
                    const int tok0 = tile * 128, b = tok0 / SEQ;
                    const NormVar V[1] = {{kin[I_NMIX], ADA + (size_t)b * 6144, ADA + (size_t)b * 6144 + 1024, U}};
                    EpiForget ES{(float*)(C.ws + WS_LOGF), kin[I_BFA]};
                    norm_tile<1, 32>(C, tok0, kin[I_X], V, 0, kin[I_WINA], 3088, 3072, 16, ES);
                    __syncthreads();
                }
            }
            SEAM(1);
            for (int rp_ = 0; rp_ < NREP(2); ++rp_) if (IN(2)) { PH_BEGIN const float* ADA = ADA0 + (size_t)layer * 4 * 6144; (void)ADA;
                { pg8::Gemm g{U, DM, DM, DM};
                  pg8::DenseSched S; S.init((const bf16_t*)(C.ws + WS_WQKV), DM, DM, NTOK, 3072, C.G, C.bid);
                  pg8::EpiQKV E{(bf16_t*)(C.ws + WS_Q), (size_t)(WS_K - WS_Q) / 2, kin[I_QNA], kin[I_KNA]};
                  pg8::gemm_phase(C.lds, g, S, E, C.wave); }
                for (int bh = C.bid; bh < NB * NH; bh += C.G) cumsum_unit(C, bh);
            }
            SEAM(2);
            for (int rp_ = 0; rp_ < NREP(3); ++rp_) if (IN(3)) { PH_BEGIN const float* ADA = ADA0 + (size_t)layer * 4 * 6144; (void)ADA;
                const float M2 = MF[0];
                const int cslot = (C.G == 256) ? ((C.bid >> 3) & 7) : 0;
                for (int i = 0;; ++i) {
                    int bh, qb;
                    if (C.G == 256) { if (i >= 8) break; bh = vcu >> 2; const int c4 = vcu & 3, k = i >> 1; qb = (i & 1) ? (8 * k + 7 - c4) : (8 * k + c4); }
                    else { const int u = i * C.G + C.bid; if (u >= NB * NH * 32) break; bh = u >> 5; qb = u & 31; }
                    if (i == cslot) CONV_LAYER_EXPERTS();
                    att::fox_unit((LAS char*)C.lds, bh >> 4, bh & 15, qb, (const bf16_t*)(C.ws + WS_Q), (const bf16_t*)(C.ws + WS_K), (const bf16_t*)(C.ws + WS_V), (bf16_t*)(C.ws + WS_O), (const float*)(C.ws + WS_CUM), M2, C.wave);
                }
            }
            SEAM(3);
            for (int rp_ = 0; rp_ < NREP(4); ++rp_) if (IN(4)) { PH_BEGIN const float* ADA = ADA0 + (size_t)layer * 4 * 6144; (void)ADA;
                pg8::Gemm g{(const bf16_t*)(C.ws + WS_O), DM, DM, DM};
                pg8::DenseSched S; S.init((const bf16_t*)(C.ws + WS_WOA), DM, DM, NTOK, DM, C.G, C.bid);
                pg8::EpiResid E{kin[I_X], C.out, ADA + 2048};
                pg8::gemm_phase(C.lds, g, S, E, C.wave);
            }
            SEAM(4);
        } else {
            if (IN(12)) { PH_BEGIN const float* ADA = ADA0 + (size_t)layer * 4 * 6144; (void)ADA;
                for (int tile = C.bid; tile < NTOK / 128; tile += C.G) {
                    const int tok0 = tile * 128, b = tok0 / SEQ;
                    const NormVar V[2] = {{kin[I_NKV], ADAKV + (size_t)b * 2048, ADAKV + (size_t)b * 2048 + 1024, (bf16_t*)(C.ws + WS_SKV)},
                                          {kin[I_NMIX] + DM, ADA + (size_t)b * 6144, ADA + (size_t)b * 6144 + 1024, U}};
                    EpiGates ES{(float*)(C.ws + WS_GATES), kin[I_BGB]};
                    norm_tile<2, 64>(C, tok0, C.out, V, 1, kin[I_WINB], 1072, 1024, 48, ES);
                    __syncthreads();
                }
            }
            SEAM(12);
            for (int rp_ = 0; rp_ < NREP(13); ++rp_) if (IN(13)) { PH_BEGIN const float* ADA = ADA0 + (size_t)layer * 4 * 6144; (void)ADA;
                pg8::Gemm g{(const bf16_t*)(C.ws + WS_SKV), DM, DM, DM};
                pg8::DenseSched S; S.init((const bf16_t*)(C.ws + WS_WKV), DM, DM, NTOK, 1536, C.G, C.bid);
                pg8::EpiKV E{(bf16_t*)(C.ws + WS_ACK), (bf16_t*)(C.ws + WS_KSEL), (size_t)(WS_ACV - WS_ACK) / 2, (size_t)(WS_VSEL - WS_KSEL) / 2,
                              kin[I_PEK], kin[I_PEV], kin[I_KNB], (const float*)(C.ws + WS_ROPE), C.lds};
                pg8::gemm_phase(C.lds, g, S, E, C.wave);
            }
            SEAM(13);
            for (int rp_ = 0; rp_ < NREP(14); ++rp_) if (IN(14)) { PH_BEGIN const float* ADA = ADA0 + (size_t)layer * 4 * 6144; (void)ADA;
                { pg8::Gemm g{U, DM, DM, DM};
                  pg8::DenseSched S; S.init((const bf16_t*)(C.ws + WS_WQB), DM, DM, NTOK, DM, C.G, C.bid);
                  pg8::EpiQB E{(bf16_t*)(C.ws + WS_QP), (bf16_t*)(C.ws + WS_QR), kin[I_QNB], (const float*)(C.ws + WS_ROPE)};
                  pg8::gemm_phase(C.lds, g, S, E, C.wave); }
#pragma unroll 1
                for (int kind = 0; kind < 2; ++kind) {
                    pg8::Gemm g{(const bf16_t*)(C.ws + (kind == 0 ? WS_ACK : WS_ACV)), 4096, 4096, 512};
                    pg8::SplitKSched S; S.init((const bf16_t*)(C.ws + (kind == 0 ? WS_WC1K : WS_WC1V)), 4096, 4096, 512, 2048, 8, C.G, (C.bid + 128 * kind) % C.G);
                    pg8::EpiSlab E{(float*)(C.ws + WS_SLAB) + (size_t)kind * 8 * 2048 * 256};
                    pg8::gemm_phase(C.lds, g, S, E, C.wave);
                }
            }
            SEAM(14);
            if (IN(15)) { PH_BEGIN compress2(C, kin); }
            SEAM(15);
            for (int rp_ = 0; rp_ < NREP(16); ++rp_) if (IN(16)) { PH_BEGIN const float* ADA = ADA0 + (size_t)layer * 4 * 6144; (void)ADA;
                att::NsaArgs A{(const bf16_t*)(C.ws + WS_QP), (const bf16_t*)(C.ws + WS_QR), (const bf16_t*)(C.ws + WS_KCMP), (const bf16_t*)(C.ws + WS_VCMP), (const bf16_t*)(C.ws + WS_KSEL), (const bf16_t*)(C.ws + WS_VSEL),
                               (const bf16_t*)(C.ws + WS_KWIN), (const bf16_t*)(C.ws + WS_VWIN), (const float*)(C.ws + WS_GATES), (bf16_t*)(C.ws + WS_ONSA), MF[1], MF[2], MF[3]};
                const int cslot = (C.G == 256) ? ((C.bid >> 3) & 7) : 0;
                for (int i = 0;; ++i) {
                    int bg, c;
                    if (C.G == 256) { if (i >= 8) break; bg = vcu >> 4; const int j = vcu & 15, k = i >> 1; c = (i & 1) ? (32 * k + 31 - j) : (32 * k + j); }
                    else { const int u = i * C.G + C.bid; if (u >= NB * NG * 128) break; bg = u >> 7; c = u & 127; }
                    if (i == cslot) CONV_LAYER_EXPERTS();
                    att::nsa_unit((LAS char*)C.lds, bg >> 2, bg & 3, c, A, C.wave);
                }
            }
            SEAM(16);
            if (IN(17)) { PH_BEGIN const float* ADA = ADA0 + (size_t)layer * 4 * 6144; (void)ADA;
                pg8::Gemm g{(const bf16_t*)(C.ws + WS_ONSA), DM, DM, DM};
                pg8::DenseSched S; S.init((const bf16_t*)(C.ws + WS_WOB), DM, DM, NTOK, DM, C.G, C.bid);
                pg8::EpiResid E{C.out, C.out, ADA + 2048};
                pg8::gemm_phase(C.lds, g, S, E, C.wave);
            }
            SEAM(17);
        }
        const int pm1 = layer == 0 ? 5 : 18;
        if (PHB(5) && INR(pm1)) { PH_BEGIN const float* ADA = ADA0 + (size_t)layer * 4 * 6144;
            for (int tile = C.bid; tile < NTOK / 128; tile += C.G) {
                const int tok0 = tile * 128, b = tok0 / SEQ; const float* ad = ADA + (size_t)b * 6144;
                const NormVar V[1] = {{kin[I_NFFN] + layer * DM, ad + 3072, ad + 4096, U}};
                EpiRoute ES{kin[I_BR] + layer * NEXP, C.ctl + CW_CNT + layer * NCH * 64, (int*)(C.ws + WS_TOKE), (int*)(C.ws + WS_TOKP), (int*)(C.ws + WS_ROWTOK), (float*)(C.ws + WS_ROWW)};
                norm_tile<1, 64>(C, tok0, C.out, V, 0, kin[I_WR] + (size_t)layer * DM * NEXP, NEXP, 0, NEXP, ES);
                __syncthreads();
            }
        }
        SEAM(pm1);
#pragma unroll 1
        for (int step = 0; step <= NCH; ++step) {
            const int pa = pm1 + 1 + 2 * step;
            for (int rp_ = 0; rp_ < NREP(6); ++rp_) if (PHB(6) && INR(pa)) { PH_BEGIN const float* ADA = ADA0 + (size_t)layer * 4 * 6144; (void)ADA;
                bf16_t* ACT = (bf16_t*)(C.ws + WS_ACT); unsigned char* Y = C.ws + WS_Y;
                if (step >= 1) {
                    const int ch = step - 1;
                    const unsigned* cntg = (const unsigned*)(C.ctl + CW_CNT + (layer * NCH + ch) * 64);
                    const LAS int* pstart; const pg8::MoeTab T = moe_tables(C, cntg, &pstart); (void)T;
                    pg8::Gemm g{(const bf16_t*)(C.ws + (ch & 1 ? WS_ACTS1 : WS_ACTS)), DEXP, DEXP, DEXP};
                    pg8::DenseSched S; S.init((const bf16_t*)(C.ws + WS_WSD) + (size_t)layer * DM * DEXP, DEXP, DEXP, CHTOK, DM, C.G, C.bid, 0);
                    pg8::EpiCombine E{C.out, Y, (const int*)(C.ws + WS_TOKE), (const int*)(C.ws + WS_TOKP), pstart, ADA + 5120, ch * CHTOK};
                    pg8::gemm_phase(C.lds, g, S, E, C.wave);
                }
                if (step < NCH) {
                    const int ch = step;
                    const unsigned* cntg = (const unsigned*)(C.ctl + CW_CNT + (layer * NCH + ch) * 64);
                    const int* ROWTOK = (const int*)(C.ws + WS_ROWTOK) + (size_t)ch * 64 * CHTOK;
                    const LAS int* pstart; const pg8::MoeTab T = moe_tables(C, cntg, &pstart, true);
                    pg8::Gemm g{U, DM / 2, 512, DM / 2};
                    pg8::MoeGatherSched S; S.T = T; S.Bt = (const bf16_t*)(C.ws + WS_WEGU); S.Bsh = (const bf16_t*)(C.ws + WS_WSGU) + (size_t)layer * 512 * DM / 2; S.rowtok = ROWTOK; S.nN = 2; S.G = C.G; S.c = C.bid; S.ldb = DM; S.bstride = (size_t)512 * DM / 2; S.tokbase = ch * CHTOK;
                    pg8::EpiGU E{ACT, (bf16_t*)(C.ws + (ch & 1 ? WS_ACTS1 : WS_ACTS)), T.tstart[NEXP]};
                    pg8::gemm_phase(C.lds, g, S, E, C.wave);
                }
            }
            if (!(layer == 1 && step == NCH)) SEAM(pa);
            if (step < NCH) {
                const int ch = step;
                for (int rp_ = 0; rp_ < NREP(7); ++rp_) if (PHB(7) && INR(pa + 1)) { PH_BEGIN
                    const unsigned* cntg = (const unsigned*)(C.ctl + CW_CNT + (layer * NCH + ch) * 64);
                    const float* ROWW = (const float*)(C.ws + WS_ROWW) + (size_t)ch * 64 * CHTOK;
                    const LAS int* pstart; const pg8::MoeTab T = moe_tables(C, cntg, &pstart);
                    pg8::Gemm g{(const bf16_t*)(C.ws + WS_ACT), DEXP / 2, DM, DEXP / 2};
                    pg8::MoeDownSched S; S.T = T; S.Bt = (const bf16_t*)(C.ws + WS_WED); S.nN = 4; S.G = C.G; S.c = C.bid; S.lda = DEXP / 2; S.ldb = DEXP; S.bstride = (size_t)DM * DEXP / 2;
                    pg8::EpiY E{C.ws + WS_Y, T, ROWW};
                    pg8::gemm_phase(C.lds, g, S, E, C.wave);
                }
                SEAM(pa + 1);
            }
        }
    }
#undef IN
#undef SEAM
}

extern "C" void kernel_launch(void* const* d_in, const int* in_sizes, int n_in, void* d_out, int out_size, void* d_ws, size_t ws_size, hipStream_t stream) {
    static int grid = 0;
    if (grid == 0) {
        if (n_in != N_IN || in_sizes[0] != NTOK * DM || out_size != NTOK * DM || ws_size < WS_END) { fprintf(stderr, "kernel_launch: unexpected shapes (n_in %d, ws %zu < %zu)\n", n_in, ws_size, (size_t)WS_END); grid = -1; return; }
        int dev = 0, cus = 0, per_cu = 0;
        if (hipGetDevice(&dev) != hipSuccess || hipDeviceGetAttribute(&cus, hipDeviceAttributeMultiprocessorCount, dev) != hipSuccess) { grid = -1; return; }
        if (hipFuncSetAttribute((const void*)fwd_kernel, hipFuncAttributeMaxDynamicSharedMemorySize, LDS_BYTES) != hipSuccess) { fprintf(stderr, "kernel_launch: hipFuncSetAttribute failed\n"); grid = -1; return; }
        if (hipOccupancyMaxActiveBlocksPerMultiprocessor(&per_cu, (const void*)fwd_kernel, NTHREADS, LDS_BYTES) != hipSuccess || per_cu < 1) { fprintf(stderr, "kernel_launch: occupancy query says %d\n", per_cu); }
        (void)hipGetLastError();
        grid = cus;
    }
    if (grid < 0) return;
    (void)hipMemsetAsync((char*)d_ws + WS_CTL, 0, CTL_ZERO_BYTES, stream);
    Args a{};
    for (int i = 0; i < N_IN; ++i) a.in[i] = (const float*)d_in[i];
    a.out = (float*)d_out; a.ws = (unsigned char*)d_ws;
#if MK_ONE_LAUNCH
    a.ph_lo = 0; a.ph_hi = N_PHASES;
    hipLaunchKernelGGL(fwd_kernel, dim3(grid), dim3(NTHREADS), LDS_BYTES, stream, a);
#else
    for (int p = 0; p < N_PHASES; ++p) { a.ph_lo = p; a.ph_hi = p + 1; hipLaunchKernelGGL(fwd_kernel, dim3(grid), dim3(NTHREADS), LDS_BYTES, stream, a); }
#endif
}
```
